# Optimizing an MI355X kernel written in HIP

```python
import math
import jax, jax.numpy as jnp
from jax import lax
import numpy as np

D_MODEL = 2048
BATCH = 4
SEQ = 2048
DEPTH = 2

PLE_DIM = 256
N_EVEN = (DEPTH + 1) // 2
N_ODD = DEPTH // 2
EPS = 1e-6

ML_HEADS = 4
ML_QK_DIM = 128
ML_V_DIM = 256
ML_QK = ML_HEADS * ML_QK_DIM
ML_WIDTH = ML_HEADS * ML_V_DIM
ML_CHUNK = 128
CONV_WIDTH = 4

DA_HEADS = 4
DA_QK_DIM = 128
DA_V_DIM = 2 * DA_QK_DIM
DA_QK = DA_HEADS * 2 * DA_QK_DIM
DA_WIDTH = DA_HEADS * DA_V_DIM
Q_BLOCK = 128
ROPE_THETA = 10000.0

AB_SPLITS = (ML_QK, ML_QK, ML_WIDTH, ML_HEADS, ML_HEADS, ML_WIDTH, ML_WIDTH,
             DA_QK, DA_QK, DA_WIDTH, DA_WIDTH)
AB_COLS = sum(AB_SPLITS)
AB_OUT = ML_WIDTH + DA_WIDTH

SGU_WIDTH = D_MODEL
SGU_CHUNK = 128
SGU_GROUPS = 8
SGU_GROUP_DIM = SGU_WIDTH // SGU_GROUPS

kernel_name = "hybrid_mlstm_diffattn_sgu_decoder"


def rms_norm(x, g):
    xf = x.astype(jnp.float32)
    y = xf * lax.rsqrt(jnp.mean(xf * xf, axis=-1, keepdims=True) + EPS)
    return (y * g.astype(jnp.float32)).astype(x.dtype)


def layer_norm(x, g, b):
    xf = x.astype(jnp.float32)
    mu = jnp.mean(xf, axis=-1, keepdims=True)
    var = jnp.mean(jnp.square(xf - mu), axis=-1, keepdims=True)
    y = (xf - mu) * lax.rsqrt(var + EPS)
    return (y * g.astype(jnp.float32) + b.astype(jnp.float32)).astype(x.dtype)


def split_cols(h, sizes):
    idx = [int(c) for c in np.cumsum(sizes)[:-1]]
    return jnp.split(h, idx, axis=-1)


def rope(x, positions):
    dh = x.shape[-1]
    half = dh // 2
    freq = ROPE_THETA ** (-jnp.arange(half, dtype=jnp.float32) / half)
    ang = positions.astype(jnp.float32)[..., None] * freq
    ang = ang.reshape(ang.shape[:2] + (1,) * (x.ndim - 3) + (half,))
    cos, sin = jnp.cos(ang), jnp.sin(ang)
    x1 = x[..., :half].astype(jnp.float32)
    x2 = x[..., half:].astype(jnp.float32)
    return jnp.concatenate([x1 * cos - x2 * sin, x1 * sin + x2 * cos], axis=-1).astype(x.dtype)


def causal_depthwise_conv(x, w, b):
    C = x.shape[-1]
    y = lax.conv_general_dilated(
        x, w[:, None, :].astype(x.dtype), window_strides=(1,),
        padding=[(CONV_WIDTH - 1, 0)], dimension_numbers=("NWC", "WIO", "NWC"),
        feature_group_count=C)
    return y + b.astype(x.dtype)


def mlstm_chunkwise(q, k, v, i_pre, f_pre):
    B, S, H, dk = q.shape
    dv = v.shape[-1]
    L = ML_CHUNK
    nc = S // L
    q = q.reshape(B, nc, L, H, dk).transpose(0, 1, 3, 2, 4)
    k = k.reshape(B, nc, L, H, dk).transpose(0, 1, 3, 2, 4) * (dk ** -0.5)
    v = v.reshape(B, nc, L, H, dv).transpose(0, 1, 3, 2, 4)
    log_i = i_pre.reshape(B, nc, L, H).transpose(0, 1, 3, 2)
    log_f = jax.nn.log_sigmoid(f_pre).reshape(B, nc, L, H).transpose(0, 1, 3, 2)
    b = jnp.cumsum(log_f, axis=-1)
    g = b[..., -1]

    w = g[..., None] - b + log_i
    m_loc = jnp.max(w, axis=-1)
    e = jnp.exp(w - m_loc[..., None])
    C_loc = jnp.einsum('bchl,bchld,bchle->bchde', e, v, k)
    n_loc = jnp.einsum('bchl,bchle->bche', e, k)

    def step(carry, xs):
        C, n, m = carry
        C_l, n_l, m_l, g_c = xs
        m_new = jnp.maximum(g_c + m, m_l)
        a = jnp.exp(g_c + m - m_new)
        c = jnp.exp(m_l - m_new)
        C_new = a[..., None, None] * C + c[..., None, None] * C_l
        n_new = a[..., None] * n + c[..., None] * n_l
        return (C_new, n_new, m_new), (C, n, m)

    init = (jnp.zeros((B, H, dv, dk), jnp.float32),
            jnp.zeros((B, H, dk), jnp.float32),
            jnp.zeros((B, H), jnp.float32))
    xs = (jnp.moveaxis(C_loc, 1, 0), jnp.moveaxis(n_loc, 1, 0),
          jnp.moveaxis(m_loc, 1, 0), jnp.moveaxis(g, 1, 0))
    _, (C_prev, n_prev, m_prev) = lax.scan(step, init, xs)
    C_prev = jnp.moveaxis(C_prev, 0, 1)
    n_prev = jnp.moveaxis(n_prev, 0, 1)
    m_prev = jnp.moveaxis(m_prev, 0, 1)

    causal = jnp.tril(jnp.ones((L, L), dtype=bool))
    logD = b[..., :, None] - b[..., None, :] + log_i[..., None, :]
    logD = jnp.where(causal, logD, -jnp.inf)
    inter_log = b + m_prev[..., None]
    m_t = jnp.maximum(inter_log, jnp.max(logD, axis=-1))
    Dmat = jnp.exp(logD - m_t[..., None])
    inter_w = jnp.exp(inter_log - m_t)

    s = jnp.einsum('bchtd,bchsd->bchts', q, k) * Dmat
    num = (jnp.einsum('bchts,bchsd->bchtd', s, v)
           + inter_w[..., None] * jnp.einsum('bchde,bchte->bchtd', C_prev, q))
    den = jnp.sum(s, axis=-1) + inter_w * jnp.einsum('bche,bchte->bcht', n_prev, q)
    h = num / jnp.maximum(jnp.abs(den), jnp.exp(-m_t))[..., None]
    return h.transpose(0, 1, 3, 2, 4).reshape(B, S, H, dv)


def diff_attention(q, k, v, lam):
    B, S, H, _, dh = q.shape
    dv = v.shape[-1]
    nb = S // Q_BLOCK
    qf = q.astype(jnp.float32) * (dh ** -0.5)
    kf = k.astype(jnp.float32)
    qb = qf.reshape(B, nb, Q_BLOCK, H, 2, dh).transpose(1, 0, 2, 3, 4, 5)
    k_pos = jnp.arange(S)

    def block(args):
        q_blk, blk = args
        s = jnp.einsum('bqhcd,bkhcd->bhcqk', q_blk, kf)
        q_pos = blk * Q_BLOCK + jnp.arange(Q_BLOCK)
        mask = k_pos[None, :] <= q_pos[:, None]
        pmap = jax.nn.softmax(jnp.where(mask, s, -jnp.inf), axis=-1)
        a = pmap[:, :, 0] - lam * pmap[:, :, 1]
        return jnp.einsum('bhqk,bkhe->bqhe', a.astype(v.dtype), v)

    o = lax.map(block, (qb, jnp.arange(nb)))
    return o.transpose(1, 0, 2, 3, 4).reshape(B, S, H, dv)


def mixer_ab(h, positions, w_in, conv_w, conv_b, i_bias, f_bias, ml_norm_g,
             lam_q1, lam_k1, lam_q2, lam_k2, da_norm_g, w_out, lam_init):
    B, S, _ = h.shape
    proj = h @ w_in
    (ml_q, ml_k, ml_v, ml_i, ml_f, ml_o, ml_z,
     da_q, da_k, da_v, da_z) = split_cols(proj, AB_SPLITS)

    qk = jax.nn.silu(causal_depthwise_conv(jnp.concatenate([ml_q, ml_k], axis=-1), conv_w, conv_b))
    ml_q, ml_k = jnp.split(qk, 2, axis=-1)
    f32 = jnp.float32
    hm = mlstm_chunkwise(
        ml_q.reshape(B, S, ML_HEADS, ML_QK_DIM).astype(f32),
        ml_k.reshape(B, S, ML_HEADS, ML_QK_DIM).astype(f32),
        ml_v.reshape(B, S, ML_HEADS, ML_V_DIM).astype(f32),
        (ml_i + i_bias).astype(f32),
        (ml_f + f_bias).astype(f32))
    hm = rms_norm(hm, ml_norm_g).astype(h.dtype)
    hm = jax.nn.sigmoid(ml_o).reshape(B, S, ML_HEADS, ML_V_DIM) * hm
    a_out = hm.reshape(B, S, ML_WIDTH) * jax.nn.silu(ml_z)

    lam = (jnp.exp(jnp.sum(lam_q1.astype(f32) * lam_k1.astype(f32)))
           - jnp.exp(jnp.sum(lam_q2.astype(f32) * lam_k2.astype(f32))) + lam_init)
    dq = rope(da_q.reshape(B, S, DA_HEADS, 2, DA_QK_DIM), positions)
    dk = rope(da_k.reshape(B, S, DA_HEADS, 2, DA_QK_DIM), positions)
    dvv = da_v.reshape(B, S, DA_HEADS, DA_V_DIM)
    hd = diff_attention(dq, dk, dvv, lam)
    hd = rms_norm(hd, da_norm_g) * (1.0 - lam_init)
    b_out = hd.reshape(B, S, DA_WIDTH) * jax.nn.silu(da_z)

    return jnp.concatenate([a_out, b_out], axis=-1) @ w_out


def mixer_c(h, w_in, ln_g, ln_b, sgu_w, sgu_b, w_out):
    B, S, _ = h.shape
    u, v, z = jnp.split(h @ w_in, 3, axis=-1)
    v = layer_norm(v, ln_g, ln_b)
    nc = S // SGU_CHUNK
    vg = v.reshape(B, nc, SGU_CHUNK, SGU_GROUPS, SGU_GROUP_DIM)
    w_causal = jnp.tril(sgu_w)
    sv = jnp.einsum('gts,bcsgd->bctgd', w_causal, vg) + sgu_b.T[:, :, None]
    sv = sv.reshape(B, S, SGU_WIDTH)
    return (u * sv * jax.nn.silu(z)) @ w_out


def setup_inputs(seed: int = 0) -> dict:
    key = jax.random.key(seed)
    ks = jax.random.split(key, 32)
    nrm = jax.random.normal
    f32 = jnp.float32
    D = D_MODEL
    NE, NO = N_EVEN, N_ODD
    return {
        "x": nrm(ks[0], (BATCH, SEQ, D), f32),
        "p": nrm(ks[1], (DEPTH, BATCH, SEQ, PLE_DIM), f32),
        "positions": jnp.broadcast_to(jnp.arange(SEQ, dtype=jnp.int32)[None, :], (BATCH, SEQ)),
        "ab_norm_g": 1.0 + 0.01 * nrm(ks[2], (NE, D), f32),
        "ab_w_in": nrm(ks[3], (NE, D, AB_COLS), f32) * D ** -0.5,
        "ab_conv_w": nrm(ks[4], (NE, CONV_WIDTH, 2 * ML_QK), f32) * CONV_WIDTH ** -0.5,
        "ab_conv_b": 0.01 * nrm(ks[5], (NE, 2 * ML_QK), f32),
        "ab_i_bias": 0.1 * nrm(ks[6], (NE, ML_HEADS), f32) - 1.0,
        "ab_f_bias": 3.0 + 0.5 * nrm(ks[7], (NE, ML_HEADS), f32),
        "ab_ml_norm_g": 1.0 + 0.01 * nrm(ks[8], (NE, ML_HEADS, ML_V_DIM), f32),
        "ab_lam_q1": 0.1 * nrm(ks[9], (NE, DA_QK_DIM), f32),
        "ab_lam_k1": 0.1 * nrm(ks[10], (NE, DA_QK_DIM), f32),
        "ab_lam_q2": 0.1 * nrm(ks[11], (NE, DA_QK_DIM), f32),
        "ab_lam_k2": 0.1 * nrm(ks[12], (NE, DA_QK_DIM), f32),
        "ab_da_norm_g": 1.0 + 0.01 * nrm(ks[13], (NE, DA_HEADS, DA_V_DIM), f32),
        "ab_w_out": nrm(ks[14], (NE, AB_OUT, D), f32) * AB_OUT ** -0.5,
        "c_norm_g": 1.0 + 0.01 * nrm(ks[15], (NO, D), f32),
        "c_w_in": nrm(ks[16], (NO, D, 3 * SGU_WIDTH), f32) * D ** -0.5,
        "c_ln_g": 1.0 + 0.01 * nrm(ks[17], (NO, SGU_WIDTH), f32),
        "c_ln_b": 0.01 * nrm(ks[18], (NO, SGU_WIDTH), f32),
        "c_sgu_w": nrm(ks[19], (NO, SGU_GROUPS, SGU_CHUNK, SGU_CHUNK), f32) * SGU_CHUNK ** -0.5,
        "c_sgu_b": 1.0 + 0.01 * nrm(ks[20], (NO, SGU_GROUPS, SGU_CHUNK), f32),
        "c_w_out": nrm(ks[21], (NO, SGU_WIDTH, D), f32) * SGU_WIDTH ** -0.5,
        "ple_norm_g": 1.0 + 0.01 * nrm(ks[22], (DEPTH, D), f32),
        "ple_gate_w": nrm(ks[23], (DEPTH, D, D), f32) * D ** -0.5,
        "ple_proj_w": nrm(ks[24], (DEPTH, PLE_DIM, D), f32) * PLE_DIM ** -0.5,
        "final_norm_g": 1.0 + 0.01 * nrm(ks[25], (D,), f32),
    }


def reference(x, p, positions, ab_norm_g, ab_w_in, ab_conv_w, ab_conv_b, ab_i_bias,
              ab_f_bias, ab_ml_norm_g, ab_lam_q1, ab_lam_k1, ab_lam_q2, ab_lam_k2,
              ab_da_norm_g, ab_w_out, c_norm_g, c_w_in, c_ln_g, c_ln_b, c_sgu_w,
              c_sgu_b, c_w_out, ple_norm_g, ple_gate_w, ple_proj_w, final_norm_g):
    for i in range(DEPTH):
        j = i // 2
        if i % 2 == 0:
            lam_init = 0.8 - 0.6 * math.exp(-0.3 * i)
            x = x + mixer_ab(rms_norm(x, ab_norm_g[j]), positions, ab_w_in[j],
                             ab_conv_w[j], ab_conv_b[j], ab_i_bias[j], ab_f_bias[j],
                             ab_ml_norm_g[j], ab_lam_q1[j], ab_lam_k1[j], ab_lam_q2[j],
                             ab_lam_k2[j], ab_da_norm_g[j], ab_w_out[j], lam_init)
        else:
            x = x + mixer_c(rms_norm(x, c_norm_g[j]), c_w_in[j], c_ln_g[j], c_ln_b[j],
                            c_sgu_w[j], c_sgu_b[j], c_w_out[j])
        gate = jax.nn.sigmoid(rms_norm(x, ple_norm_g[i]) @ ple_gate_w[i])
        x = x + gate * (p[i] @ ple_proj_w[i])
    return rms_norm(x, final_norm_g)
```

```cpp
#include <hip/hip_runtime.h>
#include <hip/hip_bf16.h>
#include <hip/hip_cooperative_groups.h>
#include <cstdio>
#include <cstdint>
namespace cg = cooperative_groups;
__device__ __forceinline__ int mk_tid() { int t = (int)threadIdx.x; asm volatile("" : "+v"(t)); return t; }
namespace pg8 {
#define PG8_LAS __attribute__((address_space(3)))
typedef unsigned short bf16_t;
typedef short bf16x8 __attribute__((ext_vector_type(8)));
typedef float f32x4 __attribute__((ext_vector_type(4)));
typedef unsigned u32x4 __attribute__((ext_vector_type(4)));
constexpr int BM = 256, BK = 64, HALF = 128, HTB = HALF * BK * 2  , STAGE_BYTES = 8 * HTB, NXCD = 8, WGM = 8;

__host__ __device__ __forceinline__ int lds_byte(int r, int c) { const int st = (r >> 4) * 2 + (c >> 5), rr = r & 15, cc = c & 31, ob = rr * 64 + cc * 2; return st * 1024 + (ob ^ (((ob >> 9) & 1) << 5)); }
__host__ __device__ __forceinline__ void stage_rc(int b, int& R, int& C) { const int st = b / 1024, sb = b % 1024, swz = sb ^ (((sb >> 9) & 1) << 5); R = (st >> 1) * 16 + swz / 64; C = (st & 1) * 32 + (swz % 64) / 2; }
__host__ __device__ __forceinline__ int perm32(int rho) { const int n = rho >> 4, i = rho & 15; return 8 * (i >> 2) + 4 * n + (i & 3); }

struct Unit { int pm, pn; };
struct Gemm { const bf16_t* A; const bf16_t* Bt; int M, N, K; };

struct StaticOrder {
    int nM, nN, nwg, G, c;
    __host__ __device__ void init(int M, int N, int G_, int c_) { nM = M / BM; nN = N / BM; nwg = nM * nN; G = G_; c = c_; }
    __host__ __device__ bool next(int i, Unit& u) const {
        const long L = (long)i * G + c; if (L >= nwg) return false;
        int wgid = (int)L; { const int q = nwg / NXCD, r = nwg % NXCD, xcd = wgid % NXCD, off = wgid / NXCD; wgid = (xcd < r ? xcd * (q + 1) : r * (q + 1) + (xcd - r) * q) + off; }
        const int nig = WGM * nN, gid = wgid / nig, fm = gid * WGM, gsz = (nM - fm) < WGM ? (nM - fm) : WGM;
        u.pm = fm + ((wgid % nig) % gsz); u.pn = (wgid % nig) / gsz; return true;
    }
    __device__ __forceinline__ void a_ready(const Unit&) const {}
    __device__ __forceinline__ void done(const Unit&) const {}
};

__device__ __forceinline__ unsigned cvt_pk_bf16(float lo, float hi) { unsigned r; asm volatile("v_cvt_pk_bf16_f32 %0, %1, %2" : "=v"(r) : "v"(lo), "v"(hi)); return r; }
typedef float f32x2 __attribute__((ext_vector_type(2)));
__device__ __forceinline__ f32x2 gelu_pk(f32x2 v) {
    const f32x2 av = __builtin_elementwise_abs(v), d = av * 0.2316418882f + 1.0f;
    f32x2 t; t.x = __builtin_amdgcn_rcpf(d.x); t.y = __builtin_amdgcn_rcpf(d.y);
    f32x2 q = t * 0.5307027145f + (-0.7265760135f); q = q * t + 0.7107068705f; q = q * t + (-0.142248368f); q = q * t + 0.127414796f; q = q * t;
    const f32x2 s = (v * v) * (-0.72134752044f);
    f32x2 e; e.x = __builtin_amdgcn_exp2f(s.x); e.y = __builtin_amdgcn_exp2f(s.y);
    const f32x2 m = v * (q * e), r = v - m;
    f32x2 o; o.x = v.x < 0.f ? m.x : r.x; o.y = v.y < 0.f ? m.y : r.y; return o;
}

template <int ACT  > struct EpiBf16 {
    static constexpr bool PERM = true, AFTER_DRAIN = false; static_assert(ACT == 0 || ACT == 1, "EpiBf16: ACT is 0 (none) or 1 (gelu_pk)");
    bf16_t* O; int ldc; const float* bias; int split_cols; size_t split_stride; float scale0;
    __device__ __forceinline__ void operator()(const f32x4 (&acc)[2][2][4][2], const Unit& u, int wr, int wc, int fr, int fq) const {
        const int row0 = u.pm * BM + wr * 64 + fr; int colt = u.pn * BM; bf16_t* base = O;
        float sc = 1.f; if (split_cols) { const int t = colt / split_cols; base += (size_t)t * split_stride; colt -= t * split_cols; if (t == 0) sc = scale0; }
        const int col0 = colt + wc * 32 + 8 * fq, bcol0 = u.pn * BM + wc * 32 + 8 * fq;
        f32x4 bv[2][2];
#pragma unroll
        for (int bj = 0; bj < 2; ++bj)
#pragma unroll
            for (int n = 0; n < 2; ++n) bv[bj][n] = bias ? *(const f32x4*)(bias + bcol0 + bj * HALF + 4 * n) : (f32x4){0.f, 0.f, 0.f, 0.f};
#pragma unroll
        for (int ai = 0; ai < 2; ++ai)
#pragma unroll
            for (int m = 0; m < 4; ++m) { bf16_t* rowp = base + (size_t)(row0 + ai * HALF + m * 16) * ldc + col0;
#pragma unroll
                for (int bj = 0; bj < 2; ++bj) { f32x4 v0 = acc[ai][bj][m][0] + bv[bj][0], v1 = acc[ai][bj][m][1] + bv[bj][1];
                    if (ACT == 1) { f32x2 a = gelu_pk((f32x2){v0[0], v0[1]}), b = gelu_pk((f32x2){v0[2], v0[3]}), c = gelu_pk((f32x2){v1[0], v1[1]}), d = gelu_pk((f32x2){v1[2], v1[3]});
                        v0 = (f32x4){a.x, a.y, b.x, b.y}; v1 = (f32x4){c.x, c.y, d.x, d.y}; }
                    v0 = v0 * sc; v1 = v1 * sc; u32x4 w; w.x = cvt_pk_bf16(v0[0], v0[1]); w.y = cvt_pk_bf16(v0[2], v0[3]); w.z = cvt_pk_bf16(v1[0], v1[1]); w.w = cvt_pk_bf16(v1[2], v1[3]);
                    *(u32x4*)(rowp + bj * HALF) = w; } }
    }
};

template <class Epi, class Sched, bool ALIGN_EPI = false, bool SP2 = false>
__device__ __forceinline__ void gemm_phase(PG8_LAS unsigned char* lds, const Gemm g, const Sched& S, const Epi& E) {
    const int tid = mk_tid(), wid = __builtin_amdgcn_readfirstlane(tid >> 6), lane = tid & 63, wr = wid >> 2, wc = wid & 3, fr = lane & 15, fq = lane >> 4;
    const int K = g.K, nt = K / BK;
    unsigned voffA[2], voffB[2];
#pragma unroll
    for (int i = 0; i < 2; ++i) { int R, C; stage_rc(tid * 16 + i * 8192, R, C); const int Rb = Epi::PERM ? ((R & ~31) + perm32(R & 31)) : R;
        voffA[i] = (unsigned)(R * K + C) * 2u; voffB[i] = (unsigned)(Rb * K + C) * 2u; }
    const size_t kstep = (size_t)(BK * 2);
    const size_t hstep = (size_t)HALF * K * 2;
    const size_t tstep = 2 * hstep;
    const unsigned ldsw = (unsigned)wid * 1024u;
    const int aoff = lds_byte(wr * 64 + fr, fq * 8), boff = lds_byte(wc * 32 + fr, fq * 8);
#define PG8_SA(b, h) (((b) * 2 + (h)) * HTB)
#define PG8_SB(b, h) ((4 + (b) * 2 + (h)) * HTB)
#define PG8_STAGE(bufoff, gbase, voff) do { _Pragma("unroll") for (int _i = 0; _i < 2; ++_i) \
        __builtin_amdgcn_global_load_lds((const unsigned*)((const char*)(gbase) + (voff)[_i]), (PG8_LAS unsigned*)(lds + (bufoff) + ldsw + _i * 8192), 16, 0, 0); } while (0)
#define PG8_LDA(dst, b, h) do { _Pragma("unroll") for (int m = 0; m < 4; ++m) _Pragma("unroll") for (int k = 0; k < 2; ++k) dst[m][k] = *(const PG8_LAS bf16x8*)(lds + PG8_SA(b, h) + aoff + m * 2048 + k * 1024); } while (0)
#define PG8_LDB(dst, b, h) do { _Pragma("unroll") for (int n = 0; n < 2; ++n) _Pragma("unroll") for (int k = 0; k < 2; ++k) dst[n][k] = *(const PG8_LAS bf16x8*)(lds + PG8_SB(b, h) + boff + n * 2048 + k * 1024); } while (0)
#define PG8_MMA(ai, bj, At, Bt) do { __builtin_amdgcn_s_setprio(1); _Pragma("unroll") for (int m = 0; m < 4; ++m) _Pragma("unroll") for (int n = 0; n < 2; ++n) _Pragma("unroll") for (int k = 0; k < 2; ++k) \
        acc[ai][bj][m][n] = __builtin_amdgcn_mfma_f32_16x16x32_bf16(Bt[n][k], At[m][k], acc[ai][bj][m][n], 0, 0, 0); __builtin_amdgcn_s_setprio(0); } while (0)
#define PG8_WAIT_V(n) asm volatile("s_waitcnt vmcnt(" #n ")" ::: "memory")
#define PG8_WAIT_L(n) asm volatile("s_waitcnt lgkmcnt(" #n ")" ::: "memory")
#define PG8_BAR __builtin_amdgcn_s_barrier()
#define PG8_SCHED __builtin_amdgcn_sched_barrier(0)
    Unit cur, nxt; int ui = 0;
    if (!S.next(0, cur)) return;
    f32x4 acc[2][2][4][2];
#pragma unroll
    for (int a = 0; a < 2; ++a)
#pragma unroll
        for (int b = 0; b < 2; ++b)
#pragma unroll
            for (int m = 0; m < 4; ++m)
#pragma unroll
                for (int n = 0; n < 2; ++n) acc[a][b][m][n] = (f32x4){0.f, 0.f, 0.f, 0.f};
    bf16x8 At[4][2], B0[2][2], B1[2][2];
    const char* cA = (const char*)g.A + (size_t)cur.pm * tstep; const char* cB = (const char*)g.Bt + (size_t)cur.pn * tstep;
    S.a_ready(cur);
    if constexpr (SP2) {
        PG8_STAGE(PG8_SB(0, 0), cB, voffB); PG8_STAGE(PG8_SB(0, 1), cB + hstep, voffB); PG8_STAGE(PG8_SA(0, 0), cA, voffA); PG8_STAGE(PG8_SA(0, 1), cA + hstep, voffA);
        if (wr == 1) PG8_BAR;
        PG8_WAIT_V(2); PG8_BAR;
        PG8_STAGE(PG8_SB(1, 0), cB + kstep, voffB); PG8_STAGE(PG8_SA(1, 0), cA + kstep, voffA); PG8_STAGE(PG8_SB(1, 1), cB + hstep + kstep, voffB);
        PG8_WAIT_V(6); PG8_BAR;
    } else {
        PG8_STAGE(PG8_SB(0, 0), cB, voffB); PG8_STAGE(PG8_SA(0, 0), cA, voffA); PG8_STAGE(PG8_SB(0, 1), cB + hstep, voffB); PG8_STAGE(PG8_SA(0, 1), cA + hstep, voffA);
        if (wr == 1) PG8_BAR;
        PG8_WAIT_V(4); PG8_BAR;
        PG8_STAGE(PG8_SB(1, 0), cB + kstep, voffB); PG8_STAGE(PG8_SA(1, 0), cA + kstep, voffA); PG8_STAGE(PG8_SB(1, 1), cB + hstep + kstep, voffB);
        PG8_WAIT_V(6); PG8_BAR;
    }
    for (;;) {
        const bool has_next = S.next(ui + 1, nxt);
        const char* nA = has_next ? (const char*)g.A + (size_t)nxt.pm * tstep : cA; const char* nB = has_next ? (const char*)g.Bt + (size_t)nxt.pn * tstep : cB;
        for (int t = 0; t < nt; t += 2) {
            const bool last = (t == nt - 2);
            const char* a1 = cA + (size_t)(t + 1) * kstep;
            const char* a2 = last ? nA : cA + (size_t)(t + 2) * kstep; const char* b2 = last ? nB : cB + (size_t)(t + 2) * kstep;
            const char* a3 = a2 + kstep; const char* b3 = b2 + kstep;
            if (last && has_next) S.a_ready(nxt);
            if constexpr (SP2) {
            PG8_LDB(B0, 0, 0); PG8_LDB(B1, 0, 1); PG8_SCHED; PG8_LDA(At, 0, 0); PG8_STAGE(PG8_SA(1, 1), a1 + hstep, voffA);
            PG8_WAIT_V(8); PG8_WAIT_L(0); PG8_BAR; PG8_MMA(0, 0, At, B0); PG8_MMA(0, 1, At, B1); PG8_BAR; PG8_SCHED;
            PG8_LDA(At, 0, 1); PG8_STAGE(PG8_SB(0, 0), b2, voffB); PG8_STAGE(PG8_SB(0, 1), b2 + hstep, voffB); PG8_STAGE(PG8_SA(0, 0), a2, voffA);
            PG8_WAIT_V(8); PG8_WAIT_L(0); PG8_BAR; PG8_MMA(1, 0, At, B0); PG8_MMA(1, 1, At, B1); PG8_BAR; PG8_SCHED;
            PG8_LDB(B0, 1, 0); PG8_LDB(B1, 1, 1); PG8_SCHED; PG8_LDA(At, 1, 0); PG8_STAGE(PG8_SA(0, 1), a2 + hstep, voffA);
            PG8_WAIT_V(8); PG8_WAIT_L(0); PG8_BAR; PG8_MMA(0, 0, At, B0); PG8_MMA(0, 1, At, B1); PG8_BAR; PG8_SCHED;
            PG8_LDA(At, 1, 1); PG8_STAGE(PG8_SB(1, 0), b3, voffB); PG8_STAGE(PG8_SB(1, 1), b3 + hstep, voffB); PG8_STAGE(PG8_SA(1, 0), a3, voffA);
            PG8_WAIT_V(8); PG8_WAIT_L(0); PG8_BAR; PG8_MMA(1, 0, At, B0); PG8_MMA(1, 1, At, B1); PG8_BAR; PG8_SCHED;
            } else {
            PG8_LDB(B0, 0, 0); PG8_SCHED; PG8_LDA(At, 0, 0); PG8_STAGE(PG8_SA(1, 1), a1 + hstep, voffA);
            PG8_WAIT_L(8); PG8_BAR; PG8_WAIT_L(0); PG8_MMA(0, 0, At, B0); PG8_BAR; PG8_SCHED;
            PG8_LDB(B1, 0, 1); PG8_STAGE(PG8_SB(0, 0), b2, voffB);
            PG8_BAR; PG8_WAIT_L(0); PG8_MMA(0, 1, At, B1); PG8_BAR;
            PG8_LDA(At, 0, 1); PG8_STAGE(PG8_SA(0, 0), a2, voffA);
            PG8_BAR; PG8_WAIT_L(0); PG8_MMA(1, 0, At, B0); PG8_BAR; PG8_SCHED;
            PG8_STAGE(PG8_SB(0, 1), b2 + hstep, voffB);
            PG8_WAIT_V(6); PG8_BAR; PG8_MMA(1, 1, At, B1); PG8_BAR;
            PG8_LDB(B0, 1, 0); PG8_SCHED; PG8_LDA(At, 1, 0); PG8_STAGE(PG8_SA(0, 1), a2 + hstep, voffA);
            PG8_WAIT_L(8); PG8_BAR; PG8_WAIT_L(0); PG8_MMA(0, 0, At, B0); PG8_BAR; PG8_SCHED;
            PG8_LDB(B1, 1, 1); PG8_STAGE(PG8_SB(1, 0), b3, voffB);
            PG8_BAR; PG8_WAIT_L(0); PG8_MMA(0, 1, At, B1); PG8_BAR;
            PG8_LDA(At, 1, 1); PG8_STAGE(PG8_SA(1, 0), a3, voffA);
            PG8_BAR; PG8_WAIT_L(0); PG8_MMA(1, 0, At, B0); PG8_BAR; PG8_SCHED;
            PG8_STAGE(PG8_SB(1, 1), b3 + hstep, voffB);
            PG8_WAIT_V(6); PG8_BAR; PG8_MMA(1, 1, At, B1); PG8_BAR;
            }
        }
        if constexpr (ALIGN_EPI) { if (wr == 0) PG8_BAR; }
        if constexpr (!Epi::AFTER_DRAIN) { E(acc, cur, wr, wc, fr, fq); S.done(cur); }
        if (!has_next) break;
#pragma unroll
        for (int a = 0; a < 2; ++a)
#pragma unroll
            for (int b = 0; b < 2; ++b)
#pragma unroll
                for (int m = 0; m < 4; ++m)
#pragma unroll
                    for (int n = 0; n < 2; ++n) acc[a][b][m][n] = (f32x4){0.f, 0.f, 0.f, 0.f};
        cur = nxt; cA = nA; cB = nB; ++ui;
        if constexpr (ALIGN_EPI) { if (wr == 1) PG8_BAR; }
    }
    PG8_WAIT_V(0);
    if constexpr (!ALIGN_EPI) { if (wr == 0) PG8_BAR; }
    PG8_BAR;
    if constexpr (Epi::AFTER_DRAIN) { E.fused(acc, cur, wr, wc, fr, fq, lds, wid, lane); S.done(cur); }
#undef PG8_SA
#undef PG8_SB
#undef PG8_STAGE
#undef PG8_LDA
#undef PG8_LDB
#undef PG8_MMA
#undef PG8_WAIT_V
#undef PG8_WAIT_L
#undef PG8_BAR
#undef PG8_SCHED
}
}

namespace att {
constexpr int D = 128;
constexpr float THR = 8.f;
constexpr bool WSKIP = false;
constexpr float SCALE = 0.08838834764831845f;
constexpr int NW = 8, QBLK = 32, KVBLK = 64, QB = NW * QBLK;
constexpr int SHM_V = KVBLK * D * 2, SHM_K = KVBLK * D * 2;
constexpr int LDS_BYTES = 2 * SHM_V + 2 * SHM_K + NW * 64 * 4;

using bf16 = __hip_bfloat16;
typedef short bf16x8 __attribute__((ext_vector_type(8)));
typedef short s16x4 __attribute__((ext_vector_type(4)));
typedef float f32x16 __attribute__((ext_vector_type(16)));
typedef float f32x4 __attribute__((ext_vector_type(4)));
typedef unsigned u32x4 __attribute__((ext_vector_type(4)));
template <class A, class Bt> struct same_t { static constexpr bool v = false; };
template <class A> struct same_t<A, A> { static constexpr bool v = true; };

#define KSWZ(row, colB) ((row) * 256 + ((colB) ^ (((row) & 7) << 4)))
#define SBAR() __builtin_amdgcn_sched_barrier(0)
__device__ __forceinline__ int v_st(int k, int c) { const int kk = (k & ~0xC) | ((k & 4) << 1) | ((k & 8) >> 1); return ((kk >> 3) * 4 + (c >> 5)) * 512 + ((kk & 7) * 32 + (c & 31)) * 2; }
__device__ __forceinline__ int v_rd_base(int lane) { return ((lane & 3) << 3) | (((lane >> 2) & 3) << 6) | (((lane >> 4) & 1) << 5) | (((lane >> 5) & 1) << 8); }
constexpr int v_rd_off(int d0, int ks, int half) { return d0 * 512 + ks * 4096 + half * 2048; }
__device__ __forceinline__ int crow(int r, int hi) { return (r & 3) + 8 * (r >> 2) + 4 * hi; }
__device__ __forceinline__ unsigned cvtpk(float lo, float hi) {
    unsigned r; asm volatile("v_cvt_pk_bf16_f32 %0, %1, %2" : "=v"(r) : "v"(lo), "v"(hi)); return r;
}
__device__ __forceinline__ bf16x8 pack8(f32x4 a, f32x4 b) {
    u32x4 w = {cvtpk(a[0], a[1]), cvtpk(a[2], a[3]), cvtpk(b[0], b[1]), cvtpk(b[2], b[3])};
    return *reinterpret_cast<bf16x8*>(&w);
}
template <class T> __device__ __forceinline__ bf16x8 load8(const T* p) {
    if constexpr (same_t<T, float>::v) { return pack8(*(const f32x4*)p, *(const f32x4*)(p + 4)); }
    else { return *reinterpret_cast<const bf16x8*>(p); }
}
__device__ __forceinline__ void mask_tile(f32x16& p0, f32x16& p1, int dq, unsigned W) {
    const float NEG = -__builtin_inff();
#pragma unroll
    for (int r = 0; r < 16; ++r) {
        const int c = (r & 3) + 8 * (r >> 2);
        if ((unsigned)(dq - c) >= W) p0[r] = NEG;
        if ((unsigned)(dq - c - 32) >= W) p1[r] = NEG;
    }
}
__device__ __forceinline__ void partialSM(f32x16& p0, f32x16& p1, float& m_reg, float& mn, float& alpha) {
    float pmax = p0[0]; for (int r = 1; r < 16; ++r) pmax = fmaxf(pmax, p0[r]); for (int r = 0; r < 16; ++r) pmax = fmaxf(pmax, p1[r]);
    { auto rr = __builtin_amdgcn_permlane32_swap(__float_as_uint(pmax), __float_as_uint(pmax), false, false);
      pmax = fmaxf(__uint_as_float(rr[0]), __uint_as_float(rr[1])); }
    constexpr float C2 = 1.4426950408889634f * SCALE;
    if (__builtin_expect(__all((pmax - m_reg) * SCALE <= THR), 1)) { mn = m_reg; alpha = 1.f; }
    else { mn = fmaxf(m_reg, pmax); alpha = __builtin_amdgcn_exp2f((m_reg - mn) * C2); m_reg = mn; }
    const float mnL = -mn * C2;
    for (int r = 0; r < 16; ++r) p0[r] = fmaf(p0[r], C2, mnL); for (int r = 0; r < 16; ++r) p1[r] = fmaf(p1[r], C2, mnL);
    for (int r = 0; r < 16; ++r) p0[r] = __builtin_amdgcn_exp2f(p0[r]);
}
__device__ __forceinline__ void finishSM(f32x16& p0, f32x16& p1, float alpha, float& l_reg, bf16x8& pa0, bf16x8& pa1, bf16x8& pa2, bf16x8& pa3) {
    for (int r = 0; r < 16; ++r) p1[r] = __builtin_amdgcn_exp2f(p1[r]);
    float ps = 0; for (int r = 0; r < 16; ++r) ps += p0[r]; for (int r = 0; r < 16; ++r) ps += p1[r];
    { auto rr = __builtin_amdgcn_permlane32_swap(__float_as_uint(ps), __float_as_uint(ps), false, false);
      ps = __uint_as_float(rr[0]) + __uint_as_float(rr[1]); }
    l_reg = l_reg * alpha + ps;
#define PK4(P, B_, OUT) do { unsigned a0 = cvtpk(P[B_+0], P[B_+1]), a1 = cvtpk(P[B_+2], P[B_+3]);                          \
        unsigned b0 = cvtpk(P[B_+4], P[B_+5]), b1 = cvtpk(P[B_+6], P[B_+7]);                                             \
        auto r0 = __builtin_amdgcn_permlane32_swap(a0, b0, false, false); auto r1 = __builtin_amdgcn_permlane32_swap(a1, b1, false, false); \
        u32x4 w = {r0[0], r1[0], r0[1], r1[1]}; OUT = *reinterpret_cast<bf16x8*>(&w); } while (0)
    PK4(p0, 0, pa0); PK4(p0, 8, pa1); PK4(p1, 0, pa2); PK4(p1, 8, pa3);
#undef PK4
}
template <int KB, bool SK>
__device__ __forceinline__ void qkt(f32x16& p0, f32x16& p1, const char* K_lds, int r32, int hi, const bf16x8* qr, bool act) {
    if (SK && !act) { const float NEG = -__builtin_inff();
#pragma unroll
        for (int r = 0; r < 16; ++r) { p0[r] = NEG; p1[r] = NEG; } return; }
    p0 = f32x16{}; p1 = f32x16{};
    const char* kb[4];
#pragma unroll
    for (int dd = 0; dd < 4; ++dd) kb[dd] = K_lds + KB * SHM_K + KSWZ(r32, (dd * 16 + hi * 8) * 2);
#pragma unroll
    for (int d0 = 0; d0 < 8; ++d0) { const char* a = kb[d0 & 3] + (d0 >> 2) * 128;
        bf16x8 b0 = *reinterpret_cast<const bf16x8*>(a);
        bf16x8 b1 = *reinterpret_cast<const bf16x8*>(a + 32 * 256);
        p0 = __builtin_amdgcn_mfma_f32_32x32x16_bf16(b0, qr[d0], p0, 0, 0, 0);
        p1 = __builtin_amdgcn_mfma_f32_32x32x16_bf16(b1, qr[d0], p1, 0, 0, 0); }
}
template <int VB, bool SK>
__device__ __forceinline__ void pv_tile(f32x16* o, int vb0, bf16x8 pa0, bf16x8 pa1, bf16x8 pa2, bf16x8 pa3, bool act) {
    if (SK && !act) return;
#define TRRD(dst, off) asm volatile("ds_read_b64_tr_b16 %0, %1 offset:%2" : "=&v"(dst) : "v"(vb0), "i"(off) : "memory")
#define PV_D0(d0) do { s16x4 l0, l1, l2, l3, h0, h1, h2, h3; constexpr int b_ = VB * SHM_V + v_rd_off(d0, 0, 0);     \
        TRRD(l0, b_); TRRD(h0, b_ + 2048); TRRD(l1, b_ + 4096); TRRD(h1, b_ + 6144); TRRD(l2, b_ + 8192); TRRD(h2, b_ + 10240); TRRD(l3, b_ + 12288); TRRD(h3, b_ + 14336); \
        asm volatile("s_waitcnt lgkmcnt(0)" ::: "memory"); SBAR();                 \
        o[d0] = __builtin_amdgcn_mfma_f32_32x32x16_bf16(pa0, (bf16x8){l0[0], l0[1], l0[2], l0[3], h0[0], h0[1], h0[2], h0[3]}, o[d0], 0, 0, 0);   \
        o[d0] = __builtin_amdgcn_mfma_f32_32x32x16_bf16(pa1, (bf16x8){l1[0], l1[1], l1[2], l1[3], h1[0], h1[1], h1[2], h1[3]}, o[d0], 0, 0, 0);   \
        o[d0] = __builtin_amdgcn_mfma_f32_32x32x16_bf16(pa2, (bf16x8){l2[0], l2[1], l2[2], l2[3], h2[0], h2[1], h2[2], h2[3]}, o[d0], 0, 0, 0);   \
        o[d0] = __builtin_amdgcn_mfma_f32_32x32x16_bf16(pa3, (bf16x8){l3[0], l3[1], l3[2], l3[3], h3[0], h3[1], h3[2], h3[3]}, o[d0], 0, 0, 0); } while (0)
    PV_D0(0); PV_D0(1); PV_D0(2); PV_D0(3);
#undef PV_D0
#undef TRRD
}

template <class TIn, class TOut> struct BlockRef { const TIn* Q; const TIn* K; const TIn* V; TOut* O; int P0; };
template <class TIn> struct Seam {
    bf16x8 qr[8];
    bf16x8 st_v0, st_v1, st_k0, st_k1; f32x4 sf0, sf1, sf2, sf3;
    f32x4 tq[16];
};
__device__ __forceinline__ int swa_jlo(int P0, int W) { const int lowk = P0 - W + 1; return lowk > 0 ? lowk / KVBLK : 0; }
#define ROW(p, k0, rr) ((p) + (size_t)((k0) + (rr)) * D + sc)
#define VMW() asm volatile("s_waitcnt vmcnt(0)" ::: "memory")
#define VMWN(n) asm volatile("s_waitcnt vmcnt(%0)" :: "i"(n) : "memory")
#define SLOAD_H(Kp, Vp, k0) do { S.st_v0 = load8<TIn>(ROW(Vp, k0, sr)); S.st_v1 = load8<TIn>(ROW(Vp, k0, 32 + sr));              \
                         S.st_k0 = load8<TIn>(ROW(Kp, k0, sr)); S.st_k1 = load8<TIn>(ROW(Kp, k0, 32 + sr)); } while (0)
#define SWRITE_HK(bf) do { *(bf16x8*)(K_lds + (bf) * SHM_K + kws) = S.st_k0; *(bf16x8*)(K_lds + (bf) * SHM_K + kws + 32 * 256) = S.st_k1; } while (0)
#define SWRITE_HV(bf) do { *(bf16x8*)(V_lds + (bf) * SHM_V + vst0) = S.st_v0; *(bf16x8*)(V_lds + (bf) * SHM_V + vst1) = S.st_v1; } while (0)
#define SWRITE_H(bf) do { SWRITE_HV(bf); SWRITE_HK(bf); } while (0)
#define SLOAD_F(p, k0) do { S.sf0 = *(const f32x4*)ROW(p, k0, sr); S.sf1 = *(const f32x4*)(ROW(p, k0, sr) + 4);                \
                            S.sf2 = *(const f32x4*)ROW(p, k0, 32 + sr); S.sf3 = *(const f32x4*)(ROW(p, k0, 32 + sr) + 4); } while (0)
#define SWRITE_KF(bf) do { *(bf16x8*)(K_lds + (bf) * SHM_K + kws) = pack8(S.sf0, S.sf1); *(bf16x8*)(K_lds + (bf) * SHM_K + kws + 32 * 256) = pack8(S.sf2, S.sf3); } while (0)
#define SWRITE_VF(bf) do { *(bf16x8*)(V_lds + (bf) * SHM_V + vst0) = pack8(S.sf0, S.sf1); *(bf16x8*)(V_lds + (bf) * SHM_V + vst1) = pack8(S.sf2, S.sf3); } while (0)
template <class TIn, class TOut>
__device__ __forceinline__ void causal_swa_prime(const BlockRef<TIn, TOut>& cur, int W, char* lds, Seam<TIn>& S) {
    constexpr bool F32 = same_t<TIn, float>::v;
    const int tid = mk_tid(), wid = __builtin_amdgcn_readfirstlane(tid >> 6), lane = tid & 63, r32 = lane & 31, hi = lane >> 5;
    const int sr = tid >> 4, sc = (tid & 15) * 8, kws = KSWZ(sr, sc * 2); char* K_lds = lds + 2 * SHM_V;
    const int kb0 = swa_jlo(cur.P0, W) * KVBLK;
    for (int d0 = 0; d0 < 8; ++d0) S.qr[d0] = load8<TIn>(cur.Q + (size_t)(wid * QBLK + r32) * D + d0 * 16 + hi * 8);
    if constexpr (F32) { SLOAD_F((const float*)cur.K, kb0); VMW(); SWRITE_KF(0); SBAR(); SLOAD_F((const float*)cur.V, kb0); }
    else { SLOAD_H(cur.K, cur.V, kb0); VMW(); SWRITE_HK(0); }
    __syncthreads();
}
template <class TIn, class TOut>
__device__ __forceinline__ void causal_swa_block(const BlockRef<TIn, TOut>& cur, const BlockRef<TIn, TOut>& nxt, int skv, int W, char* lds, Seam<TIn>& S) {
    constexpr bool F32 = same_t<TIn, float>::v;
    const int tid = mk_tid(), wid = __builtin_amdgcn_readfirstlane(tid >> 6), lane = tid & 63, r32 = lane & 31, hi = lane >> 5;
    const int j_lo = swa_jlo(cur.P0, W);
    int j_hi = (cur.P0 + QB - 1) / KVBLK + 1; if (j_hi > skv / KVBLK) j_hi = skv / KVBLK;
    const int NT = j_hi - j_lo;
    const int kbn = swa_jlo(nxt.P0, W) * KVBLK;
    const int qlo = cur.P0 + wid * QBLK, qm = qlo + r32 - 4 * hi;
    char* V_lds = lds; char* K_lds = lds + 2 * SHM_V;
    float* ws = (float*)(lds + 2 * SHM_V + 2 * SHM_K) + wid * 64; float* li_l = ws, * al_l = ws + 32;
    float m_reg = -1e30f, l_reg = 0; f32x16 o[4] = {};
    const int sr = tid >> 4, sc = (tid & 15) * 8, vst0 = v_st(sr, sc), vst1 = v_st(32 + sr, sc), kws = KSWZ(sr, sc * 2);
    const int vb0 = (int)(uintptr_t)V_lds + v_rd_base(lane);
    const TIn* Kh = cur.K; const TIn* Vh = cur.V;
#define RESC(a) do { if (__any((a) < 1.f)) { if (hi == 0) al_l[r32] = (a); asm volatile("s_waitcnt lgkmcnt(0)" ::: "memory");              \
                     for (int d_ = 0; d_ < 4; ++d_) for (int r = 0; r < 16; ++r) o[d_][r] *= al_l[crow(r, hi)]; } } while (0)
#define KBASE(t) ((j_lo + (t)) * KVBLK)
#define ACT(t) (KBASE(t) <= qlo + QBLK - 1 && KBASE(t) + KVBLK - 1 >= qlo - W + 1)
#define MASKT(P0_, P1_, t) do { const int kb_ = KBASE(t); if ((!SK || ACT(t)) && (kb_ + KVBLK - 1 > qlo || kb_ <= qlo + QBLK - 1 - W)) mask_tile(P0_, P1_, qm - kb_, (unsigned)W); } while (0)
    constexpr int NQL = F32 ? 16 : 8;
    constexpr bool SK = WSKIP && !F32;
#define SEAM_K0() do { VMWN(NQL); if constexpr (F32) { SWRITE_KF(0); SBAR(); SLOAD_F((const float*)nxt.V, kbn); } else { SWRITE_HK(0); } SBAR(); } while (0)
    f32x16 pA0, pA1, pB0, pB1; float mnA, mnB, alA, alB; bf16x8 pa0, pa1, pa2, pa3;
    if constexpr (F32) { VMW(); SWRITE_VF(0); SBAR(); } else { SWRITE_HV(0); SBAR(); }
    if (NT > 1) { if constexpr (F32) SLOAD_F((const float*)Kh, KBASE(1)); else SLOAD_H(Kh, Vh, KBASE(1)); }
    SBAR(); qkt<0, SK>(pA0, pA1, K_lds, r32, hi, S.qr, ACT(0));
    if constexpr (F32) { if (NT > 1) { VMW(); SWRITE_KF(1); SBAR(); SLOAD_F((const float*)Vh, KBASE(1)); } }
    MASKT(pA0, pA1, 0); partialSM(pA0, pA1, m_reg, mnA, alA);
    if (NT > 1) { VMW(); if constexpr (F32) { SWRITE_VF(1); SBAR(); if (NT > 2) SLOAD_F((const float*)Kh, KBASE(2)); } else SWRITE_H(1); }
    __syncthreads();
#define HALF_STEP(PX0, PX1, mnX, alX, PY0, PY1, alY, t, KB, VB, SB) do {                                                      \
        SBAR(); qkt<KB, SK>(PX0, PX1, K_lds, r32, hi, S.qr, ACT(t));                                             \
        finishSM(PY0, PY1, alY, l_reg, pa0, pa1, pa2, pa3); SBAR();                                                           \
        if ((t) + 1 < NT) { if constexpr (F32) { VMW(); SWRITE_KF(SB); SBAR(); SLOAD_F((const float*)Vh, KBASE((t) + 1)); }  \
                            else { SLOAD_H(Kh, Vh, KBASE((t) + 1)); } SBAR(); }                                               \
        pv_tile<VB, SK>(o, vb0, pa0, pa1, pa2, pa3, ACT((t) - 1)); MASKT(PX0, PX1, (t)); partialSM(PX0, PX1, m_reg, mnX, alX);                                        \
        __syncthreads();                                                                                                      \
        if ((t) + 1 < NT) { VMW(); if constexpr (F32) { SWRITE_VF(SB); SBAR(); if ((t) + 2 < NT) SLOAD_F((const float*)Kh, KBASE((t) + 2)); } \
                            else { SWRITE_H(SB); } }                                                                          \
        RESC(alX); __syncthreads(); } while (0)
    for (int t = 1; t + 1 < NT; t += 2) {
        HALF_STEP(pB0, pB1, mnB, alB, pA0, pA1, alA, t, 1, 0, 0);
        HALF_STEP(pA0, pA1, mnA, alA, pB0, pB1, alB, t + 1, 0, 1, 1);
    }
    const bool even = (NT & 1) == 0;
    if (even) { SBAR(); qkt<1, SK>(pB0, pB1, K_lds, r32, hi, S.qr, ACT(NT - 1)); SBAR(); }
#define QROW(e) (nxt.Q + (size_t)(wid * QBLK + r32) * D + ((e) >> 1) * 16 + hi * 8 + ((e) & 1) * 4)
    if constexpr (F32) { SLOAD_F((const float*)nxt.K, kbn); SBAR();
#pragma unroll
        for (int e = 0; e < 8; ++e) S.tq[e] = *(const f32x4*)QROW(e); }
    else { SLOAD_H(nxt.K, nxt.V, kbn); SBAR();
#pragma unroll
        for (int d0 = 0; d0 < 8; ++d0) S.qr[d0] = load8<TIn>(nxt.Q + (size_t)(wid * QBLK + r32) * D + d0 * 16 + hi * 8); }
    SBAR();
    finishSM(pA0, pA1, alA, l_reg, pa0, pa1, pa2, pa3); SBAR();
    if constexpr (F32) {
#pragma unroll
        for (int e = 8; e < 16; ++e) S.tq[e] = *(const f32x4*)QROW(e); SBAR(); }
#undef QROW
    pv_tile<0, SK>(o, vb0, pa0, pa1, pa2, pa3, ACT(even ? NT - 2 : NT - 1));
    if (even) { MASKT(pB0, pB1, NT - 1); partialSM(pB0, pB1, m_reg, mnB, alB); __syncthreads(); RESC(alB);
        finishSM(pB0, pB1, alB, l_reg, pa0, pa1, pa2, pa3); SBAR(); pv_tile<1, SK>(o, vb0, pa0, pa1, pa2, pa3, ACT(NT - 1)); }
    SBAR(); SEAM_K0();
    if (hi == 0) li_l[r32] = l_reg; asm volatile("s_waitcnt lgkmcnt(0)" ::: "memory");
    float rli[16];
#pragma unroll
    for (int r = 0; r < 16; ++r) rli[r] = __builtin_amdgcn_rcpf(li_l[crow(r, hi)]);
    TOut* Ow = cur.O + (size_t)(wid * QBLK) * D;
#pragma unroll
    for (int r = 0; r < 16; ++r) { const int orow = crow(r, hi);
#pragma unroll
        for (int d0 = 0; d0 < 4; ++d0) { const float v = o[d0][r] * rli[r];
            if constexpr (same_t<TOut, float>::v) { Ow[(size_t)orow * D + d0 * 32 + r32] = v; }
            else { const float vn = __shfl_xor(v, 1);
                   if ((r32 & 1) == 0) *(unsigned*)(Ow + (size_t)orow * D + d0 * 32 + r32) = cvtpk(v, vn); } } }
    if constexpr (F32) {
#pragma unroll
        for (int d0 = 0; d0 < 8; ++d0) S.qr[d0] = pack8(S.tq[2 * d0], S.tq[2 * d0 + 1]); }
    __syncthreads();
#undef RESC
#undef KBASE
#undef ACT
#undef MASKT
#undef SEAM_K0
#undef HALF_STEP
}
#undef ROW
#undef VMW
#undef VMWN
#undef SLOAD_H
#undef SWRITE_HK
#undef SWRITE_HV
#undef SWRITE_H
#undef SLOAD_F
#undef SWRITE_KF
#undef SWRITE_VF
}

#define GAS __attribute__((address_space(1)))
#define LAS __attribute__((address_space(3)))
typedef unsigned short bf16r;
typedef float f4 __attribute__((ext_vector_type(4)));
typedef unsigned u4 __attribute__((ext_vector_type(4)));
typedef unsigned u2 __attribute__((ext_vector_type(2)));
typedef short s8v __attribute__((ext_vector_type(8)));

constexpr int TOK = 8192, DM = 2048;
constexpr float EPS = 1e-6f;
constexpr size_t MiB = 1u << 20;
constexpr size_t WS_WIN = 0;
constexpr size_t WS_WOUT0 = 32 * MiB, WS_WG0 = 40 * MiB, WS_WPP0 = 48 * MiB;
constexpr size_t WS_ROPE = 49 * MiB;
constexpr size_t WS_IFG = 53 * MiB;
constexpr size_t WS_BCUM = WS_IFG + 256 * 1024;
constexpr size_t WS_NLOC = WS_BCUM + 128 * 1024;
constexpr size_t WS_NPREV = WS_NLOC + 128 * 1024;
constexpr size_t WS_MSC = WS_NPREV + 128 * 1024;
constexpr size_t WS_SSQA = 54 * MiB, WS_SSQB = 55 * MiB, WS_SSQC = 56 * MiB, WS_LNS = 57 * MiB, WS_LNQ = 58 * MiB;
constexpr size_t WS_H = 60 * MiB;
constexpr size_t WS_PB = 92 * MiB;
constexpr size_t WS_G1 = 100 * MiB;
constexpr size_t WS_MLQK = WS_G1, WS_MLV = WS_G1 + 16 * MiB, WS_MLO = WS_G1 + 32 * MiB, WS_MLZ = WS_G1 + 48 * MiB, WS_DAZ = WS_G1 + 64 * MiB,
                 WS_DAQ = WS_G1 + 80 * MiB, WS_DAK = WS_G1 + 96 * MiB, WS_DAV = WS_G1 + 112 * MiB;
constexpr size_t WS_PP0 = 228 * MiB;
constexpr size_t WS_CPREV = WS_DAQ;
constexpr size_t WS_AO = WS_DAK;
constexpr size_t WS_WCIN = 100 * MiB, WS_WCOUT = 124 * MiB, WS_WG1 = 132 * MiB, WS_WPP1 = 140 * MiB;
constexpr size_t WS_X2B = 141 * MiB;
constexpr size_t WS_PP1 = 205 * MiB;
constexpr size_t WS_V = WS_H, WS_MB = 0, WS_X1B = WS_H, WS_X3B = WS_H, WS_DAO = WS_H, WS_CLOC = 0;
constexpr size_t WS_END = 260 * MiB;
constexpr int LDS_BYTES = 147456;
constexpr size_t WS_BAR = 59 * MiB;
constexpr int LDS_BARST = 147440;

struct Args { const void* in[27]; float* out; unsigned char* ws; int ph_lo, ph_hi; };
__device__ __forceinline__ unsigned long long karg64(int off) {
    unsigned long long r;
    asm volatile("s_load_dwordx2 %0, %1, %2\n\ts_waitcnt lgkmcnt(0)" : "=s"(r) : "s"(__builtin_amdgcn_kernarg_segment_ptr()), "n"(off) : "memory");
    return r;
}
#define KIN(a_, k) (a_).in[k] = (const void*)(GAS const void*)karg64(8 * (k))
#define KOUT(a_) (a_).out = (float*)(GAS float*)karg64(216)
#define KWS(a_) (a_).ws = (unsigned char*)(GAS unsigned char*)karg64(224)

__device__ __forceinline__ unsigned pk2(float lo, float hi) { return pg8::cvt_pk_bf16(lo, hi); }
__device__ __forceinline__ float bflo(unsigned w) { return __uint_as_float(w << 16); }
__device__ __forceinline__ float bfhi(unsigned w) { return __uint_as_float(w & 0xffff0000u); }
__device__ __forceinline__ float wave_sum(float v) {
#pragma unroll
    for (int o = 1; o < 64; o <<= 1) v += __shfl_xor(v, o);
    return v;
}
__device__ __forceinline__ float sigm(float x) { return __builtin_amdgcn_rcpf(1.f + __expf(-x)); }
__device__ __forceinline__ float silu(float x) { return x * __builtin_amdgcn_rcpf(1.f + __expf(-x)); }
#define LDS_WAIT() asm volatile("s_waitcnt lgkmcnt(0)" ::: "memory")

__device__ __forceinline__ int ropeperm(int r) { const int blk = r & ~127, p = r & 127; return blk + 64 * ((p >> 2) & 1) + 16 * (p >> 5) + 4 * ((p >> 3) & 3) + (p & 3); }
__device__ __forceinline__ int win_src_col(int nd) {
    const int seg = nd >> 10, r = nd & 1023;
    if (seg < 2) return nd;
    if (seg == 2) return 2056 + r;
    if (seg == 3) return 3080 + r;
    if (seg == 4) return 4104 + ropeperm(r);
    if (seg == 5) return 5128 + ropeperm(r);
    if (seg == 6) return 6152 + r;
    return 7176 + r;
}
template <bool WINMAP>
__device__ __forceinline__ void transpose_item(const float* W, int K, int Nsrc, int Ndst, const float* gs, bf16r* WT, LAS unsigned* scr, int item, int lane) {
    const int nblk = Ndst >> 6, kb = item / nblk, nb = item - kb * nblk, k0 = kb * 64, n0 = nb * 64;
    const int nd = n0 + lane; const int src = WINMAP ? win_src_col(nd) : nd;
    const float* wp = W + (size_t)k0 * Nsrc + src;
    float v[64];
#pragma unroll
    for (int i = 0; i < 64; ++i) v[i] = __builtin_nontemporal_load(wp + (size_t)i * Nsrc);
    if (gs) {
#pragma unroll
        for (int i = 0; i < 64; ++i) v[i] *= gs[k0 + i];
    }
#pragma unroll
    for (int c = 0; c < 8; ++c) { u4 o; o.x = pk2(v[8 * c], v[8 * c + 1]); o.y = pk2(v[8 * c + 2], v[8 * c + 3]); o.z = pk2(v[8 * c + 4], v[8 * c + 5]); o.w = pk2(v[8 * c + 6], v[8 * c + 7]); *(LAS u4*)(scr + lane * 36 + 4 * c) = o; }
    LDS_WAIT();
    bf16r* op = WT + (size_t)(n0 + (lane >> 3)) * K + k0 + 8 * (lane & 7);
#pragma unroll
    for (int j = 0; j < 8; ++j) *(u4*)(op + (size_t)(8 * j) * K) = *(const LAS u4*)(scr + ((lane >> 3) + 8 * j) * 36 + 4 * (lane & 7));
    LDS_WAIT();
}

template <int PARTS = 7>
__device__ __forceinline__ void phase0(const Args& a, LAS unsigned char* lds, int tid, int lane, int wave, int G) {
    const float* x = (const float*)a.in[0]; const float* Win = (const float*)a.in[4]; const float* gn = (const float*)a.in[3];
    unsigned char* ws = a.ws;
    LAS float* wif = (LAS float*)lds;
    if (PARTS & 1) for (int k = tid; k < 2048; k += 512) { const f4 w0 = *(const f4*)(Win + (size_t)k * 8200 + 2048), w1 = *(const f4*)(Win + (size_t)k * 8200 + 2052); const float g = gn[k];
        wif[k] = w0.x * g; wif[2048 + k] = w0.y * g; wif[4096 + k] = w0.z * g; wif[6144 + k] = w0.w * g; wif[8192 + k] = w1.x * g; wif[10240 + k] = w1.y * g; wif[12288 + k] = w1.z * g; wif[14336 + k] = w1.w * g; }
    __syncthreads();
    const int gw = blockIdx.x * 8 + wave, NGW = G * 8;
    bf16r* H = (bf16r*)(ws + WS_H); float* IFG = (float*)(ws + WS_IFG);
    const float* ib = (const float*)a.in[7]; const float* fb = (const float*)a.in[8];
    f4 vnx[8];
    if (PARTS & 1) { const f4* xr0 = (const f4*)(x + (size_t)(gw < TOK ? gw : 0) * DM) + lane;
#pragma unroll
        for (int j = 0; j < 8; ++j) vnx[j] = __builtin_nontemporal_load(xr0 + 64 * j); }
    if (PARTS & 1) for (int m = gw; m < TOK; m += NGW) {
        f4 v[8]; float s = 0.f;
#pragma unroll
        for (int j = 0; j < 8; ++j) { v[j] = vnx[j]; s += (v[j].x * v[j].x + v[j].y * v[j].y) + (v[j].z * v[j].z + v[j].w * v[j].w); }
        { const int mn = m + NGW < TOK ? m + NGW : m; const f4* xr = (const f4*)(x + (size_t)mn * DM) + lane;
#pragma unroll
          for (int j = 0; j < 8; ++j) vnx[j] = __builtin_nontemporal_load(xr + 64 * j); }
        const float rstd = rsqrtf(wave_sum(s) * (1.f / DM) + EPS);
        u2* hp = (u2*)(H + (size_t)m * DM) + lane;
        float acc[8];
#pragma unroll
        for (int c = 0; c < 8; ++c) acc[c] = 0.f;
#pragma unroll
        for (int j = 0; j < 8; ++j) { const f4 g = *((const f4*)gn + lane + 64 * j); const f4 hv = v[j] * rstd * g; hp[64 * j] = (u2){pk2(hv.x, hv.y), pk2(hv.z, hv.w)};
#pragma unroll
            for (int c = 0; c < 8; ++c) { const f4 w = *(const LAS f4*)(wif + c * 2048 + 4 * lane + 256 * j); acc[c] += (v[j].x * w.x + v[j].y * w.y) + (v[j].z * w.z + v[j].w * w.w); } }
#pragma unroll
        for (int c = 0; c < 8; ++c) acc[c] = wave_sum(acc[c]) * rstd;
        float val = acc[0];
#pragma unroll
        for (int c = 1; c < 8; ++c) if (lane == c) val = acc[c];
        if (lane < 4) IFG[(size_t)m * 8 + lane] = val + ib[lane];
        else if (lane < 8) { const float xf = val + fb[lane - 4]; IFG[(size_t)m * 8 + lane] = fminf(xf, 0.f) - log1pf(expf(-fabsf(xf))); }
    }
    LAS unsigned* scr = (LAS unsigned*)(lds + 65536 + wave * 9216);
    constexpr int I_WIN = 32 * 128, I_SQ = 32 * 32, I_PP = 4 * 32, I_G0A = I_SQ - 128;
    if (PARTS & 2) for (int it = gw; it < I_WIN + I_SQ + I_G0A + I_PP; it += NGW) {
        int r = it;
        if (r < I_WIN) { transpose_item<true>(Win, 2048, 8200, 8192, nullptr, (bf16r*)(ws + WS_WIN), scr, r, lane); continue; } r -= I_WIN;
        if (r < I_SQ) { transpose_item<false>((const float*)a.in[15], 2048, 2048, 2048, nullptr, (bf16r*)(ws + WS_WOUT0), scr, r, lane); continue; } r -= I_SQ;
        if (r < I_G0A) { transpose_item<false>((const float*)a.in[24], 2048, 2048, 2048, (const float*)a.in[23], (bf16r*)(ws + WS_WG0), scr, r, lane); continue; } r -= I_G0A;
        transpose_item<false>((const float*)a.in[25], 256, 2048, 2048, nullptr, (bf16r*)(ws + WS_WPP0), scr, r, lane);
    }
    constexpr int NITEMS0 = 32 * 128 + 2 * 32 * 32 + 4 * 32 - 128;
    const int NX = NITEMS0 % NGW;
    if ((PARTS & 4) && gw >= NX) { const int gt = (gw - NX) * 64 + lane, NT = (NGW - NX) * 64;
        const f4* p4 = (const f4*)a.in[1]; u2* pb = (u2*)(ws + WS_PB);
        for (int e0 = gt; e0 < 2 * TOK * 256 / 4; e0 += 4 * NT) { f4 v[4];
#pragma unroll
            for (int k = 0; k < 4; ++k) { const int e = e0 + k * NT; v[k] = p4[e < 2 * TOK * 256 / 4 ? e : e0]; }
#pragma unroll
            for (int k = 0; k < 4; ++k) { const int e = e0 + k * NT; if (e < 2 * TOK * 256 / 4) pb[e] = (u2){pk2(v[k].x, v[k].y), pk2(v[k].z, v[k].w)}; } }
        const int* pos = (const int*)a.in[2]; float2* rt = (float2*)(ws + WS_ROPE);
        for (int e = gt; e < TOK * 64; e += NT) { const int tok = e >> 6, j = e & 63; const float freq = exp2f(-(float)j * (13.287712379549449f / 64.f));
            const float ang = (float)pos[tok] * freq; float sn, cs; sincosf(ang, &sn, &cs); rt[e] = make_float2(cs, sn); } }
}

__device__ __forceinline__ void l1_weights(const Args& a, LAS unsigned char* lds, int lane, int wave, int G) {
    unsigned char* ws = a.ws; const int gw = blockIdx.x * 8 + wave, NGW = G * 8;
    LAS unsigned* scr = (LAS unsigned*)(lds + wave * 9216);
    constexpr int I_CIN = 32 * 96, I_SQ = 32 * 32, I_PP = 4 * 32;
    for (int it = gw; it < I_CIN + 2 * I_SQ + I_PP + 128; it += NGW) {
        int r = it;
        if (r < 128) { transpose_item<false>((const float*)a.in[24], 2048, 2048, 2048, (const float*)a.in[23], (bf16r*)(ws + WS_WG0), scr, I_SQ - 128 + r, lane); continue; } r -= 128;
        if (r < I_CIN) { transpose_item<false>((const float*)a.in[17], 2048, 6144, 6144, (const float*)a.in[16], (bf16r*)(ws + WS_WCIN), scr, r, lane); continue; } r -= I_CIN;
        if (r < I_SQ) { transpose_item<false>((const float*)a.in[22], 2048, 2048, 2048, nullptr, (bf16r*)(ws + WS_WCOUT), scr, r, lane); continue; } r -= I_SQ;
        if (r < I_SQ) { transpose_item<false>((const float*)a.in[24] + (size_t)2048 * 2048, 2048, 2048, 2048, (const float*)a.in[23] + 2048, (bf16r*)(ws + WS_WG1), scr, r, lane); continue; } r -= I_SQ;
        transpose_item<false>((const float*)a.in[25] + (size_t)256 * 2048, 256, 2048, 2048, nullptr, (bf16r*)(ws + WS_WPP1), scr, r, lane);
    }
}

#define XB_TMO      128
#define XB_XCNT(j)  (256  + 64 * (j))
#define XB_XSUB(j)  (1280 + 64 * (j))
#define XB_XGEN(j)  (2304 + 64 * (j))
#define XB_TOP      3328
#define XB_TOPGEN   3392
#define XCD_BAR_WORDS 3456
#define XB_SPIN_CAP (1u << 18)

__device__ __forceinline__ unsigned xb_ld(unsigned* p)              { return __hip_atomic_load(p, __ATOMIC_RELAXED, __HIP_MEMORY_SCOPE_AGENT); }
__device__ __forceinline__ unsigned xb_add(unsigned* p, unsigned v) { return __hip_atomic_fetch_add(p, v, __ATOMIC_RELAXED, __HIP_MEMORY_SCOPE_AGENT); }
__device__ __forceinline__ unsigned xb_xcc_id() { return (unsigned)__builtin_amdgcn_s_getreg((3 << 11) | 20) & 0xFu; }
#define XB_SPIN(cond, bar) do { unsigned _sp = 0; while (cond) { __builtin_amdgcn_s_sleep(1); \
    if ((++_sp & 255u) == 0u) { if (xb_ld(&(bar)[XB_TMO])) break; if (_sp > XB_SPIN_CAP) { atomicAdd(&(bar)[XB_TMO], 1u); break; } } } } while (0)

struct XcdBarrier {
    unsigned* bar; unsigned x;
    volatile LAS unsigned* st;
};

__device__ __forceinline__ XcdBarrier xcd_barrier_post(unsigned* bar, volatile LAS unsigned* st) {
    XcdBarrier b; b.bar = bar; b.x = xb_xcc_id(); b.st = st;
    if (threadIdx.x == 0) (void)xb_add(&bar[XB_XCNT(b.x)], 1u);
    return b;
}
__device__ __forceinline__ void xcd_barrier_complete(unsigned* bar, unsigned x, unsigned& nloc, unsigned& nx) {
    const unsigned G = gridDim.x * gridDim.y * gridDim.z;
    unsigned sum, cnt, mine, sp = 0u;
    for (;;) {
        sum = 0u; cnt = 0u; mine = 0u;
#pragma unroll
        for (unsigned j = 0; j < 16; ++j) { const unsigned c = xb_ld(&bar[XB_XCNT(j)]); sum += c; cnt += (c > 0u) ? 1u : 0u; mine = (j == x) ? c : mine; }
        if (sum == G) break;
        __builtin_amdgcn_s_sleep(1);
        if ((++sp & 255u) == 0u) { if (xb_ld(&bar[XB_TMO])) break; if (sp > XB_SPIN_CAP) { atomicAdd(&bar[XB_TMO], 1u); break; } }
    }
    nloc = mine > 0u ? mine : 1u; nx = cnt > 0u ? cnt : 1u;
}

__device__ __forceinline__ void xcd_barrier(const XcdBarrier& b) {
    asm volatile("s_waitcnt vmcnt(0)" ::: "memory");
    __syncthreads();
    if (threadIdx.x == 0) {
        unsigned* bar = b.bar;
        __builtin_amdgcn_s_waitcnt(0);
        unsigned nloc = b.st[0], nx = b.st[1];
        if (nloc == 0u) { xcd_barrier_complete(bar, b.x, nloc, nx); b.st[0] = nloc; b.st[1] = nx; }
        const unsigned old = xb_add(&bar[XB_XSUB(b.x)], 1u);
        const unsigned gen = old / nloc;
        if (old + 1u == (gen + 1u) * nloc) {
            __builtin_amdgcn_fence(__ATOMIC_RELEASE, "agent");
            asm volatile("s_waitcnt vmcnt(0)" ::: "memory");
            const unsigned og = xb_add(&bar[XB_TOP], 1u);
            const unsigned tg = og / nx;
            if (og + 1u == (tg + 1u) * nx) xb_add(&bar[XB_TOPGEN], 1u);
            else XB_SPIN(xb_ld(&bar[XB_TOPGEN]) == tg, bar);
            __builtin_amdgcn_fence(__ATOMIC_ACQUIRE, "agent");
            xb_add(&bar[XB_XGEN(b.x)], 1u);
            asm volatile("s_waitcnt vmcnt(0)" ::: "memory");
        } else {
            XB_SPIN(xb_ld(&bar[XB_XGEN(b.x)]) == gen, bar);
            __builtin_amdgcn_fence(__ATOMIC_ACQUIRE, "agent");
            asm volatile("s_waitcnt vmcnt(0)" ::: "memory");
        }
    }
    __syncthreads();
}


using pg8::Unit;
typedef pg8::f32x4 accv;

__device__ __forceinline__ u4 pack8(const accv& a, const accv& b) { u4 w; w.x = pk2(a[0], a[1]); w.y = pk2(a[2], a[3]); w.z = pk2(b[0], b[1]); w.w = pk2(b[2], b[3]); return w; }
__device__ __forceinline__ float row_rstd(const float* ssq, int r, int fq) {
    const f4 p0 = *(const f4*)(ssq + (size_t)r * 32 + 8 * fq), p1 = *(const f4*)(ssq + (size_t)r * 32 + 8 * fq + 4);
    float s = ((p0.x + p0.y) + (p0.z + p0.w)) + ((p1.x + p1.y) + (p1.z + p1.w));
    s += __shfl_xor(s, 16); s += __shfl_xor(s, 32);
    return rsqrtf(s * (1.f / DM) + EPS);
}

__device__ __forceinline__ float row_rstd_sc1(const float* ssq, int r, int fq) {
    GAS unsigned long long* p = (GAS unsigned long long*)(ssq + (size_t)r * 32 + 8 * fq); float s = 0.f;
#pragma unroll
    for (int i = 0; i < 4; ++i) { const unsigned long long w = __hip_atomic_load(p + i, __ATOMIC_RELAXED, __HIP_MEMORY_SCOPE_AGENT); s += __uint_as_float((unsigned)w) + __uint_as_float((unsigned)(w >> 32)); }
    s += __shfl_xor(s, 16); s += __shfl_xor(s, 32);
    return rsqrtf(s * (1.f / DM) + EPS);
}

__device__ __forceinline__ void unpack8(const u4& w, accv& a, accv& b) { a[0] = bflo(w.x); a[1] = bfhi(w.x); a[2] = bflo(w.y); a[3] = bfhi(w.y); b[0] = bflo(w.z); b[1] = bfhi(w.z); b[2] = bflo(w.w); b[3] = bfhi(w.w); }

struct RsPart { f4 p0, p1; };
__device__ __forceinline__ RsPart rs_load(const float* ssq, int r, int fq) { RsPart p; p.p0 = *(const f4*)(ssq + (size_t)r * 32 + 8 * fq); p.p1 = *(const f4*)(ssq + (size_t)r * 32 + 8 * fq + 4); return p; }
__device__ __forceinline__ float rs_fin(const RsPart& p) {
    float s = ((p.p0.x + p.p0.y) + (p.p0.z + p.p0.w)) + ((p.p1.x + p.p1.y) + (p.p1.z + p.p1.w));
    s += __shfl_xor(s, 16); s += __shfl_xor(s, 32);
    return rsqrtf(s * (1.f / DM) + EPS);
}

struct EpiG1 {
    static constexpr bool PERM = true, AFTER_DRAIN = false;
    unsigned char* ws;
    __device__ __forceinline__ void operator()(const accv (&acc)[2][2][4][2], const Unit& u, int wr, int wc, int fr, int fq) const {
        const int seg = u.pn >> 2, q4 = u.pn & 3;
        const int row0 = u.pm * 256 + wr * 64 + fr, cl = wc * 32 + 8 * fq;
        if (seg < 4 || seg == 7) {
            const int reg = seg == 7 ? 4 : seg;
            bf16r* base = (bf16r*)(ws + WS_G1 + (size_t)reg * 16 * MiB);
#pragma unroll
            for (int ai = 0; ai < 2; ++ai)
#pragma unroll
                for (int m = 0; m < 4; ++m) { bf16r* rowp = base + (size_t)(row0 + ai * 128 + m * 16) * 1024 + q4 * 256 + cl;
#pragma unroll
                    for (int bj = 0; bj < 2; ++bj) *(u4*)(rowp + bj * 128) = pack8(acc[ai][bj][m][0], acc[ai][bj][m][1]); }
        } else if (seg == 6) {
            bf16r* base = (bf16r*)(ws + WS_DAV);
#pragma unroll
            for (int ai = 0; ai < 2; ++ai)
#pragma unroll
                for (int m = 0; m < 4; ++m) { const int r = row0 + ai * 128 + m * 16, b = r >> 11, s = r & 2047;
#pragma unroll
                    for (int bj = 0; bj < 2; ++bj) *(u4*)(base + ((size_t)((b * 4 + q4) * 2 + bj) * 2048 + s) * 128 + cl) = pack8(acc[ai][bj][m][0], acc[ai][bj][m][1]); }
        } else {
            bf16r* base = (bf16r*)(ws + (seg == 4 ? WS_DAQ : WS_DAK));
            const float* rope = (const float*)(ws + WS_ROPE);
            const int j0 = 16 * wc + 4 * fq;
#pragma unroll
            for (int ai = 0; ai < 2; ++ai)
#pragma unroll
                for (int m = 0; m < 4; ++m) { const int r = row0 + ai * 128 + m * 16, b = r >> 11, s = r & 2047;
                    const f4 t0 = *(const f4*)(rope + ((size_t)r * 64 + j0) * 2), t1 = *(const f4*)(rope + ((size_t)r * 64 + j0) * 2 + 4);
                    const accv cs = {t0.x, t0.z, t1.x, t1.z}, sn = {t0.y, t0.w, t1.y, t1.w};
#pragma unroll
                    for (int bj = 0; bj < 2; ++bj) { const accv x1 = acc[ai][bj][m][0], x2 = acc[ai][bj][m][1];
                        const accv o1 = x1 * cs - x2 * sn, o2 = x1 * sn + x2 * cs;
                        *(u4*)(base + ((size_t)((b * 4 + q4) * 2 + bj) * 2048 + s) * 128 + cl) = pack8(o1, o2); } }
        }
    }
};

template <bool XBF>
struct EpiRes {
    static constexpr bool PERM = true, AFTER_DRAIN = false;
    const void* xin; bf16r* xb; float* ssq;
    __device__ __forceinline__ void operator()(const accv (&acc)[2][2][4][2], const Unit& u, int wr, int wc, int fr, int fq) const {
        const int row0 = u.pm * 256 + wr * 64 + fr, col0 = u.pn * 256 + wc * 32 + 8 * fq;
#pragma unroll
        for (int ah = 0; ah < 4; ++ah) { const int ai = ah >> 1, m0 = (ah & 1) * 2;
            accv xa[4][2], xc[4][2];
#pragma unroll
            for (int m = m0; m < m0 + 2; ++m)
#pragma unroll
                for (int bj = 0; bj < 2; ++bj) { const size_t o = (size_t)(row0 + ai * 128 + m * 16) * DM + col0 + bj * 128;
                    if constexpr (XBF) { unpack8(*(const u4*)((const bf16r*)xin + o), xa[m][bj], xc[m][bj]); } else { xa[m][bj] = *(const accv*)((const float*)xin + o); xc[m][bj] = *(const accv*)((const float*)xin + o + 4); } }
#pragma unroll
            for (int m = m0; m < m0 + 2; ++m) { const int r = row0 + ai * 128 + m * 16; float q = 0.f;
#pragma unroll
                for (int bj = 0; bj < 2; ++bj) { const size_t o = (size_t)r * DM + col0 + bj * 128;
                    const accv v0 = acc[ai][bj][m][0] + xa[m][bj], v1 = acc[ai][bj][m][1] + xc[m][bj];
                    *(u4*)(xb + o) = pack8(v0, v1);
                    q += ((v0[0] * v0[0] + v0[1] * v0[1]) + (v0[2] * v0[2] + v0[3] * v0[3])) + ((v1[0] * v1[0] + v1[1] * v1[1]) + (v1[2] * v1[2] + v1[3] * v1[3])); }
                q += __shfl_xor(q, 16); q += __shfl_xor(q, 32);
                if (fq == 0) ssq[(size_t)r * 32 + u.pn * 4 + wc] = q; } }
    }
};

struct EpiGate {
    static constexpr bool PERM = true, AFTER_DRAIN = false;
    const bf16r* xin; bf16r* xb; const bf16r* pp; const float* ssq_in; float* ssq_out;
    __device__ __forceinline__ void operator()(const accv (&acc)[2][2][4][2], const Unit& u, int wr, int wc, int fr, int fq) const {
        const int row0 = u.pm * 256 + wr * 64 + fr, col0 = u.pn * 256 + wc * 32 + 8 * fq;
#pragma unroll
        for (int ah = 0; ah < 4; ++ah) { const int ai = ah >> 1, m0 = (ah & 1) * 2;
            u4 xw[4][2], pw[4][2]; RsPart rp[4];
#pragma unroll
            for (int m = m0; m < m0 + 2; ++m) { const int r = row0 + ai * 128 + m * 16; rp[m] = rs_load(ssq_in, r, fq);
#pragma unroll
                for (int bj = 0; bj < 2; ++bj) { const size_t o = (size_t)r * DM + col0 + bj * 128; xw[m][bj] = *(const u4*)(xin + o); pw[m][bj] = *(const u4*)(pp + o); } }
#pragma unroll
            for (int m = m0; m < m0 + 2; ++m) { const int r = row0 + ai * 128 + m * 16; const float rstd = rs_fin(rp[m]); float q = 0.f;
#pragma unroll
                for (int bj = 0; bj < 2; ++bj) { const size_t o = (size_t)r * DM + col0 + bj * 128;
                    accv xa, xc, pa, pc; unpack8(xw[m][bj], xa, xc); unpack8(pw[m][bj], pa, pc);
                    const accv a0 = acc[ai][bj][m][0] * rstd, a1 = acc[ai][bj][m][1] * rstd;
                    accv v0, v1;
#pragma unroll
                    for (int i = 0; i < 4; ++i) { v0[i] = xa[i] + sigm(a0[i]) * pa[i]; v1[i] = xc[i] + sigm(a1[i]) * pc[i]; }
                    *(u4*)(xb + o) = pack8(v0, v1);
                    q += ((v0[0] * v0[0] + v0[1] * v0[1]) + (v0[2] * v0[2] + v0[3] * v0[3])) + ((v1[0] * v1[0] + v1[1] * v1[1]) + (v1[2] * v1[2] + v1[3] * v1[3])); }
                q += __shfl_xor(q, 16); q += __shfl_xor(q, 32); if (fq == 0) ssq_out[(size_t)r * 32 + u.pn * 4 + wc] = q; } }
    }
};

struct EpiUVZ {
    static constexpr bool PERM = true, AFTER_DRAIN = false;
    bf16r* U; bf16r* V; const float* ssq_in; float* lns; float* lnq;
    __device__ __forceinline__ void operator()(const accv (&acc)[2][2][4][2], const Unit& u, int wr, int wc, int fr, int fq) const {
        const int seg = u.pn >> 3, pnl = u.pn & 7;
        bf16r* base = (seg == 1) ? V : U + (size_t)(seg >> 1) * TOK * DM;
        const int row0 = u.pm * 256 + wr * 64 + fr, col0 = pnl * 256 + wc * 32 + 8 * fq;

#pragma unroll
        for (int ai = 0; ai < 2; ++ai) { RsPart rp[4];
#pragma unroll
            for (int m = 0; m < 4; ++m) rp[m] = rs_load(ssq_in, row0 + ai * 128 + m * 16, fq);
#pragma unroll
            for (int m = 0; m < 4; ++m) { const int r = row0 + ai * 128 + m * 16; const float rstd = rs_fin(rp[m]); float s1 = 0.f, s2 = 0.f;
#pragma unroll
                for (int bj = 0; bj < 2; ++bj) { const size_t o = (size_t)r * DM + col0 + bj * 128;
                    const accv v0 = acc[ai][bj][m][0] * rstd, v1 = acc[ai][bj][m][1] * rstd;
                    *(u4*)(base + o) = pack8(v0, v1);
                    s1 += ((v0[0] + v0[1]) + (v0[2] + v0[3])) + ((v1[0] + v1[1]) + (v1[2] + v1[3]));
                    s2 += ((v0[0] * v0[0] + v0[1] * v0[1]) + (v0[2] * v0[2] + v0[3] * v0[3])) + ((v1[0] * v1[0] + v1[1] * v1[1]) + (v1[2] * v1[2] + v1[3] * v1[3])); }
                if (seg == 1) { s1 += __shfl_xor(s1, 16); s1 += __shfl_xor(s1, 32); s2 += __shfl_xor(s2, 16); s2 += __shfl_xor(s2, 32);
                    if (fq == 0) { lns[(size_t)r * 32 + pnl * 4 + wc] = s1; lnq[(size_t)r * 32 + pnl * 4 + wc] = s2; } } } }
    }
};

struct EpiGateFinal {
    static constexpr bool PERM = true, AFTER_DRAIN = false;
    const bf16r* xin; float* out; const bf16r* pp; const float* ssq_in; float* ssq_x; unsigned* cnt; const float* gfin;
    __device__ __forceinline__ void operator()(accv (&acc)[2][2][4][2], const Unit& u, int wr, int wc, int fr, int fq) const {
        const int row0 = u.pm * 256 + wr * 64 + fr, col0 = u.pn * 256 + wc * 32 + 8 * fq;
#pragma unroll
        for (int ah = 0; ah < 4; ++ah) { const int ai = ah >> 1, m0 = (ah & 1) * 2;
            u4 xw[4][2], pw[4][2]; RsPart rp[4];
#pragma unroll
            for (int m = m0; m < m0 + 2; ++m) { const int r = row0 + ai * 128 + m * 16; rp[m] = rs_load(ssq_in, r, fq);
#pragma unroll
                for (int bj = 0; bj < 2; ++bj) { const size_t o = (size_t)r * DM + col0 + bj * 128; xw[m][bj] = *(const u4*)(xin + o); pw[m][bj] = *(const u4*)(pp + o); } }
#pragma unroll
            for (int m = m0; m < m0 + 2; ++m) { const int r = row0 + ai * 128 + m * 16; const float rstd = rs_fin(rp[m]); float q = 0.f;
#pragma unroll
                for (int bj = 0; bj < 2; ++bj) {
                    accv xa, xc, pa, pc; unpack8(xw[m][bj], xa, xc); unpack8(pw[m][bj], pa, pc);
                    const accv a0 = acc[ai][bj][m][0] * rstd, a1 = acc[ai][bj][m][1] * rstd;
                    accv v0, v1;
#pragma unroll
                    for (int i = 0; i < 4; ++i) { v0[i] = xa[i] + sigm(a0[i]) * pa[i]; v1[i] = xc[i] + sigm(a1[i]) * pc[i]; }
                    acc[ai][bj][m][0] = v0; acc[ai][bj][m][1] = v1;
                    q += ((v0[0] * v0[0] + v0[1] * v0[1]) + (v0[2] * v0[2] + v0[3] * v0[3])) + ((v1[0] * v1[0] + v1[1] * v1[1]) + (v1[2] * v1[2] + v1[3] * v1[3])); }
                q += __shfl_xor(q, 16); q += __shfl_xor(q, 32); if (fq == 0) __hip_atomic_store((GAS unsigned*)(ssq_x + (size_t)r * 32 + u.pn * 4 + wc), __float_as_uint(q), __ATOMIC_RELAXED, __HIP_MEMORY_SCOPE_AGENT); } }
        asm volatile("s_waitcnt vmcnt(0)" ::: "memory");
        __builtin_amdgcn_s_barrier();
        if ((wr | wc) == 0) { GAS unsigned* c = (GAS unsigned*)(cnt + u.pm * 64);
            if ((fr | fq) == 0) (void)__hip_atomic_fetch_add(c, 1u, __ATOMIC_RELAXED, __HIP_MEMORY_SCOPE_AGENT);
            unsigned spins = 0; while ((unsigned)__builtin_amdgcn_readfirstlane((int)__hip_atomic_load(c, __ATOMIC_RELAXED, __HIP_MEMORY_SCOPE_AGENT)) < 8u) { __builtin_amdgcn_s_sleep(1); if (++spins > (1u << 22)) break; }
            __builtin_amdgcn_fence(__ATOMIC_ACQUIRE, "agent"); asm volatile("s_waitcnt vmcnt(0)" ::: "memory"); }
        __builtin_amdgcn_s_barrier();
        accv g[2][2];
#pragma unroll
        for (int bj = 0; bj < 2; ++bj) { g[bj][0] = *(const accv*)(gfin + col0 + bj * 128); g[bj][1] = *(const accv*)(gfin + col0 + bj * 128 + 4); }
#pragma unroll
        for (int ai = 0; ai < 2; ++ai)
#pragma unroll
            for (int m = 0; m < 4; ++m) { const int r = row0 + ai * 128 + m * 16; const float rstd = row_rstd_sc1(ssq_x, r, fq);
#pragma unroll
                for (int bj = 0; bj < 2; ++bj) { const size_t o = (size_t)r * DM + col0 + bj * 128;
                    const accv v0 = acc[ai][bj][m][0] * rstd * g[bj][0], v1 = acc[ai][bj][m][1] * rstd * g[bj][1]; const bool lo = fr < 8;
                    const accv snd = lo ? v1 : v0; accv rcv;
#pragma unroll
                    for (int i = 0; i < 4; ++i) rcv[i] = __shfl_xor(snd[i], 8);
                    float* pa = lo ? out + o : out + o - (size_t)8 * DM + 4; float* pb = lo ? out + o + (size_t)8 * DM : out + o + 4;
                    *(accv*)pa = lo ? v0 : rcv; *(accv*)pb = lo ? rcv : v1; } }
    }
};

#define MFMA16(a, b, c) __builtin_amdgcn_mfma_f32_16x16x32_bf16((a), (b), (c), 0, 0, 0)
constexpr int LP = 136;

struct ConvW { f4 w[4][2]; f4 b[2]; };
__device__ __forceinline__ void conv_w_load(const float* cw, const float* cb, int col, ConvW& W) {
    W.b[0] = *(const f4*)(cb + col); W.b[1] = *(const f4*)(cb + col + 4);
#pragma unroll
    for (int j = 0; j < 4; ++j) { W.w[j][0] = *(const f4*)(cw + j * 1024 + col); W.w[j][1] = *(const f4*)(cw + j * 1024 + col + 4); }
}
__device__ __forceinline__ void conv8_ld(const bf16r* mlqk, int t0, int cpos, int l, int col, u4 (&xv)[4]) {
#pragma unroll
    for (int j = 0; j < 4; ++j) { const int tt = l - 3 + j; const bool ok = cpos + tt >= 0;
        xv[j] = *(const u4*)(mlqk + (size_t)(t0 + (ok ? tt : 0)) * 1024 + col); if (!ok) xv[j] = (u4){0u, 0u, 0u, 0u}; }
}
__device__ __forceinline__ void conv8_fin(const ConvW& W, const u4 (&xv)[4], float scale, float (&o)[8]) {
    o[0] = W.b[0].x; o[1] = W.b[0].y; o[2] = W.b[0].z; o[3] = W.b[0].w; o[4] = W.b[1].x; o[5] = W.b[1].y; o[6] = W.b[1].z; o[7] = W.b[1].w;
#pragma unroll
    for (int j = 0; j < 4; ++j) { const f4 w0 = W.w[j][0], w1 = W.w[j][1];
        o[0] += w0.x * bflo(xv[j].x); o[1] += w0.y * bfhi(xv[j].x); o[2] += w0.z * bflo(xv[j].y); o[3] += w0.w * bfhi(xv[j].y);
        o[4] += w1.x * bflo(xv[j].z); o[5] += w1.y * bfhi(xv[j].z); o[6] += w1.z * bflo(xv[j].w); o[7] += w1.w * bfhi(xv[j].w); }
#pragma unroll
    for (int i = 0; i < 8; ++i) o[i] = silu(o[i]) * scale;
}
constexpr float KSCALE = 0.08838834764831845f;
constexpr int LPV = 264;
typedef short s4v __attribute__((ext_vector_type(4)));
__device__ __forceinline__ s8v tr_frag(const LAS bf16r* base, int pitch, int fr, int fq) {
    const LAS bf16r* p = base + (8 * fq + (fr >> 2)) * pitch + 4 * (fr & 3);
    const s4v lo = __builtin_amdgcn_ds_read_tr16_b64_v4i16((LAS s4v*)p), hi = __builtin_amdgcn_ds_read_tr16_b64_v4i16((LAS s4v*)(p + 4 * pitch));
    return (s8v){lo[0], lo[1], lo[2], lo[3], hi[0], hi[1], hi[2], hi[3]};
}
__device__ __forceinline__ float wave_scan_add(float x, int lane) {
#pragma unroll
    for (int o = 1; o < 64; o <<= 1) { const float y = __shfl_up(x, o); if (lane >= o) x += y; }
    return x;
}
__device__ __forceinline__ float wave_scan_max(float x, int lane) {
#pragma unroll
    for (int o = 1; o < 64; o <<= 1) { const float y = __shfl_up(x, o); if (lane >= o) x = fmaxf(x, y); }
    return x;
}
__device__ __forceinline__ float wave_max(float v) {
#pragma unroll
    for (int o = 1; o < 64; o <<= 1) v = fmaxf(v, __shfl_xor(v, o));
    return v;
}

__device__ __forceinline__ void m1_unit(const Args& a, LAS unsigned char* lds, int unit, int tid, int lane, int wave) {
    unsigned char* ws = a.ws;
    const int b = unit >> 6, c = (unit >> 2) & 15, h = unit & 3, t0 = b * 2048 + c * 128;
    LAS bf16r* Kn = (LAS bf16r*)lds;
    LAS bf16r* Vn = (LAS bf16r*)(lds + 34816);
    LAS float* fs = (LAS float*)(lds + 104448);
    const float* IFG = (const float*)(ws + WS_IFG); float* BCUM = (float*)(ws + WS_BCUM); float* MSC = (float*)(ws + WS_MSC);
    float li = 0.f, bsum = 0.f;
    if (wave < 2) { li = IFG[(size_t)(t0 + tid) * 8 + h]; bsum = wave_scan_add(IFG[(size_t)(t0 + tid) * 8 + 4 + h], lane); if (tid == 63) fs[128] = bsum; }
    __syncthreads();
    if (wave == 1) bsum += fs[128];
    if (wave < 2) { BCUM[(size_t)(t0 + tid) * 4 + h] = bsum; if (tid == 127) fs[129] = bsum; }
    __syncthreads();
    float w = 0.f;
    if (wave < 2) { w = fs[129] - bsum + li; const float wm = wave_max(w); if (lane == 0) fs[130 + wave] = wm; }
    __syncthreads();
    if (wave < 2) { const float m = fmaxf(fs[130], fs[131]); fs[tid] = __expf(w - m); if (tid == 0) { MSC[unit * 4 + 0] = m; MSC[unit * 4 + 1] = fs[129]; } }
    __syncthreads();
    const bf16r* mlqk = (const bf16r*)(ws + WS_MLQK); const bf16r* mlv = (const bf16r*)(ws + WS_MLV);
    const float* cw = (const float*)a.in[5]; const float* cb = (const float*)a.in[6];
    { const int dg = (tid & 15) * 8, col = 512 + h * 128 + dg; ConvW W; conv_w_load(cw, cb, col, W);
      u4 xv[4][4];
#pragma unroll
      for (int n = 0; n < 4; ++n) conv8_ld(mlqk, t0, c * 128, (tid >> 4) + 32 * n, col, xv[n]);
#pragma unroll
      for (int n = 0; n < 4; ++n) { const int l = (tid >> 4) + 32 * n; float o[8]; conv8_fin(W, xv[n], KSCALE, o);
          *(LAS u4*)(Kn + l * LP + dg) = (u4){pk2(o[0], o[1]), pk2(o[2], o[3]), pk2(o[4], o[5]), pk2(o[6], o[7])}; } }
#pragma unroll
    for (int it = tid; it < 128 * 32; it += 512) { const int l = it >> 5, dg = (it & 31) * 8; const float e = fs[l];
        const u4 xv = *(const u4*)(mlv + (size_t)(t0 + l) * 1024 + h * 256 + dg);
        *(LAS u4*)(Vn + l * LPV + dg) = (u4){pk2(bflo(xv.x) * e, bfhi(xv.x) * e), pk2(bflo(xv.y) * e, bfhi(xv.y) * e), pk2(bflo(xv.z) * e, bfhi(xv.z) * e), pk2(bflo(xv.w) * e, bfhi(xv.w) * e)}; }
    __syncthreads();
    if (tid < 128) { float sacc = 0.f;
#pragma unroll 16
        for (int l = 0; l < 128; ++l) sacc += fs[l] * __uint_as_float((unsigned)Kn[l * LP + tid] << 16);
        ((float*)(ws + WS_NLOC))[unit * 128 + tid] = sacc; }
    const int fr = lane & 15, fq = lane >> 4;
    f4 acc[8][2];
#pragma unroll
    for (int mt = 0; mt < 8; ++mt) { acc[mt][0] = (f4){0.f, 0.f, 0.f, 0.f}; acc[mt][1] = (f4){0.f, 0.f, 0.f, 0.f}; }
#pragma unroll
    for (int ks = 0; ks < 4; ++ks) {
        const s8v b0 = tr_frag(Vn + 32 * ks * LPV + 32 * wave, LPV, fr, fq), b1 = tr_frag(Vn + 32 * ks * LPV + 32 * wave + 16, LPV, fr, fq);
#pragma unroll
        for (int mt = 0; mt < 8; ++mt) { const s8v av = tr_frag(Kn + 32 * ks * LP + 16 * mt, LP, fr, fq); acc[mt][0] = MFMA16(av, b0, acc[mt][0]); acc[mt][1] = MFMA16(av, b1, acc[mt][1]); } }
    float* cl = (float*)(ws + WS_CLOC) + (size_t)unit * 32768;
#pragma unroll
    for (int mt = 0; mt < 8; ++mt)
#pragma unroll
        for (int nt = 0; nt < 2; ++nt) *(f4*)(cl + (size_t)(32 * wave + 16 * nt + fr) * 128 + 16 * mt + 4 * fq) = acc[mt][nt];
    __syncthreads();
}

__device__ __forceinline__ void m2_scan(const Args& a, int tid, int G) {
    unsigned char* ws = a.ws; const int gt = blockIdx.x * 512 + tid, NT = G * 512;
    const float* MSC = (const float*)(ws + WS_MSC); float* MSCw = (float*)(ws + WS_MSC);
    const float* CL = (const float*)(ws + WS_CLOC); bf16r* CP = (bf16r*)(ws + WS_CPREV);
    for (int e = gt; e < 16 * 8192; e += NT) { const int bh = e >> 13, idx = (e & 8191) * 4, b = bh >> 2, h = bh & 3;
        f4 C = {0.f, 0.f, 0.f, 0.f}; float m = 0.f;
        for (int c = 0; c < 16; ++c) { const int u = (b * 16 + c) * 4 + h;
            *(u2*)(CP + (size_t)u * 32768 + idx) = (u2){pk2(C[0], C[1]), pk2(C[2], C[3])};
            const float ml = MSC[u * 4 + 0], g = MSC[u * 4 + 1]; const float mn = fmaxf(g + m, ml), aa = __expf(g + m - mn), cc = __expf(ml - mn);
            const f4 Cl = __builtin_nontemporal_load((const f4*)(CL + (size_t)u * 32768 + idx)); C = C * aa + Cl * cc; m = mn; } }
    const float* NL = (const float*)(ws + WS_NLOC); float* NP = (float*)(ws + WS_NPREV);
    for (int e = gt; e < 16 * 128; e += NT) { const int bh = e >> 7, dk = e & 127, b = bh >> 2, h = bh & 3; float n = 0.f, m = 0.f;
        for (int c = 0; c < 16; ++c) { const int u = (b * 16 + c) * 4 + h; NP[u * 128 + dk] = n; if (dk == 0) MSCw[u * 4 + 2] = m;
            const float ml = MSC[u * 4 + 0], g = MSC[u * 4 + 1]; const float mn = fmaxf(g + m, ml), aa = __expf(g + m - mn), cc = __expf(ml - mn);
            n = aa * n + cc * NL[u * 128 + dk]; m = mn; } }
}

template <int ONLY_STAGE = 0>
__device__ __forceinline__ void m3_unit(const Args& a, LAS unsigned char* lds, int unit, int tid, int lane, int wave) {
    unsigned char* ws = a.ws;
    const int b = unit >> 6, c = (unit >> 2) & 15, h = unit & 3, t0 = b * 2048 + c * 128;
    LAS bf16r* Qc = (LAS bf16r*)lds;
    LAS bf16r* Kc = (LAS bf16r*)(lds + 34816);
    LAS bf16r* Vn = (LAS bf16r*)(lds + 69632);
    LAS float* fs = (LAS float*)(lds + 139264);
    const float* IFG = (const float*)(ws + WS_IFG); const float* BCUM = (const float*)(ws + WS_BCUM); const float* MSC = (const float*)(ws + WS_MSC);
    const float m_prev = MSC[unit * 4 + 2];
    if (tid < 128) { const float bt = BCUM[(size_t)(t0 + tid) * 4 + h]; fs[tid] = IFG[(size_t)(t0 + tid) * 8 + h] - bt; fs[128 + tid] = bt; }
    else if (tid < 256) fs[256 + tid - 128] = ((const float*)(ws + WS_NPREV))[unit * 128 + tid - 128];
    const bf16r* mlqk = (const bf16r*)(ws + WS_MLQK); const bf16r* mlv = (const bf16r*)(ws + WS_MLV);
    const float* cw = (const float*)a.in[5]; const float* cb = (const float*)a.in[6];
    { const int isk = (tid >> 4) & 1, dg = (tid & 15) * 8, col = isk * 512 + h * 128 + dg; ConvW W; conv_w_load(cw, cb, col, W);
      LAS bf16r* dst = isk ? Kc : Qc; const float sc = isk ? KSCALE : 1.f;
#pragma unroll
      for (int hf = 0; hf < 2; ++hf) { u4 xv[4][4];
#pragma unroll
          for (int n = 0; n < 4; ++n) conv8_ld(mlqk, t0, c * 128, (tid >> 5) + 16 * (4 * hf + n), col, xv[n]);
#pragma unroll
          for (int n = 0; n < 4; ++n) { const int l = (tid >> 5) + 16 * (4 * hf + n); float o[8]; conv8_fin(W, xv[n], sc, o);
              *(LAS u4*)(dst + l * LP + dg) = (u4){pk2(o[0], o[1]), pk2(o[2], o[3]), pk2(o[4], o[5]), pk2(o[6], o[7])}; } } }
#pragma unroll
    for (int it = tid; it < 128 * 32; it += 512) { const int l = it >> 5, dg = (it & 31) * 8;
        *(LAS u4*)(Vn + l * LPV + dg) = __builtin_nontemporal_load((const u4*)(mlv + (size_t)(t0 + l) * 1024 + h * 256 + dg)); }
    const int fr = lane & 15, fq = lane >> 4, t = 16 * wave + fr;
    const bf16r* cp = (const bf16r*)(ws + WS_CPREV) + (size_t)unit * 32768 + (size_t)fr * 128 + 8 * fq;
    s8v cpa[32];
#pragma unroll
    for (int ks = 0; ks < 4; ++ks)
#pragma unroll
        for (int mt = 0; mt < 8; ++mt) cpa[ks * 8 + mt] = *(const s8v*)(cp + (size_t)(16 * mt) * 128 + 32 * ks);
    __syncthreads();
    if (ONLY_STAGE) return;
    float pmx = 0.f;
    if (wave < 2) { pmx = wave_scan_max(fs[tid], lane); if (tid == 63) fs[896] = pmx; }
    __syncthreads();
    if (wave < 2) { if (wave == 1) pmx = fmaxf(pmx, fs[896]);
        const float M = fmaxf(m_prev, pmx); fs[384 + tid] = M; fs[512 + tid] = __expf(m_prev - M); fs[640 + tid] = __expf(-(fs[128 + tid] + M));
        float qn = 0.f;
#pragma unroll 4
        for (int d8 = 0; d8 < 16; ++d8) { const u4 qv = *(const LAS u4*)(Qc + tid * LP + 8 * d8); const f4 n0 = *(const LAS f4*)(fs + 256 + 8 * d8), n1 = *(const LAS f4*)(fs + 256 + 8 * d8 + 4);
            qn += (bflo(qv.x) * n0.x + bfhi(qv.x) * n0.y) + (bflo(qv.y) * n0.z + bfhi(qv.y) * n0.w) + (bflo(qv.z) * n1.x + bfhi(qv.z) * n1.y) + (bflo(qv.w) * n1.z + bfhi(qv.w) * n1.w); }
        fs[768 + tid] = qn; }
    __syncthreads();
    f4 as[8];
#pragma unroll
    for (int mt = 0; mt < 8; ++mt) as[mt] = (f4){0.f, 0.f, 0.f, 0.f};
#pragma unroll
    for (int ks = 0; ks < 4; ++ks) { const s8v bq = *(const LAS s8v*)(Qc + t * LP + 32 * ks + 8 * fq);
#pragma unroll
        for (int mt = 0; mt < 8; ++mt) if (mt <= wave) { const s8v av = *(const LAS s8v*)(Kc + (16 * mt + fr) * LP + 32 * ks + 8 * fq); as[mt] = MFMA16(av, bq, as[mt]); } }
    __syncthreads();
    const float Mt = fs[384 + t]; float den = 0.f; const int lim = fr - 4 * fq;
#pragma unroll
    for (int mt = 0; mt < 8; ++mt) if (mt <= wave + 1) { float v[4];
        if (mt < wave) {
#pragma unroll
            for (int r = 0; r < 4; ++r) v[r] = as[mt][r] * __expf(fs[16 * mt + 4 * fq + r] - Mt);
        } else if (mt == wave) {
#pragma unroll
            for (int r = 0; r < 4; ++r) v[r] = (r <= lim) ? as[mt][r] * __expf(fs[16 * mt + 4 * fq + r] - Mt) : 0.f;
        } else { v[0] = 0.f; v[1] = 0.f; v[2] = 0.f; v[3] = 0.f; }
        den += (v[0] + v[1]) + (v[2] + v[3]);
        if (mt <= wave || (wave & 1) == 0) *(LAS u2*)(Kc + t * LP + 16 * mt + 4 * fq) = (u2){pk2(v[0], v[1]), pk2(v[2], v[3])}; }
    den += __shfl_xor(den, 16); den += __shfl_xor(den, 32);
    __syncthreads();
    f4 ao[16]; const float iw = fs[512 + t];
#pragma unroll
    for (int mt = 0; mt < 16; ++mt) ao[mt] = (f4){0.f, 0.f, 0.f, 0.f};
#pragma unroll
    for (int ks = 0; ks < 4; ++ks) { const s8v bq = *(const LAS s8v*)(Qc + t * LP + 32 * ks + 8 * fq);
#pragma unroll
        for (int mt = 0; mt < 8; ++mt) ao[mt] = MFMA16(cpa[ks * 8 + mt], bq, ao[mt]); }
#pragma unroll
    for (int ks = 0; ks < 4; ++ks)
#pragma unroll
        for (int mt = 0; mt < 8; ++mt) cpa[ks * 8 + mt] = *(const s8v*)(cp + (size_t)(16 * (mt + 8)) * 128 + 32 * ks);
#pragma unroll
    for (int ks = 0; ks < 4; ++ks) { const s8v bq = *(const LAS s8v*)(Qc + t * LP + 32 * ks + 8 * fq);
#pragma unroll
        for (int mt = 0; mt < 8; ++mt) ao[8 + mt] = MFMA16(cpa[ks * 8 + mt], bq, ao[8 + mt]); }
    const bf16r* mlo = (const bf16r*)(ws + WS_MLO) + (size_t)(t0 + t) * 1024 + h * 256 + 4 * fq; const bf16r* mlz = (const bf16r*)(ws + WS_MLZ) + (size_t)(t0 + t) * 1024 + h * 256 + 4 * fq;
    u2 ovv[16], zvv[16];
#pragma unroll
    for (int mt = 0; mt < 16; ++mt) { ovv[mt] = __builtin_nontemporal_load((const u2*)(mlo + 16 * mt)); zvv[mt] = __builtin_nontemporal_load((const u2*)(mlz + 16 * mt)); }
#pragma unroll
    for (int mt = 0; mt < 16; ++mt) ao[mt] = ao[mt] * iw;
    const int nks = (wave + 2) >> 1;
    for (int ks = 0; ks < nks; ++ks) { const s8v bs = *(const LAS s8v*)(Kc + t * LP + 32 * ks + 8 * fq);
#pragma unroll
        for (int mt = 0; mt < 16; ++mt) { const s8v av = tr_frag(Vn + 32 * ks * LPV + 16 * mt, LPV, fr, fq); ao[mt] = MFMA16(av, bs, ao[mt]); } }
    const float dt = den + iw * fs[768 + t], inv = 1.f / fmaxf(fabsf(dt), fs[640 + t]);
    float ssq = 0.f;
#pragma unroll
    for (int mt = 0; mt < 16; ++mt) { const f4 hv = ao[mt] * inv; ssq += (hv[0] * hv[0] + hv[1] * hv[1]) + (hv[2] * hv[2] + hv[3] * hv[3]); }
    ssq += __shfl_xor(ssq, 16); ssq += __shfl_xor(ssq, 32);
    const float rstd = rsqrtf(ssq * (1.f / 256.f) + EPS) * inv;
    const float* gn = (const float*)a.in[9] + h * 256 + 4 * fq;
    bf16r* ao_out = (bf16r*)(ws + WS_AO) + (size_t)(t0 + t) * 2048 + h * 256 + 4 * fq;
#pragma unroll
    for (int mt = 0; mt < 16; ++mt) { const f4 g = *(const f4*)(gn + 16 * mt); const u2 ov = ovv[mt], zv = zvv[mt];
        const float r0 = ao[mt][0] * rstd * g.x * sigm(bflo(ov.x)) * silu(bflo(zv.x)), r1 = ao[mt][1] * rstd * g.y * sigm(bfhi(ov.x)) * silu(bfhi(zv.x));
        const float r2 = ao[mt][2] * rstd * g.z * sigm(bflo(ov.y)) * silu(bflo(zv.y)), r3 = ao[mt][3] * rstd * g.w * sigm(bfhi(ov.y)) * silu(bfhi(zv.y));
        *(u2*)(ao_out + 16 * mt) = (u2){pk2(r0, r1), pk2(r2, r3)}; }
    __syncthreads();
}

__device__ __forceinline__ void da_combine(const Args& a, int lane, int wave, int G) {
    unsigned char* ws = a.ws; const int gw = blockIdx.x * 8 + wave, NGW = G * 8;
    const float* q1 = (const float*)a.in[10]; const float* k1 = (const float*)a.in[11]; const float* q2 = (const float*)a.in[12]; const float* k2 = (const float*)a.in[13];
    const float s1 = wave_sum(q1[lane] * k1[lane] + q1[lane + 64] * k1[lane + 64]), s2 = wave_sum(q2[lane] * k2[lane] + q2[lane + 64] * k2[lane + 64]);
    const float lam_init = 0.2f, lam = expf(s1) - expf(s2) + lam_init;
    const bf16r* dao = (const bf16r*)(ws + WS_DAO); const bf16r* daz = (const bf16r*)(ws + WS_DAZ); bf16r* ao = (bf16r*)(ws + WS_AO);
    const float* gn = (const float*)a.in[14];
    const int half = lane >> 5, d = (lane & 31) * 4, dv = half * 128 + d;
    for (int it0 = gw; it0 < TOK * 4; it0 += 4 * NGW) {
        u2 o0[4], o1[4], zv[4]; f4 g[4];
#pragma unroll
        for (int k = 0; k < 4; ++k) { const int it = it0 + k * NGW, tok = it >> 2, h = it & 3, b = tok >> 11, s = tok & 2047;
            o0[k] = __builtin_nontemporal_load((const u2*)(dao + ((size_t)(((b * 4 + h) * 2 + 0) * 2 + half) * 2048 + s) * 128 + d)); o1[k] = __builtin_nontemporal_load((const u2*)(dao + ((size_t)(((b * 4 + h) * 2 + 1) * 2 + half) * 2048 + s) * 128 + d));
            g[k] = *(const f4*)(gn + h * 256 + dv); zv[k] = __builtin_nontemporal_load((const u2*)(daz + (size_t)tok * 1024 + h * 256 + dv)); }
#pragma unroll
        for (int k = 0; k < 4; ++k) { const int it = it0 + k * NGW, tok = it >> 2, h = it & 3;
            const float h0 = bflo(o0[k].x) - lam * bflo(o1[k].x), h1 = bfhi(o0[k].x) - lam * bfhi(o1[k].x), h2 = bflo(o0[k].y) - lam * bflo(o1[k].y), h3 = bfhi(o0[k].y) - lam * bfhi(o1[k].y);
            const float rstd = rsqrtf(wave_sum((h0 * h0 + h1 * h1) + (h2 * h2 + h3 * h3)) * (1.f / 256.f) + EPS) * (1.f - lam_init);
            *(u2*)(ao + (size_t)tok * 2048 + 1024 + h * 256 + dv) = (u2){pk2(h0 * rstd * g[k].x * silu(bflo(zv[k].x)), h1 * rstd * g[k].y * silu(bfhi(zv[k].x))), pk2(h2 * rstd * g[k].z * silu(bflo(zv[k].y)), h3 * rstd * g[k].w * silu(bfhi(zv[k].y)))}; } }
}

__device__ __forceinline__ void sgu_unit(const Args& a, LAS unsigned char* lds, int unit, int tid, int lane, int wave) {
    unsigned char* ws = a.ws;
    const int b = unit >> 7, c = (unit >> 3) & 15, g = unit & 7, t0 = b * 2048 + c * 128;
    LAS bf16r* VLn = (LAS bf16r*)lds;
    LAS bf16r* Wt = (LAS bf16r*)(lds + 69632);
    LAS float* fs = (LAS float*)(lds + 104448);
    if (tid < 128) { const f4* p1 = (const f4*)((const float*)(ws + WS_LNS) + (size_t)(t0 + tid) * 32); const f4* p2 = (const f4*)((const float*)(ws + WS_LNQ) + (size_t)(t0 + tid) * 32); float s1 = 0.f, s2 = 0.f;
#pragma unroll
        for (int i = 0; i < 8; ++i) { const f4 x1 = p1[i], x2 = p2[i]; s1 += (x1.x + x1.y) + (x1.z + x1.w); s2 += (x2.x + x2.y) + (x2.z + x2.w); }
        const float mu = s1 * (1.f / DM), var = fmaxf(s2 * (1.f / DM) - mu * mu, 0.f); fs[tid] = mu; fs[128 + tid] = rsqrtf(var + EPS); }
    __syncthreads();
    const bf16r* V = (const bf16r*)(ws + WS_V); const float* lg = (const float*)a.in[18] + g * 256; const float* lb = (const float*)a.in[19] + g * 256;
    const int dgs = (tid & 31) * 8;
    const f4 g0 = *(const f4*)(lg + dgs), g1 = *(const f4*)(lg + dgs + 4), b0 = *(const f4*)(lb + dgs), b1 = *(const f4*)(lb + dgs + 4);
#pragma unroll
    for (int it = tid; it < 128 * 32; it += 512) { const int s = it >> 5, dg = dgs; const float mu = fs[s], rs = fs[128 + s];
        const u4 xv = __builtin_nontemporal_load((const u4*)(V + (size_t)(t0 + s) * 2048 + g * 256 + dg));
        const unsigned w0 = pk2((bflo(xv.x) - mu) * rs * g0.x + b0.x, (bfhi(xv.x) - mu) * rs * g0.y + b0.y), w1 = pk2((bflo(xv.y) - mu) * rs * g0.z + b0.z, (bfhi(xv.y) - mu) * rs * g0.w + b0.w);
        const unsigned w2 = pk2((bflo(xv.z) - mu) * rs * g1.x + b1.x, (bfhi(xv.z) - mu) * rs * g1.y + b1.y), w3 = pk2((bflo(xv.w) - mu) * rs * g1.z + b1.z, (bfhi(xv.w) - mu) * rs * g1.w + b1.w);
        *(LAS u4*)(VLn + s * LPV + dg) = (u4){w0, w1, w2, w3}; }
    const float* sw = (const float*)a.in[20] + (size_t)g * 128 * 128;
#pragma unroll
    for (int it = tid; it < 128 * 16; it += 512) { const int t = it >> 4, sg = (it & 15) * 8; f4 w0 = *(const f4*)(sw + t * 128 + sg), w1 = *(const f4*)(sw + t * 128 + sg + 4);
        if (sg + 0 > t) w0.x = 0.f; if (sg + 1 > t) w0.y = 0.f; if (sg + 2 > t) w0.z = 0.f; if (sg + 3 > t) w0.w = 0.f;
        if (sg + 4 > t) w1.x = 0.f; if (sg + 5 > t) w1.y = 0.f; if (sg + 6 > t) w1.z = 0.f; if (sg + 7 > t) w1.w = 0.f;
        *(LAS u4*)(Wt + t * LP + sg) = (u4){pk2(w0.x, w0.y), pk2(w0.z, w0.w), pk2(w1.x, w1.y), pk2(w1.z, w1.w)}; }
    __syncthreads();
    const int fr = lane & 15, fq = lane >> 4, t = 16 * wave + fr;
    f4 ac[16];
#pragma unroll
    for (int mt = 0; mt < 16; ++mt) ac[mt] = (f4){0.f, 0.f, 0.f, 0.f};
    const int nks = (wave + 2) >> 1;
    for (int ks = 0; ks < nks; ++ks) { const s8v bw = *(const LAS s8v*)(Wt + t * LP + 32 * ks + 8 * fq);
#pragma unroll
        for (int mt = 0; mt < 16; ++mt) { const s8v av = tr_frag(VLn + 32 * ks * LPV + 16 * mt, LPV, fr, fq); ac[mt] = MFMA16(av, bw, ac[mt]); } }
    __syncthreads();
    LAS float* OUTS = (LAS float*)lds;
    { const float sb = ((const float*)a.in[21])[g * 128 + t];
#pragma unroll
      for (int mt = 0; mt < 16; ++mt) *(LAS f4*)(OUTS + t * 260 + 16 * mt + 4 * fq) = ac[mt] + sb; }
    __syncthreads();
    { const int dg = (tid & 31) * 8;
      const bf16r* U = (const bf16r*)a.out + (size_t)t0 * 2048 + g * 256 + dg; const bf16r* Z = U + (size_t)TOK * DM; bf16r* MB = (bf16r*)(ws + WS_MB) + (size_t)t0 * 2048 + g * 256 + dg;
      u4 uw[8], zw[8];
#pragma unroll
      for (int n = 0; n < 8; ++n) { const int tt = (tid >> 5) + 16 * n; uw[n] = __builtin_nontemporal_load((const u4*)(U + (size_t)tt * 2048)); zw[n] = __builtin_nontemporal_load((const u4*)(Z + (size_t)tt * 2048)); }
#pragma unroll
      for (int n = 0; n < 8; ++n) { const int tt = (tid >> 5) + 16 * n; const f4 s0 = *(const LAS f4*)(OUTS + tt * 260 + dg), s1 = *(const LAS f4*)(OUTS + tt * 260 + dg + 4);
          u4 o; o.x = pk2(bflo(uw[n].x) * s0.x * silu(bflo(zw[n].x)), bfhi(uw[n].x) * s0.y * silu(bfhi(zw[n].x))); o.y = pk2(bflo(uw[n].y) * s0.z * silu(bflo(zw[n].y)), bfhi(uw[n].y) * s0.w * silu(bfhi(zw[n].y)));
          o.z = pk2(bflo(uw[n].z) * s1.x * silu(bflo(zw[n].z)), bfhi(uw[n].z) * s1.y * silu(bfhi(zw[n].z))); o.w = pk2(bflo(uw[n].w) * s1.z * silu(bflo(zw[n].w)), bfhi(uw[n].w) * s1.w * silu(bfhi(zw[n].w)));
          *(u4*)(MB + (size_t)tt * 2048) = o; } }
    __syncthreads();
}

__device__ __forceinline__ void final_norm(const Args& a, int lane, int wave, int G) {
    const int gw = blockIdx.x * 8 + wave, NGW = G * 8; const f4* gn = (const f4*)a.in[26];
    for (int m = gw; m < TOK; m += NGW) { f4* xr = (f4*)(a.out + (size_t)m * DM) + lane; f4 v[8]; float s = 0.f;
#pragma unroll
        for (int j = 0; j < 8; ++j) { v[j] = xr[64 * j]; s += (v[j].x * v[j].x + v[j].y * v[j].y) + (v[j].z * v[j].z + v[j].w * v[j].w); }
        const float rstd = rsqrtf(wave_sum(s) * (1.f / DM) + EPS);
#pragma unroll
        for (int j = 0; j < 8; ++j) xr[64 * j] = v[j] * rstd * gn[lane + 64 * j]; }
}

__device__ __forceinline__ void attn_phase(const Args& a, char* lds, int G) {
    using namespace att;
    unsigned char* ws = a.ws;
    const bf16* DQ = (const bf16*)(ws + WS_DAQ); const bf16* DK = (const bf16*)(ws + WS_DAK); const bf16* DV = (const bf16*)(ws + WS_DAV); bf16* DO = (bf16*)(ws + WS_DAO);
    const int W = 1 << 30;
    { const int L = blockIdx.x;
        const int xcd = L & 7, slot = L >> 3, grp = xcd * 2 + (slot >> 4), w = slot & 15, map = w >> 3, half = (w >> 2) & 1, x = w & 3;
        const bf16* Q = DQ + (size_t)(grp * 2 + map) * 2048 * 128; const bf16* K = DK + (size_t)(grp * 2 + map) * 2048 * 128;
        const bf16* V = DV + (size_t)(grp * 2 + half) * 2048 * 128; bf16* O = DO + (size_t)((grp * 2 + map) * 2 + half) * 2048 * 128;
        const int qb0 = x, qb1 = 7 - x;
        BlockRef<bf16, bf16> c0, c1;
        c0.Q = Q + (size_t)qb0 * QB * D; c0.K = K; c0.V = V; c0.O = O + (size_t)qb0 * QB * D; c0.P0 = qb0 * QB;
        c1.Q = Q + (size_t)qb1 * QB * D; c1.K = K; c1.V = V; c1.O = O + (size_t)qb1 * QB * D; c1.P0 = qb1 * QB;
        Seam<bf16> S;
        causal_swa_prime<bf16, bf16>(c0, W, lds, S);
        causal_swa_block<bf16, bf16>(c0, c1, 2048, W, lds, S);
        causal_swa_block<bf16, bf16>(c1, c1, 2048, W, lds, S);
        __syncthreads();
    }
}

#ifndef MK_LAUNCHES
#define MK_LAUNCHES 1
#endif
constexpr int NPHASE = 11;
__global__ void __launch_bounds__(512, 2) mk_fwd(Args args_unused) {
    extern __shared__ __attribute__((aligned(16))) unsigned char lds_raw[];
    LAS unsigned char* lds = (LAS unsigned char*)lds_raw;
    const int G = gridDim.x;
#define TIDS int tid = threadIdx.x; asm volatile("" : "+v"(tid)); const int lane = tid & 63, wave = __builtin_amdgcn_readfirstlane(tid >> 6); (void)tid; (void)lane; (void)wave
    const unsigned long long lohi = karg64(232); const int lo = (int)(unsigned)lohi, hi = (int)(unsigned)(lohi >> 32);
#define IN(k) (lo <= (k) && (k) < hi)
#if MK_LAUNCHES == 1
    if ((int)(unsigned)(karg64(232) >> 32) > NPHASE) cg::this_grid().sync();
    if (threadIdx.x < 2) ((volatile LAS unsigned*)(lds + LDS_BARST))[threadIdx.x] = 0u;
    __syncthreads();
    (void)xcd_barrier_post((unsigned*)(GAS unsigned*)(karg64(224) + WS_BAR), (volatile LAS unsigned*)(lds + LDS_BARST));
#define SEAM(k) do { if (IN(k) && IN((k) + 1)) { XcdBarrier b_; b_.bar = (unsigned*)(GAS unsigned*)(karg64(224) + WS_BAR); b_.x = xb_xcc_id(); b_.st = (volatile LAS unsigned*)(lds + LDS_BARST); xcd_barrier(b_); } } while (0)
#else
#define SEAM(k) do { } while (0)
#endif
    typedef pg8::EpiBf16<0> EpiPlain;
    if (IN(0)) { TIDS; Args args; KWS(args); KIN(args, 0); KIN(args, 1); KIN(args, 2); KIN(args, 3); KIN(args, 4); KIN(args, 7); KIN(args, 8); KIN(args, 15); KIN(args, 23); KIN(args, 24); KIN(args, 25);
        phase0<7>(args, lds, tid, lane, wave, G); }
#ifdef MK_P4_PART
    if (lo == 21) {
        if (MK_P4_PART & 1) { TIDS; Args args; KWS(args); KIN(args, 5); KIN(args, 6); KIN(args, 9);
          __syncthreads();
          for (int rr = 0; rr < MK_INNER; ++rr) for (int u = blockIdx.x; u < 256; u += G) m3_unit(args, lds, u, tid, lane, wave); }
        if (MK_P4_PART & 2) { TIDS; Args args; KWS(args); KIN(args, 10); KIN(args, 11); KIN(args, 12); KIN(args, 13); KIN(args, 14);
          da_combine(args, lane, wave, G); }
    }
#endif
#ifdef MK_P0_PART
    if (lo == 20) { TIDS; Args args; KWS(args); KIN(args, 0); KIN(args, 1); KIN(args, 2); KIN(args, 3); KIN(args, 4); KIN(args, 7); KIN(args, 8); KIN(args, 15); KIN(args, 23); KIN(args, 24); KIN(args, 25);
        phase0<MK_P0_PART>(args, lds, tid, lane, wave, G); }
#endif
    SEAM(0);
    if (IN(1)) {
        Args args; KWS(args); unsigned char* ws = args.ws;
        __syncthreads();
        { pg8::Gemm g{(const bf16r*)(ws + WS_H), (const bf16r*)(ws + WS_WIN), TOK, 8192, 2048}; pg8::StaticOrder S; S.init(TOK, 8192, G, (int)blockIdx.x);
          EpiG1 E{ws}; pg8::gemm_phase<EpiG1, pg8::StaticOrder, true, true>(lds, g, S, E); }
        __syncthreads();
        { pg8::Gemm g{(const bf16r*)(ws + WS_PB), (const bf16r*)(ws + WS_WPP0), TOK, 2048, 256}; pg8::StaticOrder S; S.init(TOK, 2048, G, (int)blockIdx.x);
          EpiPlain E{(bf16r*)(ws + WS_PP0), 2048, nullptr, 0, 0, 1.f}; pg8::gemm_phase<EpiPlain, pg8::StaticOrder, true, true>(lds, g, S, E); }
    }
    SEAM(1);
    if (IN(2)) {
        TIDS; Args args; KWS(args); KIN(args, 5); KIN(args, 6);
        __syncthreads();
        attn_phase(args, (char*)lds_raw, G);
        __syncthreads();
        for (int u = blockIdx.x; u < 256; u += G) m1_unit(args, lds, u, tid, lane, wave);
    }
    SEAM(2);
    if (IN(3)) { TIDS; Args args; KWS(args); m2_scan(args, tid, G); }
    SEAM(3);
    if (IN(4)) {
        { TIDS; Args args; KWS(args); KIN(args, 5); KIN(args, 6); KIN(args, 9);
          __syncthreads();
#ifdef MK_M3_STAGE2
          for (int rr = 0; rr < MK_M3_STAGE2; ++rr) { for (int u = blockIdx.x; u < 256; u += G) m3_unit<1>(args, lds, u, tid, lane, wave); __syncthreads(); }
#endif
          for (int u = blockIdx.x; u < 256; u += G) m3_unit(args, lds, u, tid, lane, wave); }
        { TIDS; Args args; KWS(args); KIN(args, 10); KIN(args, 11); KIN(args, 12); KIN(args, 13); KIN(args, 14);
          da_combine(args, lane, wave, G); }
    }
    SEAM(4);
    if (IN(5)) {
        TIDS; Args args; KWS(args); KOUT(args); KIN(args, 0); KIN(args, 16); KIN(args, 17); KIN(args, 22); KIN(args, 23); KIN(args, 24); KIN(args, 25); unsigned char* ws = args.ws;
        __syncthreads();
        l1_weights(args, lds, lane, wave, G);
        __syncthreads();
        pg8::Gemm g{(const bf16r*)(ws + WS_AO), (const bf16r*)(ws + WS_WOUT0), TOK, 2048, 2048}; pg8::StaticOrder S; S.init(TOK, 2048, G, (int)blockIdx.x);
        EpiRes<false> E{args.in[0], (bf16r*)(ws + WS_X1B), (float*)(ws + WS_SSQA)};
        pg8::gemm_phase<EpiRes<false>, pg8::StaticOrder, true, true>(lds, g, S, E);
    }
    SEAM(5);
    if (IN(6)) {
        Args args; KWS(args); KOUT(args); unsigned char* ws = args.ws;
        __syncthreads();
        pg8::Gemm g{(const bf16r*)(ws + WS_X1B), (const bf16r*)(ws + WS_WG0), TOK, 2048, 2048}; pg8::StaticOrder S; S.init(TOK, 2048, G, (int)blockIdx.x);
        EpiGate E{(const bf16r*)(ws + WS_X1B), (bf16r*)(ws + WS_X2B), (const bf16r*)(ws + WS_PP0), (const float*)(ws + WS_SSQA), (float*)(ws + WS_SSQB)};
        pg8::gemm_phase<EpiGate, pg8::StaticOrder, true, true>(lds, g, S, E);
    }
    SEAM(6);
    if (IN(7)) {
        Args args; KWS(args); KOUT(args); unsigned char* ws = args.ws;
        __syncthreads();
        { pg8::Gemm g{(const bf16r*)(ws + WS_X2B), (const bf16r*)(ws + WS_WCIN), TOK, 6144, 2048}; pg8::StaticOrder S; S.init(TOK, 6144, G, (int)blockIdx.x);
          EpiUVZ E{(bf16r*)args.out, (bf16r*)(ws + WS_V), (const float*)(ws + WS_SSQB), (float*)(ws + WS_LNS), (float*)(ws + WS_LNQ)};
          pg8::gemm_phase<EpiUVZ, pg8::StaticOrder, true, true>(lds, g, S, E); }
        __syncthreads();
        { pg8::Gemm g{(const bf16r*)(ws + WS_PB) + (size_t)TOK * 256, (const bf16r*)(ws + WS_WPP1), TOK, 2048, 256}; pg8::StaticOrder S; S.init(TOK, 2048, G, (int)blockIdx.x);
          EpiPlain E{(bf16r*)(ws + WS_PP1), 2048, nullptr, 0, 0, 1.f}; pg8::gemm_phase<EpiPlain, pg8::StaticOrder, true, true>(lds, g, S, E); }
    }
    SEAM(7);
    if (IN(8)) {
        TIDS; Args args; KWS(args); KOUT(args); KIN(args, 18); KIN(args, 19); KIN(args, 20); KIN(args, 21);
        __syncthreads();
        for (int u = blockIdx.x; u < 512; u += G) sgu_unit(args, lds, u, tid, lane, wave);
    }
    SEAM(8);
    if (IN(9)) {
        Args args; KWS(args); KOUT(args); unsigned char* ws = args.ws;
        __syncthreads();
        pg8::Gemm g{(const bf16r*)(ws + WS_MB), (const bf16r*)(ws + WS_WCOUT), TOK, 2048, 2048}; pg8::StaticOrder S; S.init(TOK, 2048, G, (int)blockIdx.x);
        EpiRes<true> E{(const void*)(ws + WS_X2B), (bf16r*)(ws + WS_X3B), (float*)(ws + WS_SSQC)};
        pg8::gemm_phase<EpiRes<true>, pg8::StaticOrder, true, true>(lds, g, S, E);
    }
    SEAM(9);
    if (IN(10)) {
        Args args; KWS(args); KOUT(args); KIN(args, 26); unsigned char* ws = args.ws;
        __syncthreads();
        pg8::Gemm g{(const bf16r*)(ws + WS_X3B), (const bf16r*)(ws + WS_WG1), TOK, 2048, 2048}; pg8::StaticOrder S; S.init(TOK, 2048, G, (int)blockIdx.x);
        EpiGateFinal E{(const bf16r*)(ws + WS_X3B), args.out, (const bf16r*)(ws + WS_PP1), (const float*)(ws + WS_SSQC), (float*)(ws + WS_SSQA), (unsigned*)(ws + WS_BAR + 16384), (const float*)args.in[26]};
        pg8::gemm_phase<EpiGateFinal, pg8::StaticOrder, true, true>(lds, g, S, E);
    }
#undef IN
#undef SEAM
}

extern "C" void kernel_launch(void* const* d_in, const int* in_sizes, int n_in, void* d_out, int out_size, void* d_ws, size_t ws_size, hipStream_t stream) {
    static int grid = 0;
    if (grid == 0) {
        if (n_in != 27 || out_size != TOK * DM || ws_size < WS_END) { fprintf(stderr, "kernel_launch: unexpected shapes (n_in %d out %d ws %zu)\n", n_in, out_size, ws_size); grid = -1; return; }
        int dev = 0, cus = 0, per_cu = 0;
        (void)hipGetDevice(&dev); (void)hipDeviceGetAttribute(&cus, hipDeviceAttributeMultiprocessorCount, dev);
        (void)hipFuncSetAttribute((const void*)mk_fwd, hipFuncAttributeMaxDynamicSharedMemorySize, LDS_BYTES);
        (void)hipOccupancyMaxActiveBlocksPerMultiprocessor(&per_cu, (const void*)mk_fwd, 512, LDS_BYTES);
        if (per_cu < 1) { fprintf(stderr, "kernel_launch: occupancy query says %d blocks per CU\n", per_cu); per_cu = 1; }
        if (cus != 256) { fprintf(stderr, "kernel_launch: built for a 256-CU device (got %d)\n", cus); grid = -1; return; }
        grid = 256;
        (void)hipGetLastError();
    }
    if (grid < 0) return;
    Args a{};
    for (int i = 0; i < 27; ++i) a.in[i] = d_in[i];
    (void)hipMemsetAsync((unsigned char*)d_ws + WS_BAR, 0, 32768, stream);
    a.out = (float*)d_out; a.ws = (unsigned char*)d_ws;
#if MK_LAUNCHES == 1
    a.ph_lo = 0; a.ph_hi = NPHASE;
    void* kargs[] = {&a};
    hipError_t e = hipLaunchCooperativeKernel((const void*)mk_fwd, dim3(grid), dim3(512), kargs, LDS_BYTES, stream);
    if (e != hipSuccess) fprintf(stderr, "cooperative launch failed: %s (grid %d)\n", hipGetErrorString(e), grid);
#else
    for (int p = 0; p < NPHASE; ++p) { a.ph_lo = p; a.ph_hi = p + 1; hipLaunchKernelGGL(mk_fwd, dim3(grid), dim3(512), LDS_BYTES, stream, a);
#ifdef MK_REP_PHASE
#if defined(MK_P4_PART)
        if (p == 4) { a.ph_lo = 21; a.ph_hi = 22; for (int r = 0; r < MK_REP_N; ++r) hipLaunchKernelGGL(mk_fwd, dim3(grid), dim3(512), LDS_BYTES, stream, a); }
#elif defined(MK_P0_PART)
        if (p == 0) { a.ph_lo = 20; a.ph_hi = 21; for (int r = 0; r < MK_REP_N; ++r) hipLaunchKernelGGL(mk_fwd, dim3(grid), dim3(512), LDS_BYTES, stream, a); }
#else
        if (p == MK_REP_PHASE) for (int r = 0; r < MK_REP_N; ++r) hipLaunchKernelGGL(mk_fwd, dim3(grid), dim3(512), LDS_BYTES, stream, a);
#endif
#endif
    }
#endif
}
```

```cpp
#include <hip/hip_runtime.h>
#include <hip/hip_bf16.h>
#include <hip/hip_cooperative_groups.h>
#include <cstdio>
#include <cstdint>
namespace cg = cooperative_groups;
__device__ __forceinline__ int mk_tid() { int t = (int)threadIdx.x; asm volatile("" : "+v"(t)); return t; }
namespace pg8 {
#define PG8_LAS __attribute__((address_space(3)))
typedef unsigned short bf16_t;
typedef short bf16x8 __attribute__((ext_vector_type(8)));
typedef float f32x4 __attribute__((ext_vector_type(4)));
typedef unsigned u32x4 __attribute__((ext_vector_type(4)));
constexpr int BM = 256, BK = 64, HALF = 128, HTB = HALF * BK * 2  , STAGE_BYTES = 8 * HTB, NXCD = 8, WGM = 8;

__host__ __device__ __forceinline__ int lds_byte(int r, int c) { const int st = (r >> 4) * 2 + (c >> 5), rr = r & 15, cc = c & 31, ob = rr * 64 + cc * 2; return st * 1024 + (ob ^ (((ob >> 9) & 1) << 5)); }
__host__ __device__ __forceinline__ void stage_rc(int b, int& R, int& C) { const int st = b / 1024, sb = b % 1024, swz = sb ^ (((sb >> 9) & 1) << 5); R = (st >> 1) * 16 + swz / 64; C = (st & 1) * 32 + (swz % 64) / 2; }
__host__ __device__ __forceinline__ int perm32(int rho) { const int n = rho >> 4, i = rho & 15; return 8 * (i >> 2) + 4 * n + (i & 3); }

struct Unit { int pm, pn; };
struct Gemm { const bf16_t* A; const bf16_t* Bt; int M, N, K; };

struct StaticOrder {
    int nM, nN, nwg, G, c;
    __host__ __device__ void init(int M, int N, int G_, int c_) { nM = M / BM; nN = N / BM; nwg = nM * nN; G = G_; c = c_; }
    __host__ __device__ bool next(int i, Unit& u) const {
        const long L = (long)i * G + c; if (L >= nwg) return false;
        int wgid = (int)L; { const int q = nwg / NXCD, r = nwg % NXCD, xcd = wgid % NXCD, off = wgid / NXCD; wgid = (xcd < r ? xcd * (q + 1) : r * (q + 1) + (xcd - r) * q) + off; }
        const int nig = WGM * nN, gid = wgid / nig, fm = gid * WGM, gsz = (nM - fm) < WGM ? (nM - fm) : WGM;
        u.pm = fm + ((wgid % nig) % gsz); u.pn = (wgid % nig) / gsz; return true;
    }
    __device__ __forceinline__ void a_ready(const Unit&) const {}
    __device__ __forceinline__ void done(const Unit&) const {}
};

__device__ __forceinline__ unsigned cvt_pk_bf16(float lo, float hi) { unsigned r; asm volatile("v_cvt_pk_bf16_f32 %0, %1, %2" : "=v"(r) : "v"(lo), "v"(hi)); return r; }
typedef float f32x2 __attribute__((ext_vector_type(2)));
__device__ __forceinline__ f32x2 gelu_pk(f32x2 v) {
    const f32x2 av = __builtin_elementwise_abs(v), d = av * 0.2316418882f + 1.0f;
    f32x2 t; t.x = __builtin_amdgcn_rcpf(d.x); t.y = __builtin_amdgcn_rcpf(d.y);
    f32x2 q = t * 0.5307027145f + (-0.7265760135f); q = q * t + 0.7107068705f; q = q * t + (-0.142248368f); q = q * t + 0.127414796f; q = q * t;
    const f32x2 s = (v * v) * (-0.72134752044f);
    f32x2 e; e.x = __builtin_amdgcn_exp2f(s.x); e.y = __builtin_amdgcn_exp2f(s.y);
    const f32x2 m = v * (q * e), r = v - m;
    f32x2 o; o.x = v.x < 0.f ? m.x : r.x; o.y = v.y < 0.f ? m.y : r.y; return o;
}

template <int ACT  > struct EpiBf16 {
    static constexpr bool PERM = true, AFTER_DRAIN = false; static_assert(ACT == 0 || ACT == 1, "EpiBf16: ACT is 0 (none) or 1 (gelu_pk)");
    bf16_t* O; int ldc; const float* bias; int split_cols; size_t split_stride; float scale0;
    __device__ __forceinline__ void operator()(const f32x4 (&acc)[2][2][4][2], const Unit& u, int wr, int wc, int fr, int fq) const {
        const int row0 = u.pm * BM + wr * 64 + fr; int colt = u.pn * BM; bf16_t* base = O;
        float sc = 1.f; if (split_cols) { const int t = colt / split_cols; base += (size_t)t * split_stride; colt -= t * split_cols; if (t == 0) sc = scale0; }
        const int col0 = colt + wc * 32 + 8 * fq, bcol0 = u.pn * BM + wc * 32 + 8 * fq;
        f32x4 bv[2][2];
#pragma unroll
        for (int bj = 0; bj < 2; ++bj)
#pragma unroll
            for (int n = 0; n < 2; ++n) bv[bj][n] = bias ? *(const f32x4*)(bias + bcol0 + bj * HALF + 4 * n) : (f32x4){0.f, 0.f, 0.f, 0.f};
#pragma unroll
        for (int ai = 0; ai < 2; ++ai)
#pragma unroll
            for (int m = 0; m < 4; ++m) { bf16_t* rowp = base + (size_t)(row0 + ai * HALF + m * 16) * ldc + col0;
#pragma unroll
                for (int bj = 0; bj < 2; ++bj) { f32x4 v0 = acc[ai][bj][m][0] + bv[bj][0], v1 = acc[ai][bj][m][1] + bv[bj][1];
                    if (ACT == 1) { f32x2 a = gelu_pk((f32x2){v0[0], v0[1]}), b = gelu_pk((f32x2){v0[2], v0[3]}), c = gelu_pk((f32x2){v1[0], v1[1]}), d = gelu_pk((f32x2){v1[2], v1[3]});
                        v0 = (f32x4){a.x, a.y, b.x, b.y}; v1 = (f32x4){c.x, c.y, d.x, d.y}; }
                    v0 = v0 * sc; v1 = v1 * sc; u32x4 w; w.x = cvt_pk_bf16(v0[0], v0[1]); w.y = cvt_pk_bf16(v0[2], v0[3]); w.z = cvt_pk_bf16(v1[0], v1[1]); w.w = cvt_pk_bf16(v1[2], v1[3]);
                    *(u32x4*)(rowp + bj * HALF) = w; } }
    }
};

template <class Epi, class Sched, bool ALIGN_EPI = false, bool SP2 = false>
__device__ __forceinline__ void gemm_phase(PG8_LAS unsigned char* lds, const Gemm g, const Sched& S, const Epi& E) {
    const int tid = mk_tid(), wid = __builtin_amdgcn_readfirstlane(tid >> 6), lane = tid & 63, wr = wid >> 2, wc = wid & 3, fr = lane & 15, fq = lane >> 4;
    const int K = g.K, nt = K / BK;
    unsigned voffA[2], voffB[2];
#pragma unroll
    for (int i = 0; i < 2; ++i) { int R, C; stage_rc(tid * 16 + i * 8192, R, C); const int Rb = Epi::PERM ? ((R & ~31) + perm32(R & 31)) : R;
        voffA[i] = (unsigned)(R * K + C) * 2u; voffB[i] = (unsigned)(Rb * K + C) * 2u; }
    const size_t kstep = (size_t)(BK * 2);
    const size_t hstep = (size_t)HALF * K * 2;
    const size_t tstep = 2 * hstep;
    const unsigned ldsw = (unsigned)wid * 1024u;
    const int aoff = lds_byte(wr * 64 + fr, fq * 8), boff = lds_byte(wc * 32 + fr, fq * 8);
#define PG8_SA(b, h) (((b) * 2 + (h)) * HTB)
#define PG8_SB(b, h) ((4 + (b) * 2 + (h)) * HTB)
#define PG8_STAGE(bufoff, gbase, voff) do { _Pragma("unroll") for (int _i = 0; _i < 2; ++_i) \
        __builtin_amdgcn_global_load_lds((const unsigned*)((const char*)(gbase) + (voff)[_i]), (PG8_LAS unsigned*)(lds + (bufoff) + ldsw + _i * 8192), 16, 0, 0); } while (0)
#define PG8_LDA(dst, b, h) do { _Pragma("unroll") for (int m = 0; m < 4; ++m) _Pragma("unroll") for (int k = 0; k < 2; ++k) dst[m][k] = *(const PG8_LAS bf16x8*)(lds + PG8_SA(b, h) + aoff + m * 2048 + k * 1024); } while (0)
#define PG8_LDB(dst, b, h) do { _Pragma("unroll") for (int n = 0; n < 2; ++n) _Pragma("unroll") for (int k = 0; k < 2; ++k) dst[n][k] = *(const PG8_LAS bf16x8*)(lds + PG8_SB(b, h) + boff + n * 2048 + k * 1024); } while (0)
#define PG8_MMA(ai, bj, At, Bt) do { __builtin_amdgcn_s_setprio(1); _Pragma("unroll") for (int m = 0; m < 4; ++m) _Pragma("unroll") for (int n = 0; n < 2; ++n) _Pragma("unroll") for (int k = 0; k < 2; ++k) \
        acc[ai][bj][m][n] = __builtin_amdgcn_mfma_f32_16x16x32_bf16(Bt[n][k], At[m][k], acc[ai][bj][m][n], 0, 0, 0); __builtin_amdgcn_s_setprio(0); } while (0)
#define PG8_WAIT_V(n) asm volatile("s_waitcnt vmcnt(" #n ")" ::: "memory")
#define PG8_WAIT_L(n) asm volatile("s_waitcnt lgkmcnt(" #n ")" ::: "memory")
#define PG8_BAR __builtin_amdgcn_s_barrier()
#define PG8_SCHED __builtin_amdgcn_sched_barrier(0)
    Unit cur, nxt; int ui = 0;
    if (!S.next(0, cur)) return;
    f32x4 acc[2][2][4][2];
#pragma unroll
    for (int a = 0; a < 2; ++a)
#pragma unroll
        for (int b = 0; b < 2; ++b)
#pragma unroll
            for (int m = 0; m < 4; ++m)
#pragma unroll
                for (int n = 0; n < 2; ++n) acc[a][b][m][n] = (f32x4){0.f, 0.f, 0.f, 0.f};
    bf16x8 At[4][2], B0[2][2], B1[2][2];
    const char* cA = (const char*)g.A + (size_t)cur.pm * tstep; const char* cB = (const char*)g.Bt + (size_t)cur.pn * tstep;
    S.a_ready(cur);
    if constexpr (SP2) {
        PG8_STAGE(PG8_SB(0, 0), cB, voffB); PG8_STAGE(PG8_SB(0, 1), cB + hstep, voffB); PG8_STAGE(PG8_SA(0, 0), cA, voffA); PG8_STAGE(PG8_SA(0, 1), cA + hstep, voffA);
        if (wr == 1) PG8_BAR;
        PG8_WAIT_V(2); PG8_BAR;
        PG8_STAGE(PG8_SB(1, 0), cB + kstep, voffB); PG8_STAGE(PG8_SA(1, 0), cA + kstep, voffA); PG8_STAGE(PG8_SB(1, 1), cB + hstep + kstep, voffB);
        PG8_WAIT_V(6); PG8_BAR;
    } else {
        PG8_STAGE(PG8_SB(0, 0), cB, voffB); PG8_STAGE(PG8_SA(0, 0), cA, voffA); PG8_STAGE(PG8_SB(0, 1), cB + hstep, voffB); PG8_STAGE(PG8_SA(0, 1), cA + hstep, voffA);
        if (wr == 1) PG8_BAR;
        PG8_WAIT_V(4); PG8_BAR;
        PG8_STAGE(PG8_SB(1, 0), cB + kstep, voffB); PG8_STAGE(PG8_SA(1, 0), cA + kstep, voffA); PG8_STAGE(PG8_SB(1, 1), cB + hstep + kstep, voffB);
        PG8_WAIT_V(6); PG8_BAR;
    }
    for (;;) {
        const bool has_next = S.next(ui + 1, nxt);
        const char* nA = has_next ? (const char*)g.A + (size_t)nxt.pm * tstep : cA; const char* nB = has_next ? (const char*)g.Bt + (size_t)nxt.pn * tstep : cB;
        for (int t = 0; t < nt; t += 2) {
            const bool last = (t == nt - 2);
            const char* a1 = cA + (size_t)(t + 1) * kstep;
            const char* a2 = last ? nA : cA + (size_t)(t + 2) * kstep; const char* b2 = last ? nB : cB + (size_t)(t + 2) * kstep;
            const char* a3 = a2 + kstep; const char* b3 = b2 + kstep;
            if (last && has_next) S.a_ready(nxt);
            if constexpr (SP2) {
            PG8_LDB(B0, 0, 0); PG8_LDB(B1, 0, 1); PG8_SCHED; PG8_LDA(At, 0, 0); PG8_STAGE(PG8_SA(1, 1), a1 + hstep, voffA);
            PG8_WAIT_V(8); PG8_WAIT_L(0); PG8_BAR; PG8_MMA(0, 0, At, B0); PG8_MMA(0, 1, At, B1); PG8_BAR; PG8_SCHED;
            PG8_LDA(At, 0, 1); PG8_STAGE(PG8_SB(0, 0), b2, voffB); PG8_STAGE(PG8_SB(0, 1), b2 + hstep, voffB); PG8_STAGE(PG8_SA(0, 0), a2, voffA);
            PG8_WAIT_V(8); PG8_WAIT_L(0); PG8_BAR; PG8_MMA(1, 0, At, B0); PG8_MMA(1, 1, At, B1); PG8_BAR; PG8_SCHED;
            PG8_LDB(B0, 1, 0); PG8_LDB(B1, 1, 1); PG8_SCHED; PG8_LDA(At, 1, 0); PG8_STAGE(PG8_SA(0, 1), a2 + hstep, voffA);
            PG8_WAIT_V(8); PG8_WAIT_L(0); PG8_BAR; PG8_MMA(0, 0, At, B0); PG8_MMA(0, 1, At, B1); PG8_BAR; PG8_SCHED;
            PG8_LDA(At, 1, 1); PG8_STAGE(PG8_SB(1, 0), b3, voffB); PG8_STAGE(PG8_SB(1, 1), b3 + hstep, voffB); PG8_STAGE(PG8_SA(1, 0), a3, voffA);
            PG8_WAIT_V(8); PG8_WAIT_L(0); PG8_BAR; PG8_MMA(1, 0, At, B0); PG8_MMA(1, 1, At, B1); PG8_BAR; PG8_SCHED;
            } else {
            PG8_LDB(B0, 0, 0); PG8_SCHED; PG8_LDA(At, 0, 0); PG8_STAGE(PG8_SA(1, 1), a1 + hstep, voffA);
            PG8_WAIT_L(8); PG8_BAR; PG8_WAIT_L(0); PG8_MMA(0, 0, At, B0); PG8_BAR; PG8_SCHED;
            PG8_LDB(B1, 0, 1); PG8_STAGE(PG8_SB(0, 0), b2, voffB);
            PG8_BAR; PG8_WAIT_L(0); PG8_MMA(0, 1, At, B1); PG8_BAR;
            PG8_LDA(At, 0, 1); PG8_STAGE(PG8_SA(0, 0), a2, voffA);
            PG8_BAR; PG8_WAIT_L(0); PG8_MMA(1, 0, At, B0); PG8_BAR; PG8_SCHED;
            PG8_STAGE(PG8_SB(0, 1), b2 + hstep, voffB);
            PG8_WAIT_V(6); PG8_BAR; PG8_MMA(1, 1, At, B1); PG8_BAR;
            PG8_LDB(B0, 1, 0); PG8_SCHED; PG8_LDA(At, 1, 0); PG8_STAGE(PG8_SA(0, 1), a2 + hstep, voffA);
            PG8_WAIT_L(8); PG8_BAR; PG8_WAIT_L(0); PG8_MMA(0, 0, At, B0); PG8_BAR; PG8_SCHED;
            PG8_LDB(B1, 1, 1); PG8_STAGE(PG8_SB(1, 0), b3, voffB);
            PG8_BAR; PG8_WAIT_L(0); PG8_MMA(0, 1, At, B1); PG8_BAR;
            PG8_LDA(At, 1, 1); PG8_STAGE(PG8_SA(1, 0), a3, voffA);
            PG8_BAR; PG8_WAIT_L(0); PG8_MMA(1, 0, At, B0); PG8_BAR; PG8_SCHED;
            PG8_STAGE(PG8_SB(1, 1), b3 + hstep, voffB);
            PG8_WAIT_V(6); PG8_BAR; PG8_MMA(1, 1, At, B1); PG8_BAR;
            }
        }
        if constexpr (ALIGN_EPI) { if (wr == 0) PG8_BAR; }
        if constexpr (!Epi::AFTER_DRAIN) { E(acc, cur, wr, wc, fr, fq); S.done(cur); }
        if (!has_next) break;
#pragma unroll
        for (int a = 0; a < 2; ++a)
#pragma unroll
            for (int b = 0; b < 2; ++b)
#pragma unroll
                for (int m = 0; m < 4; ++m)
#pragma unroll
                    for (int n = 0; n < 2; ++n) acc[a][b][m][n] = (f32x4){0.f, 0.f, 0.f, 0.f};
        cur = nxt; cA = nA; cB = nB; ++ui;
        if constexpr (ALIGN_EPI) { if (wr == 1) PG8_BAR; }
    }
    PG8_WAIT_V(0);
    if constexpr (!ALIGN_EPI) { if (wr == 0) PG8_BAR; }
    PG8_BAR;
    if constexpr (Epi::AFTER_DRAIN) { E.fused(acc, cur, wr, wc, fr, fq, lds, wid, lane); S.done(cur); }
#undef PG8_SA
#undef PG8_SB
#undef PG8_STAGE
#undef PG8_LDA
#undef PG8_LDB
#undef PG8_MMA
#undef PG8_WAIT_V
#undef PG8_WAIT_L
#undef PG8_BAR
#undef PG8_SCHED
}
}

namespace att {
constexpr int D = 128;
constexpr float THR = 8.f;
constexpr bool WSKIP = false;
constexpr float SCALE = 0.08838834764831845f;
constexpr int NW = 8, QBLK = 32, KVBLK = 64, QB = NW * QBLK;
constexpr int SHM_V = KVBLK * D * 2, SHM_K = KVBLK * D * 2;
constexpr int LDS_BYTES = 2 * SHM_V + 2 * SHM_K + NW * 64 * 4;

using bf16 = __hip_bfloat16;
typedef short bf16x8 __attribute__((ext_vector_type(8)));
typedef short s16x4 __attribute__((ext_vector_type(4)));
typedef float f32x16 __attribute__((ext_vector_type(16)));
typedef float f32x4 __attribute__((ext_vector_type(4)));
typedef unsigned u32x4 __attribute__((ext_vector_type(4)));
template <class A, class Bt> struct same_t { static constexpr bool v = false; };
template <class A> struct same_t<A, A> { static constexpr bool v = true; };

#define KSWZ(row, colB) ((row) * 256 + ((colB) ^ (((row) & 7) << 4)))
#define SBAR() __builtin_amdgcn_sched_barrier(0)
__device__ __forceinline__ int v_st(int k, int c) { const int kk = (k & ~0xC) | ((k & 4) << 1) | ((k & 8) >> 1); return ((kk >> 3) * 4 + (c >> 5)) * 512 + ((kk & 7) * 32 + (c & 31)) * 2; }
__device__ __forceinline__ int v_rd_base(int lane) { return ((lane & 3) << 3) | (((lane >> 2) & 3) << 6) | (((lane >> 4) & 1) << 5) | (((lane >> 5) & 1) << 8); }
constexpr int v_rd_off(int d0, int ks, int half) { return d0 * 512 + ks * 4096 + half * 2048; }
__device__ __forceinline__ int crow(int r, int hi) { return (r & 3) + 8 * (r >> 2) + 4 * hi; }
__device__ __forceinline__ unsigned cvtpk(float lo, float hi) {
    unsigned r; asm volatile("v_cvt_pk_bf16_f32 %0, %1, %2" : "=v"(r) : "v"(lo), "v"(hi)); return r;
}
__device__ __forceinline__ bf16x8 pack8(f32x4 a, f32x4 b) {
    u32x4 w = {cvtpk(a[0], a[1]), cvtpk(a[2], a[3]), cvtpk(b[0], b[1]), cvtpk(b[2], b[3])};
    return *reinterpret_cast<bf16x8*>(&w);
}
template <class T> __device__ __forceinline__ bf16x8 load8(const T* p) {
    if constexpr (same_t<T, float>::v) { return pack8(*(const f32x4*)p, *(const f32x4*)(p + 4)); }
    else { return *reinterpret_cast<const bf16x8*>(p); }
}
__device__ __forceinline__ void mask_tile(f32x16& p0, f32x16& p1, int dq, unsigned W) {
    const float NEG = -__builtin_inff();
#pragma unroll
    for (int r = 0; r < 16; ++r) {
        const int c = (r & 3) + 8 * (r >> 2);
        if ((unsigned)(dq - c) >= W) p0[r] = NEG;
        if ((unsigned)(dq - c - 32) >= W) p1[r] = NEG;
    }
}
__device__ __forceinline__ void partialSM(f32x16& p0, f32x16& p1, float& m_reg, float& mn, float& alpha) {
    float pmax = p0[0]; for (int r = 1; r < 16; ++r) pmax = fmaxf(pmax, p0[r]); for (int r = 0; r < 16; ++r) pmax = fmaxf(pmax, p1[r]);
    { auto rr = __builtin_amdgcn_permlane32_swap(__float_as_uint(pmax), __float_as_uint(pmax), false, false);
      pmax = fmaxf(__uint_as_float(rr[0]), __uint_as_float(rr[1])); }
    constexpr float C2 = 1.4426950408889634f * SCALE;
    if (__builtin_expect(__all((pmax - m_reg) * SCALE <= THR), 1)) { mn = m_reg; alpha = 1.f; }
    else { mn = fmaxf(m_reg, pmax); alpha = __builtin_amdgcn_exp2f((m_reg - mn) * C2); m_reg = mn; }
    const float mnL = -mn * C2;
    for (int r = 0; r < 16; ++r) p0[r] = fmaf(p0[r], C2, mnL); for (int r = 0; r < 16; ++r) p1[r] = fmaf(p1[r], C2, mnL);
    for (int r = 0; r < 16; ++r) p0[r] = __builtin_amdgcn_exp2f(p0[r]);
}
__device__ __forceinline__ void finishSM(f32x16& p0, f32x16& p1, float alpha, float& l_reg, bf16x8& pa0, bf16x8& pa1, bf16x8& pa2, bf16x8& pa3) {
    for (int r = 0; r < 16; ++r) p1[r] = __builtin_amdgcn_exp2f(p1[r]);
    float ps = 0; for (int r = 0; r < 16; ++r) ps += p0[r]; for (int r = 0; r < 16; ++r) ps += p1[r];
    { auto rr = __builtin_amdgcn_permlane32_swap(__float_as_uint(ps), __float_as_uint(ps), false, false);
      ps = __uint_as_float(rr[0]) + __uint_as_float(rr[1]); }
    l_reg = l_reg * alpha + ps;
#define PK4(P, B_, OUT) do { unsigned a0 = cvtpk(P[B_+0], P[B_+1]), a1 = cvtpk(P[B_+2], P[B_+3]);                          \
        unsigned b0 = cvtpk(P[B_+4], P[B_+5]), b1 = cvtpk(P[B_+6], P[B_+7]);                                             \
        auto r0 = __builtin_amdgcn_permlane32_swap(a0, b0, false, false); auto r1 = __builtin_amdgcn_permlane32_swap(a1, b1, false, false); \
        u32x4 w = {r0[0], r1[0], r0[1], r1[1]}; OUT = *reinterpret_cast<bf16x8*>(&w); } while (0)
    PK4(p0, 0, pa0); PK4(p0, 8, pa1); PK4(p1, 0, pa2); PK4(p1, 8, pa3);
#undef PK4
}
template <int KB, bool SK>
__device__ __forceinline__ void qkt(f32x16& p0, f32x16& p1, const char* K_lds, int r32, int hi, const bf16x8* qr, bool act) {
    if (SK && !act) { const float NEG = -__builtin_inff();
#pragma unroll
        for (int r = 0; r < 16; ++r) { p0[r] = NEG; p1[r] = NEG; } return; }
    p0 = f32x16{}; p1 = f32x16{};
    const char* kb[4];
#pragma unroll
    for (int dd = 0; dd < 4; ++dd) kb[dd] = K_lds + KB * SHM_K + KSWZ(r32, (dd * 16 + hi * 8) * 2);
#pragma unroll
    for (int d0 = 0; d0 < 8; ++d0) { const char* a = kb[d0 & 3] + (d0 >> 2) * 128;
        bf16x8 b0 = *reinterpret_cast<const bf16x8*>(a);
        bf16x8 b1 = *reinterpret_cast<const bf16x8*>(a + 32 * 256);
        p0 = __builtin_amdgcn_mfma_f32_32x32x16_bf16(b0, qr[d0], p0, 0, 0, 0);
        p1 = __builtin_amdgcn_mfma_f32_32x32x16_bf16(b1, qr[d0], p1, 0, 0, 0); }
}
template <int VB, bool SK>
__device__ __forceinline__ void pv_tile(f32x16* o, int vb0, bf16x8 pa0, bf16x8 pa1, bf16x8 pa2, bf16x8 pa3, bool act) {
    if (SK && !act) return;
#define TRRD(dst, off) asm volatile("ds_read_b64_tr_b16 %0, %1 offset:%2" : "=&v"(dst) : "v"(vb0), "i"(off) : "memory")
#define PV_D0(d0) do { s16x4 l0, l1, l2, l3, h0, h1, h2, h3; constexpr int b_ = VB * SHM_V + v_rd_off(d0, 0, 0);     \
        TRRD(l0, b_); TRRD(h0, b_ + 2048); TRRD(l1, b_ + 4096); TRRD(h1, b_ + 6144); TRRD(l2, b_ + 8192); TRRD(h2, b_ + 10240); TRRD(l3, b_ + 12288); TRRD(h3, b_ + 14336); \
        asm volatile("s_waitcnt lgkmcnt(0)" ::: "memory"); SBAR();                 \
        o[d0] = __builtin_amdgcn_mfma_f32_32x32x16_bf16(pa0, (bf16x8){l0[0], l0[1], l0[2], l0[3], h0[0], h0[1], h0[2], h0[3]}, o[d0], 0, 0, 0);   \
        o[d0] = __builtin_amdgcn_mfma_f32_32x32x16_bf16(pa1, (bf16x8){l1[0], l1[1], l1[2], l1[3], h1[0], h1[1], h1[2], h1[3]}, o[d0], 0, 0, 0);   \
        o[d0] = __builtin_amdgcn_mfma_f32_32x32x16_bf16(pa2, (bf16x8){l2[0], l2[1], l2[2], l2[3], h2[0], h2[1], h2[2], h2[3]}, o[d0], 0, 0, 0);   \
        o[d0] = __builtin_amdgcn_mfma_f32_32x32x16_bf16(pa3, (bf16x8){l3[0], l3[1], l3[2], l3[3], h3[0], h3[1], h3[2], h3[3]}, o[d0], 0, 0, 0); } while (0)
    PV_D0(0); PV_D0(1); PV_D0(2); PV_D0(3);
#undef PV_D0
#undef TRRD
}

template <class TIn, class TOut> struct BlockRef { const TIn* Q; const TIn* K; const TIn* V; TOut* O; int P0; };
template <class TIn> struct Seam {
    bf16x8 qr[8];
    bf16x8 st_v0, st_v1, st_k0, st_k1; f32x4 sf0, sf1, sf2, sf3;
    f32x4 tq[16];
};
__device__ __forceinline__ int swa_jlo(int P0, int W) { const int lowk = P0 - W + 1; return lowk > 0 ? lowk / KVBLK : 0; }
#define ROW(p, k0, rr) ((p) + (size_t)((k0) + (rr)) * D + sc)
#define VMW() asm volatile("s_waitcnt vmcnt(0)" ::: "memory")
#define VMWN(n) asm volatile("s_waitcnt vmcnt(%0)" :: "i"(n) : "memory")
#define SLOAD_H(Kp, Vp, k0) do { S.st_v0 = load8<TIn>(ROW(Vp, k0, sr)); S.st_v1 = load8<TIn>(ROW(Vp, k0, 32 + sr));              \
                         S.st_k0 = load8<TIn>(ROW(Kp, k0, sr)); S.st_k1 = load8<TIn>(ROW(Kp, k0, 32 + sr)); } while (0)
#define SWRITE_HK(bf) do { *(bf16x8*)(K_lds + (bf) * SHM_K + kws) = S.st_k0; *(bf16x8*)(K_lds + (bf) * SHM_K + kws + 32 * 256) = S.st_k1; } while (0)
#define SWRITE_HV(bf) do { *(bf16x8*)(V_lds + (bf) * SHM_V + vst0) = S.st_v0; *(bf16x8*)(V_lds + (bf) * SHM_V + vst1) = S.st_v1; } while (0)
#define SWRITE_H(bf) do { SWRITE_HV(bf); SWRITE_HK(bf); } while (0)
#define SLOAD_F(p, k0) do { S.sf0 = *(const f32x4*)ROW(p, k0, sr); S.sf1 = *(const f32x4*)(ROW(p, k0, sr) + 4);                \
                            S.sf2 = *(const f32x4*)ROW(p, k0, 32 + sr); S.sf3 = *(const f32x4*)(ROW(p, k0, 32 + sr) + 4); } while (0)
#define SWRITE_KF(bf) do { *(bf16x8*)(K_lds + (bf) * SHM_K + kws) = pack8(S.sf0, S.sf1); *(bf16x8*)(K_lds + (bf) * SHM_K + kws + 32 * 256) = pack8(S.sf2, S.sf3); } while (0)
#define SWRITE_VF(bf) do { *(bf16x8*)(V_lds + (bf) * SHM_V + vst0) = pack8(S.sf0, S.sf1); *(bf16x8*)(V_lds + (bf) * SHM_V + vst1) = pack8(S.sf2, S.sf3); } while (0)
template <class TIn, class TOut>
__device__ __forceinline__ void causal_swa_prime(const BlockRef<TIn, TOut>& cur, int W, char* lds, Seam<TIn>& S) {
    constexpr bool F32 = same_t<TIn, float>::v;
    const int tid = mk_tid(), wid = __builtin_amdgcn_readfirstlane(tid >> 6), lane = tid & 63, r32 = lane & 31, hi = lane >> 5;
    const int sr = tid >> 4, sc = (tid & 15) * 8, kws = KSWZ(sr, sc * 2); char* K_lds = lds + 2 * SHM_V;
    const int kb0 = swa_jlo(cur.P0, W) * KVBLK;
    for (int d0 = 0; d0 < 8; ++d0) S.qr[d0] = load8<TIn>(cur.Q + (size_t)(wid * QBLK + r32) * D + d0 * 16 + hi * 8);
    if constexpr (F32) { SLOAD_F((const float*)cur.K, kb0); VMW(); SWRITE_KF(0); SBAR(); SLOAD_F((const float*)cur.V, kb0); }
    else { SLOAD_H(cur.K, cur.V, kb0); VMW(); SWRITE_HK(0); }
    __syncthreads();
}
template <class TIn, class TOut>
__device__ __forceinline__ void causal_swa_block(const BlockRef<TIn, TOut>& cur, const BlockRef<TIn, TOut>& nxt, int skv, int W, char* lds, Seam<TIn>& S) {
    constexpr bool F32 = same_t<TIn, float>::v;
    const int tid = mk_tid(), wid = __builtin_amdgcn_readfirstlane(tid >> 6), lane = tid & 63, r32 = lane & 31, hi = lane >> 5;
    const int j_lo = swa_jlo(cur.P0, W);
    int j_hi = (cur.P0 + QB - 1) / KVBLK + 1; if (j_hi > skv / KVBLK) j_hi = skv / KVBLK;
    const int NT = j_hi - j_lo;
    const int kbn = swa_jlo(nxt.P0, W) * KVBLK;
    const int qlo = cur.P0 + wid * QBLK, qm = qlo + r32 - 4 * hi;
    char* V_lds = lds; char* K_lds = lds + 2 * SHM_V;
    float* ws = (float*)(lds + 2 * SHM_V + 2 * SHM_K) + wid * 64; float* li_l = ws, * al_l = ws + 32;
    float m_reg = -1e30f, l_reg = 0; f32x16 o[4] = {};
    const int sr = tid >> 4, sc = (tid & 15) * 8, vst0 = v_st(sr, sc), vst1 = v_st(32 + sr, sc), kws = KSWZ(sr, sc * 2);
    const int vb0 = (int)(uintptr_t)V_lds + v_rd_base(lane);
    const TIn* Kh = cur.K; const TIn* Vh = cur.V;
#define RESC(a) do { if (__any((a) < 1.f)) { if (hi == 0) al_l[r32] = (a); asm volatile("s_waitcnt lgkmcnt(0)" ::: "memory");              \
                     for (int d_ = 0; d_ < 4; ++d_) for (int r = 0; r < 16; ++r) o[d_][r] *= al_l[crow(r, hi)]; } } while (0)
#define KBASE(t) ((j_lo + (t)) * KVBLK)
#define ACT(t) (KBASE(t) <= qlo + QBLK - 1 && KBASE(t) + KVBLK - 1 >= qlo - W + 1)
#define MASKT(P0_, P1_, t) do { const int kb_ = KBASE(t); if ((!SK || ACT(t)) && (kb_ + KVBLK - 1 > qlo || kb_ <= qlo + QBLK - 1 - W)) mask_tile(P0_, P1_, qm - kb_, (unsigned)W); } while (0)
    constexpr int NQL = F32 ? 16 : 8;
    constexpr bool SK = WSKIP && !F32;
#define SEAM_K0() do { VMWN(NQL); if constexpr (F32) { SWRITE_KF(0); SBAR(); SLOAD_F((const float*)nxt.V, kbn); } else { SWRITE_HK(0); } SBAR(); } while (0)
    f32x16 pA0, pA1, pB0, pB1; float mnA, mnB, alA, alB; bf16x8 pa0, pa1, pa2, pa3;
    if constexpr (F32) { VMW(); SWRITE_VF(0); SBAR(); } else { SWRITE_HV(0); SBAR(); }
    if (NT > 1) { if constexpr (F32) SLOAD_F((const float*)Kh, KBASE(1)); else SLOAD_H(Kh, Vh, KBASE(1)); }
    SBAR(); qkt<0, SK>(pA0, pA1, K_lds, r32, hi, S.qr, ACT(0));
    if constexpr (F32) { if (NT > 1) { VMW(); SWRITE_KF(1); SBAR(); SLOAD_F((const float*)Vh, KBASE(1)); } }
    MASKT(pA0, pA1, 0); partialSM(pA0, pA1, m_reg, mnA, alA);
    if (NT > 1) { VMW(); if constexpr (F32) { SWRITE_VF(1); SBAR(); if (NT > 2) SLOAD_F((const float*)Kh, KBASE(2)); } else SWRITE_H(1); }
    __syncthreads();
#define HALF_STEP(PX0, PX1, mnX, alX, PY0, PY1, alY, t, KB, VB, SB) do {                                                      \
        SBAR(); qkt<KB, SK>(PX0, PX1, K_lds, r32, hi, S.qr, ACT(t));                                             \
        finishSM(PY0, PY1, alY, l_reg, pa0, pa1, pa2, pa3); SBAR();                                                           \
        if ((t) + 1 < NT) { if constexpr (F32) { VMW(); SWRITE_KF(SB); SBAR(); SLOAD_F((const float*)Vh, KBASE((t) + 1)); }  \
                            else { SLOAD_H(Kh, Vh, KBASE((t) + 1)); } SBAR(); }                                               \
        pv_tile<VB, SK>(o, vb0, pa0, pa1, pa2, pa3, ACT((t) - 1)); MASKT(PX0, PX1, (t)); partialSM(PX0, PX1, m_reg, mnX, alX);                                        \
        __syncthreads();                                                                                                      \
        if ((t) + 1 < NT) { VMW(); if constexpr (F32) { SWRITE_VF(SB); SBAR(); if ((t) + 2 < NT) SLOAD_F((const float*)Kh, KBASE((t) + 2)); } \
                            else { SWRITE_H(SB); } }                                                                          \
        RESC(alX); __syncthreads(); } while (0)
    for (int t = 1; t + 1 < NT; t += 2) {
        HALF_STEP(pB0, pB1, mnB, alB, pA0, pA1, alA, t, 1, 0, 0);
        HALF_STEP(pA0, pA1, mnA, alA, pB0, pB1, alB, t + 1, 0, 1, 1);
    }
    const bool even = (NT & 1) == 0;
    if (even) { SBAR(); qkt<1, SK>(pB0, pB1, K_lds, r32, hi, S.qr, ACT(NT - 1)); SBAR(); }
#define QROW(e) (nxt.Q + (size_t)(wid * QBLK + r32) * D + ((e) >> 1) * 16 + hi * 8 + ((e) & 1) * 4)
    if constexpr (F32) { SLOAD_F((const float*)nxt.K, kbn); SBAR();
#pragma unroll
        for (int e = 0; e < 8; ++e) S.tq[e] = *(const f32x4*)QROW(e); }
    else { SLOAD_H(nxt.K, nxt.V, kbn); SBAR();
#pragma unroll
        for (int d0 = 0; d0 < 8; ++d0) S.qr[d0] = load8<TIn>(nxt.Q + (size_t)(wid * QBLK + r32) * D + d0 * 16 + hi * 8); }
    SBAR();
    finishSM(pA0, pA1, alA, l_reg, pa0, pa1, pa2, pa3); SBAR();
    if constexpr (F32) {
#pragma unroll
        for (int e = 8; e < 16; ++e) S.tq[e] = *(const f32x4*)QROW(e); SBAR(); }
#undef QROW
    pv_tile<0, SK>(o, vb0, pa0, pa1, pa2, pa3, ACT(even ? NT - 2 : NT - 1));
    if (even) { MASKT(pB0, pB1, NT - 1); partialSM(pB0, pB1, m_reg, mnB, alB); __syncthreads(); RESC(alB);
        finishSM(pB0, pB1, alB, l_reg, pa0, pa1, pa2, pa3); SBAR(); pv_tile<1, SK>(o, vb0, pa0, pa1, pa2, pa3, ACT(NT - 1)); }
    SBAR(); SEAM_K0();
    if (hi == 0) li_l[r32] = l_reg; asm volatile("s_waitcnt lgkmcnt(0)" ::: "memory");
    float rli[16];
#pragma unroll
    for (int r = 0; r < 16; ++r) rli[r] = __builtin_amdgcn_rcpf(li_l[crow(r, hi)]);
    TOut* Ow = cur.O + (size_t)(wid * QBLK) * D;
#pragma unroll
    for (int r = 0; r < 16; ++r) { const int orow = crow(r, hi);
#pragma unroll
        for (int d0 = 0; d0 < 4; ++d0) { const float v = o[d0][r] * rli[r];
            if constexpr (same_t<TOut, float>::v) { Ow[(size_t)orow * D + d0 * 32 + r32] = v; }
            else { const float vn = __shfl_xor(v, 1);
                   if ((r32 & 1) == 0) *(unsigned*)(Ow + (size_t)orow * D + d0 * 32 + r32) = cvtpk(v, vn); } } }
    if constexpr (F32) {
#pragma unroll
        for (int d0 = 0; d0 < 8; ++d0) S.qr[d0] = pack8(S.tq[2 * d0], S.tq[2 * d0 + 1]); }
    __syncthreads();
#undef RESC
#undef KBASE
#undef ACT
#undef MASKT
#undef SEAM_K0
#undef HALF_STEP
}
#undef ROW
#undef VMW
#undef VMWN
#undef SLOAD_H
#undef SWRITE_HK
#undef SWRITE_HV
#undef SWRITE_H
#undef SLOAD_F
#undef SWRITE_KF
#undef SWRITE_VF
}

#define GAS __attribute__((address_space(1)))
#define LAS __attribute__((address_space(3)))
typedef unsigned short bf16r;
typedef float f4 __attribute__((ext_vector_type(4)));
typedef unsigned u4 __attribute__((ext_vector_type(4)));
typedef unsigned u2 __attribute__((ext_vector_type(2)));
typedef short s8v __attribute__((ext_vector_type(8)));

constexpr int TOK = 8192, DM = 2048;
constexpr float EPS = 1e-6f;
constexpr size_t MiB = 1u << 20;
constexpr size_t WS_WIN = 0;
constexpr size_t WS_WOUT0 = 32 * MiB, WS_WG0 = 40 * MiB, WS_WPP0 = 48 * MiB;
constexpr size_t WS_ROPE = 49 * MiB;
constexpr size_t WS_IFG = 53 * MiB;
constexpr size_t WS_BCUM = WS_IFG + 256 * 1024;
constexpr size_t WS_NLOC = WS_BCUM + 128 * 1024;
constexpr size_t WS_NPREV = WS_NLOC + 128 * 1024;
constexpr size_t WS_MSC = WS_NPREV + 128 * 1024;
constexpr size_t WS_SSQA = 54 * MiB, WS_SSQB = 55 * MiB, WS_SSQC = 56 * MiB, WS_LNS = 57 * MiB, WS_LNQ = 58 * MiB;
constexpr size_t WS_H = 60 * MiB;
constexpr size_t WS_PB = 92 * MiB;
constexpr size_t WS_G1 = 100 * MiB;
constexpr size_t WS_MLQK = WS_G1, WS_MLV = WS_G1 + 16 * MiB, WS_MLO = WS_G1 + 32 * MiB, WS_MLZ = WS_G1 + 48 * MiB, WS_DAZ = WS_G1 + 64 * MiB,
                 WS_DAQ = WS_G1 + 80 * MiB, WS_DAK = WS_G1 + 96 * MiB, WS_DAV = WS_G1 + 112 * MiB;
constexpr size_t WS_PP0 = 228 * MiB;
constexpr size_t WS_CPREV = WS_DAQ;
constexpr size_t WS_AO = WS_DAK;
constexpr size_t WS_WCIN = 100 * MiB, WS_WCOUT = 124 * MiB, WS_WG1 = 132 * MiB, WS_WPP1 = 140 * MiB;
constexpr size_t WS_X2B = 141 * MiB;
constexpr size_t WS_PP1 = 205 * MiB;
constexpr size_t WS_V = WS_H, WS_MB = 0, WS_X1B = WS_H, WS_X3B = WS_H, WS_DAO = WS_H, WS_CLOC = 0;
constexpr size_t WS_END = 260 * MiB;
constexpr int LDS_BYTES = 147456;
constexpr size_t WS_BAR = 59 * MiB;
constexpr int LDS_BARST = 147440;

struct Args { const void* in[27]; float* out; unsigned char* ws; int ph_lo, ph_hi; };
__device__ __forceinline__ unsigned long long karg64(int off) {
    unsigned long long r;
    asm volatile("s_load_dwordx2 %0, %1, %2\n\ts_waitcnt lgkmcnt(0)" : "=s"(r) : "s"(__builtin_amdgcn_kernarg_segment_ptr()), "n"(off) : "memory");
    return r;
}
#define KIN(a_, k) (a_).in[k] = (const void*)(GAS const void*)karg64(8 * (k))
#define KOUT(a_) (a_).out = (float*)(GAS float*)karg64(216)
#define KWS(a_) (a_).ws = (unsigned char*)(GAS unsigned char*)karg64(224)

__device__ __forceinline__ unsigned pk2(float lo, float hi) { return pg8::cvt_pk_bf16(lo, hi); }
__device__ __forceinline__ float bflo(unsigned w) { return __uint_as_float(w << 16); }
__device__ __forceinline__ float bfhi(unsigned w) { return __uint_as_float(w & 0xffff0000u); }
__device__ __forceinline__ float wave_sum(float v) {
#pragma unroll
    for (int o = 1; o < 64; o <<= 1) v += __shfl_xor(v, o);
    return v;
}
__device__ __forceinline__ float sigm(float x) { return __builtin_amdgcn_rcpf(1.f + __expf(-x)); }
__device__ __forceinline__ float silu(float x) { return x * __builtin_amdgcn_rcpf(1.f + __expf(-x)); }
#define LDS_WAIT() asm volatile("s_waitcnt lgkmcnt(0)" ::: "memory")

__device__ __forceinline__ int ropeperm(int r) { const int blk = r & ~127, p = r & 127; return blk + 64 * ((p >> 2) & 1) + 16 * (p >> 5) + 4 * ((p >> 3) & 3) + (p & 3); }
__device__ __forceinline__ int win_src_col(int nd) {
    const int seg = nd >> 10, r = nd & 1023;
    if (seg < 2) return nd;
    if (seg == 2) return 2056 + r;
    if (seg == 3) return 3080 + r;
    if (seg == 4) return 4104 + ropeperm(r);
    if (seg == 5) return 5128 + ropeperm(r);
    if (seg == 6) return 6152 + r;
    return 7176 + r;
}
template <bool WINMAP>
__device__ __forceinline__ void transpose_item(const float* W, int K, int Nsrc, int Ndst, const float* gs, bf16r* WT, LAS unsigned* scr, int item, int lane) {
    const int nblk = Ndst >> 6, kb = item / nblk, nb = item - kb * nblk, k0 = kb * 64, n0 = nb * 64;
    const int nd = n0 + lane; const int src = WINMAP ? win_src_col(nd) : nd;
    const float* wp = W + (size_t)k0 * Nsrc + src;
    float v[64];
#pragma unroll
    for (int i = 0; i < 64; ++i) v[i] = __builtin_nontemporal_load(wp + (size_t)i * Nsrc);
    if (gs) {
#pragma unroll
        for (int i = 0; i < 64; ++i) v[i] *= gs[k0 + i];
    }
#pragma unroll
    for (int c = 0; c < 8; ++c) { u4 o; o.x = pk2(v[8 * c], v[8 * c + 1]); o.y = pk2(v[8 * c + 2], v[8 * c + 3]); o.z = pk2(v[8 * c + 4], v[8 * c + 5]); o.w = pk2(v[8 * c + 6], v[8 * c + 7]); *(LAS u4*)(scr + lane * 36 + 4 * c) = o; }
    LDS_WAIT();
    bf16r* op = WT + (size_t)(n0 + (lane >> 3)) * K + k0 + 8 * (lane & 7);
#pragma unroll
    for (int j = 0; j < 8; ++j) *(u4*)(op + (size_t)(8 * j) * K) = *(const LAS u4*)(scr + ((lane >> 3) + 8 * j) * 36 + 4 * (lane & 7));
    LDS_WAIT();
}

template <int PARTS = 7>
__device__ __forceinline__ void phase0(const Args& a, LAS unsigned char* lds, int tid, int lane, int wave, int G) {
    const float* x = (const float*)a.in[0]; const float* Win = (const float*)a.in[4]; const float* gn = (const float*)a.in[3];
    unsigned char* ws = a.ws;
    LAS float* wif = (LAS float*)lds;
    if (PARTS & 1) for (int k = tid; k < 2048; k += 512) { const f4 w0 = *(const f4*)(Win + (size_t)k * 8200 + 2048), w1 = *(const f4*)(Win + (size_t)k * 8200 + 2052); const float g = gn[k];
        wif[k] = w0.x * g; wif[2048 + k] = w0.y * g; wif[4096 + k] = w0.z * g; wif[6144 + k] = w0.w * g; wif[8192 + k] = w1.x * g; wif[10240 + k] = w1.y * g; wif[12288 + k] = w1.z * g; wif[14336 + k] = w1.w * g; }
    __syncthreads();
    const int gw = blockIdx.x * 8 + wave, NGW = G * 8;
    bf16r* H = (bf16r*)(ws + WS_H); float* IFG = (float*)(ws + WS_IFG);
    const float* ib = (const float*)a.in[7]; const float* fb = (const float*)a.in[8];
    f4 vnx[8];
    if (PARTS & 1) { const f4* xr0 = (const f4*)(x + (size_t)(gw < TOK ? gw : 0) * DM) + lane;
#pragma unroll
        for (int j = 0; j < 8; ++j) vnx[j] = __builtin_nontemporal_load(xr0 + 64 * j); }
    if (PARTS & 1) for (int m = gw; m < TOK; m += NGW) {
        f4 v[8]; float s = 0.f;
#pragma unroll
        for (int j = 0; j < 8; ++j) { v[j] = vnx[j]; s += (v[j].x * v[j].x + v[j].y * v[j].y) + (v[j].z * v[j].z + v[j].w * v[j].w); }
        { const int mn = m + NGW < TOK ? m + NGW : m; const f4* xr = (const f4*)(x + (size_t)mn * DM) + lane;
#pragma unroll
          for (int j = 0; j < 8; ++j) vnx[j] = __builtin_nontemporal_load(xr + 64 * j); }
        const float rstd = rsqrtf(wave_sum(s) * (1.f / DM) + EPS);
        u2* hp = (u2*)(H + (size_t)m * DM) + lane;
        float acc[8];
#pragma unroll
        for (int c = 0; c < 8; ++c) acc[c] = 0.f;
#pragma unroll
        for (int j = 0; j < 8; ++j) { const f4 g = *((const f4*)gn + lane + 64 * j); const f4 hv = v[j] * rstd * g; hp[64 * j] = (u2){pk2(hv.x, hv.y), pk2(hv.z, hv.w)};
#pragma unroll
            for (int c = 0; c < 8; ++c) { const f4 w = *(const LAS f4*)(wif + c * 2048 + 4 * lane + 256 * j); acc[c] += (v[j].x * w.x + v[j].y * w.y) + (v[j].z * w.z + v[j].w * w.w); } }
#pragma unroll
        for (int c = 0; c < 8; ++c) acc[c] = wave_sum(acc[c]) * rstd;
        float val = acc[0];
#pragma unroll
        for (int c = 1; c < 8; ++c) if (lane == c) val = acc[c];
        if (lane < 4) IFG[(size_t)m * 8 + lane] = val + ib[lane];
        else if (lane < 8) { const float xf = val + fb[lane - 4]; IFG[(size_t)m * 8 + lane] = fminf(xf, 0.f) - log1pf(expf(-fabsf(xf))); }
    }
    LAS unsigned* scr = (LAS unsigned*)(lds + 65536 + wave * 9216);
    constexpr int I_WIN = 32 * 128, I_SQ = 32 * 32, I_PP = 4 * 32, I_G0A = I_SQ - 128;
    if (PARTS & 2) for (int it = gw; it < I_WIN + I_SQ + I_G0A + I_PP; it += NGW) {
        int r = it;
        if (r < I_WIN) { transpose_item<true>(Win, 2048, 8200, 8192, nullptr, (bf16r*)(ws + WS_WIN), scr, r, lane); continue; } r -= I_WIN;
        if (r < I_SQ) { transpose_item<false>((const float*)a.in[15], 2048, 2048, 2048, nullptr, (bf16r*)(ws + WS_WOUT0), scr, r, lane); continue; } r -= I_SQ;
        if (r < I_G0A) { transpose_item<false>((const float*)a.in[24], 2048, 2048, 2048, (const float*)a.in[23], (bf16r*)(ws + WS_WG0), scr, r, lane); continue; } r -= I_G0A;
        transpose_item<false>((const float*)a.in[25], 256, 2048, 2048, nullptr, (bf16r*)(ws + WS_WPP0), scr, r, lane);
    }
    constexpr int NITEMS0 = 32 * 128 + 2 * 32 * 32 + 4 * 32 - 128;
    const int NX = NITEMS0 % NGW;
    if ((PARTS & 4) && gw >= NX) { const int gt = (gw - NX) * 64 + lane, NT = (NGW - NX) * 64;
        const f4* p4 = (const f4*)a.in[1]; u2* pb = (u2*)(ws + WS_PB);
        for (int e0 = gt; e0 < 2 * TOK * 256 / 4; e0 += 4 * NT) { f4 v[4];
#pragma unroll
            for (int k = 0; k < 4; ++k) { const int e = e0 + k * NT; v[k] = __builtin_nontemporal_load(p4 + (e < 2 * TOK * 256 / 4 ? e : e0)); }
#pragma unroll
            for (int k = 0; k < 4; ++k) { const int e = e0 + k * NT; if (e < 2 * TOK * 256 / 4) pb[e] = (u2){pk2(v[k].x, v[k].y), pk2(v[k].z, v[k].w)}; } }
        const int* pos = (const int*)a.in[2]; float2* rt = (float2*)(ws + WS_ROPE);
        for (int e = gt; e < TOK * 64; e += NT) { const int tok = e >> 6, j = e & 63; const float freq = exp2f(-(float)j * (13.287712379549449f / 64.f));
            const float ang = (float)pos[tok] * freq; float sn, cs; sincosf(ang, &sn, &cs); rt[e] = make_float2(cs, sn); } }
}

__device__ __forceinline__ void l1_weights(const Args& a, LAS unsigned char* lds, int lane, int wave, int G) {
    unsigned char* ws = a.ws; const int gw = blockIdx.x * 8 + wave, NGW = G * 8;
    LAS unsigned* scr = (LAS unsigned*)(lds + wave * 9216);
    constexpr int I_CIN = 32 * 96, I_SQ = 32 * 32, I_PP = 4 * 32;
    for (int it = gw; it < I_CIN + 2 * I_SQ + I_PP + 128; it += NGW) {
        int r = it;
        if (r < 128) { transpose_item<false>((const float*)a.in[24], 2048, 2048, 2048, (const float*)a.in[23], (bf16r*)(ws + WS_WG0), scr, I_SQ - 128 + r, lane); continue; } r -= 128;
        if (r < I_CIN) { transpose_item<false>((const float*)a.in[17], 2048, 6144, 6144, (const float*)a.in[16], (bf16r*)(ws + WS_WCIN), scr, r, lane); continue; } r -= I_CIN;
        if (r < I_SQ) { transpose_item<false>((const float*)a.in[22], 2048, 2048, 2048, nullptr, (bf16r*)(ws + WS_WCOUT), scr, r, lane); continue; } r -= I_SQ;
        if (r < I_SQ) { transpose_item<false>((const float*)a.in[24] + (size_t)2048 * 2048, 2048, 2048, 2048, (const float*)a.in[23] + 2048, (bf16r*)(ws + WS_WG1), scr, r, lane); continue; } r -= I_SQ;
        transpose_item<false>((const float*)a.in[25] + (size_t)256 * 2048, 256, 2048, 2048, nullptr, (bf16r*)(ws + WS_WPP1), scr, r, lane);
    }
}

#define XB_TMO      128
#define XB_XCNT(j)  (256  + 64 * (j))
#define XB_XSUB(j)  (1280 + 64 * (j))
#define XB_XGEN(j)  (2304 + 64 * (j))
#define XB_TOP      3328
#define XB_TOPGEN   3392
#define XCD_BAR_WORDS 3456
#define XB_SPIN_CAP (1u << 18)

__device__ __forceinline__ unsigned xb_ld(unsigned* p)              { return __hip_atomic_load(p, __ATOMIC_RELAXED, __HIP_MEMORY_SCOPE_AGENT); }
__device__ __forceinline__ unsigned xb_add(unsigned* p, unsigned v) { return __hip_atomic_fetch_add(p, v, __ATOMIC_RELAXED, __HIP_MEMORY_SCOPE_AGENT); }
__device__ __forceinline__ unsigned xb_xcc_id() { return (unsigned)__builtin_amdgcn_s_getreg((3 << 11) | 20) & 0xFu; }
#define XB_SPIN(cond, bar) do { unsigned _sp = 0; while (cond) { __builtin_amdgcn_s_sleep(1); \
    if ((++_sp & 255u) == 0u) { if (xb_ld(&(bar)[XB_TMO])) break; if (_sp > XB_SPIN_CAP) { atomicAdd(&(bar)[XB_TMO], 1u); break; } } } } while (0)

struct XcdBarrier {
    unsigned* bar; unsigned x;
    volatile LAS unsigned* st;
};

__device__ __forceinline__ XcdBarrier xcd_barrier_post(unsigned* bar, volatile LAS unsigned* st) {
    XcdBarrier b; b.bar = bar; b.x = xb_xcc_id(); b.st = st;
    if (threadIdx.x == 0) (void)xb_add(&bar[XB_XCNT(b.x)], 1u);
    return b;
}
__device__ __forceinline__ void xcd_barrier_complete(unsigned* bar, unsigned x, unsigned& nloc, unsigned& nx) {
    const unsigned G = gridDim.x * gridDim.y * gridDim.z;
    unsigned sum, cnt, mine, sp = 0u;
    for (;;) {
        sum = 0u; cnt = 0u; mine = 0u;
#pragma unroll
        for (unsigned j = 0; j < 16; ++j) { const unsigned c = xb_ld(&bar[XB_XCNT(j)]); sum += c; cnt += (c > 0u) ? 1u : 0u; mine = (j == x) ? c : mine; }
        if (sum == G) break;
        __builtin_amdgcn_s_sleep(1);
        if ((++sp & 255u) == 0u) { if (xb_ld(&bar[XB_TMO])) break; if (sp > XB_SPIN_CAP) { atomicAdd(&bar[XB_TMO], 1u); break; } }
    }
    nloc = mine > 0u ? mine : 1u; nx = cnt > 0u ? cnt : 1u;
}

__device__ __forceinline__ void xcd_barrier(const XcdBarrier& b) {
    asm volatile("s_waitcnt vmcnt(0)" ::: "memory");
    __syncthreads();
    if (threadIdx.x == 0) {
        unsigned* bar = b.bar;
        __builtin_amdgcn_s_waitcnt(0);
        unsigned nloc = b.st[0], nx = b.st[1];
        if (nloc == 0u) { xcd_barrier_complete(bar, b.x, nloc, nx); b.st[0] = nloc; b.st[1] = nx; }
        const unsigned old = xb_add(&bar[XB_XSUB(b.x)], 1u);
        const unsigned gen = old / nloc;
        if (old + 1u == (gen + 1u) * nloc) {
            __builtin_amdgcn_fence(__ATOMIC_RELEASE, "agent");
            asm volatile("s_waitcnt vmcnt(0)" ::: "memory");
            const unsigned og = xb_add(&bar[XB_TOP], 1u);
            const unsigned tg = og / nx;
            if (og + 1u == (tg + 1u) * nx) xb_add(&bar[XB_TOPGEN], 1u);
            else XB_SPIN(xb_ld(&bar[XB_TOPGEN]) == tg, bar);
            __builtin_amdgcn_fence(__ATOMIC_ACQUIRE, "agent");
            xb_add(&bar[XB_XGEN(b.x)], 1u);
            asm volatile("s_waitcnt vmcnt(0)" ::: "memory");
        } else {
            XB_SPIN(xb_ld(&bar[XB_XGEN(b.x)]) == gen, bar);
            __builtin_amdgcn_fence(__ATOMIC_ACQUIRE, "agent");
            asm volatile("s_waitcnt vmcnt(0)" ::: "memory");
        }
    }
    __syncthreads();
}


using pg8::Unit;
typedef pg8::f32x4 accv;

__device__ __forceinline__ u4 pack8(const accv& a, const accv& b) { u4 w; w.x = pk2(a[0], a[1]); w.y = pk2(a[2], a[3]); w.z = pk2(b[0], b[1]); w.w = pk2(b[2], b[3]); return w; }
__device__ __forceinline__ float row_rstd(const float* ssq, int r, int fq) {
    const f4 p0 = *(const f4*)(ssq + (size_t)r * 32 + 8 * fq), p1 = *(const f4*)(ssq + (size_t)r * 32 + 8 * fq + 4);
    float s = ((p0.x + p0.y) + (p0.z + p0.w)) + ((p1.x + p1.y) + (p1.z + p1.w));
    s += __shfl_xor(s, 16); s += __shfl_xor(s, 32);
    return rsqrtf(s * (1.f / DM) + EPS);
}

__device__ __forceinline__ float row_rstd_sc1(const float* ssq, int r, int fq) {
    GAS unsigned long long* p = (GAS unsigned long long*)(ssq + (size_t)r * 32 + 8 * fq); float s = 0.f;
#pragma unroll
    for (int i = 0; i < 4; ++i) { const unsigned long long w = __hip_atomic_load(p + i, __ATOMIC_RELAXED, __HIP_MEMORY_SCOPE_AGENT); s += __uint_as_float((unsigned)w) + __uint_as_float((unsigned)(w >> 32)); }
    s += __shfl_xor(s, 16); s += __shfl_xor(s, 32);
    return rsqrtf(s * (1.f / DM) + EPS);
}

__device__ __forceinline__ void unpack8(const u4& w, accv& a, accv& b) { a[0] = bflo(w.x); a[1] = bfhi(w.x); a[2] = bflo(w.y); a[3] = bfhi(w.y); b[0] = bflo(w.z); b[1] = bfhi(w.z); b[2] = bflo(w.w); b[3] = bfhi(w.w); }

struct RsPart { f4 p0, p1; };
__device__ __forceinline__ RsPart rs_load(const float* ssq, int r, int fq) { RsPart p; p.p0 = *(const f4*)(ssq + (size_t)r * 32 + 8 * fq); p.p1 = *(const f4*)(ssq + (size_t)r * 32 + 8 * fq + 4); return p; }
__device__ __forceinline__ float rs_fin(const RsPart& p) {
    float s = ((p.p0.x + p.p0.y) + (p.p0.z + p.p0.w)) + ((p.p1.x + p.p1.y) + (p.p1.z + p.p1.w));
    s += __shfl_xor(s, 16); s += __shfl_xor(s, 32);
    return rsqrtf(s * (1.f / DM) + EPS);
}

struct EpiG1 {
    static constexpr bool PERM = true, AFTER_DRAIN = false;
    unsigned char* ws;
    __device__ __forceinline__ void operator()(const accv (&acc)[2][2][4][2], const Unit& u, int wr, int wc, int fr, int fq) const {
        const int seg = u.pn >> 2, q4 = u.pn & 3;
        const int row0 = u.pm * 256 + wr * 64 + fr, cl = wc * 32 + 8 * fq;
        if (seg < 4 || seg == 7) {
            const int reg = seg == 7 ? 4 : seg;
            bf16r* base = (bf16r*)(ws + WS_G1 + (size_t)reg * 16 * MiB);
#pragma unroll
            for (int ai = 0; ai < 2; ++ai)
#pragma unroll
                for (int m = 0; m < 4; ++m) { bf16r* rowp = base + (size_t)(row0 + ai * 128 + m * 16) * 1024 + q4 * 256 + cl;
#pragma unroll
                    for (int bj = 0; bj < 2; ++bj) *(u4*)(rowp + bj * 128) = pack8(acc[ai][bj][m][0], acc[ai][bj][m][1]); }
        } else if (seg == 6) {
            bf16r* base = (bf16r*)(ws + WS_DAV);
#pragma unroll
            for (int ai = 0; ai < 2; ++ai)
#pragma unroll
                for (int m = 0; m < 4; ++m) { const int r = row0 + ai * 128 + m * 16, b = r >> 11, s = r & 2047;
#pragma unroll
                    for (int bj = 0; bj < 2; ++bj) *(u4*)(base + ((size_t)((b * 4 + q4) * 2 + bj) * 2048 + s) * 128 + cl) = pack8(acc[ai][bj][m][0], acc[ai][bj][m][1]); }
        } else {
            bf16r* base = (bf16r*)(ws + (seg == 4 ? WS_DAQ : WS_DAK));
            const float* rope = (const float*)(ws + WS_ROPE);
            const int j0 = 16 * wc + 4 * fq;
#pragma unroll
            for (int ai = 0; ai < 2; ++ai)
#pragma unroll
                for (int m = 0; m < 4; ++m) { const int r = row0 + ai * 128 + m * 16, b = r >> 11, s = r & 2047;
                    const f4 t0 = *(const f4*)(rope + ((size_t)r * 64 + j0) * 2), t1 = *(const f4*)(rope + ((size_t)r * 64 + j0) * 2 + 4);
                    const accv cs = {t0.x, t0.z, t1.x, t1.z}, sn = {t0.y, t0.w, t1.y, t1.w};
#pragma unroll
                    for (int bj = 0; bj < 2; ++bj) { const accv x1 = acc[ai][bj][m][0], x2 = acc[ai][bj][m][1];
                        const accv o1 = x1 * cs - x2 * sn, o2 = x1 * sn + x2 * cs;
                        *(u4*)(base + ((size_t)((b * 4 + q4) * 2 + bj) * 2048 + s) * 128 + cl) = pack8(o1, o2); } }
        }
    }
};

template <bool XBF>
struct EpiRes {
    static constexpr bool PERM = true, AFTER_DRAIN = false;
    const void* xin; bf16r* xb; float* ssq;
    __device__ __forceinline__ void operator()(const accv (&acc)[2][2][4][2], const Unit& u, int wr, int wc, int fr, int fq) const {
        const int row0 = u.pm * 256 + wr * 64 + fr, col0 = u.pn * 256 + wc * 32 + 8 * fq;
#pragma unroll
        for (int ah = 0; ah < 4; ++ah) { const int ai = ah >> 1, m0 = (ah & 1) * 2;
            accv xa[4][2], xc[4][2];
#pragma unroll
            for (int m = m0; m < m0 + 2; ++m)
#pragma unroll
                for (int bj = 0; bj < 2; ++bj) { const size_t o = (size_t)(row0 + ai * 128 + m * 16) * DM + col0 + bj * 128;
                    if constexpr (XBF) { unpack8(*(const u4*)((const bf16r*)xin + o), xa[m][bj], xc[m][bj]); } else { xa[m][bj] = __builtin_nontemporal_load((const accv*)((const float*)xin + o)); xc[m][bj] = __builtin_nontemporal_load((const accv*)((const float*)xin + o + 4)); } }
#pragma unroll
            for (int m = m0; m < m0 + 2; ++m) { const int r = row0 + ai * 128 + m * 16; float q = 0.f;
#pragma unroll
                for (int bj = 0; bj < 2; ++bj) { const size_t o = (size_t)r * DM + col0 + bj * 128;
                    const accv v0 = acc[ai][bj][m][0] + xa[m][bj], v1 = acc[ai][bj][m][1] + xc[m][bj];
                    *(u4*)(xb + o) = pack8(v0, v1);
                    q += ((v0[0] * v0[0] + v0[1] * v0[1]) + (v0[2] * v0[2] + v0[3] * v0[3])) + ((v1[0] * v1[0] + v1[1] * v1[1]) + (v1[2] * v1[2] + v1[3] * v1[3])); }
                q += __shfl_xor(q, 16); q += __shfl_xor(q, 32);
                if (fq == 0) ssq[(size_t)r * 32 + u.pn * 4 + wc] = q; } }
    }
};

struct EpiGate {
    static constexpr bool PERM = true, AFTER_DRAIN = false;
    const bf16r* xin; bf16r* xb; const bf16r* pp; const float* ssq_in; float* ssq_out;
    __device__ __forceinline__ void operator()(const accv (&acc)[2][2][4][2], const Unit& u, int wr, int wc, int fr, int fq) const {
        const int row0 = u.pm * 256 + wr * 64 + fr, col0 = u.pn * 256 + wc * 32 + 8 * fq;
#pragma unroll
        for (int ah = 0; ah < 4; ++ah) { const int ai = ah >> 1, m0 = (ah & 1) * 2;
            u4 xw[4][2], pw[4][2]; RsPart rp[4];
#pragma unroll
            for (int m = m0; m < m0 + 2; ++m) { const int r = row0 + ai * 128 + m * 16; rp[m] = rs_load(ssq_in, r, fq);
#pragma unroll
                for (int bj = 0; bj < 2; ++bj) { const size_t o = (size_t)r * DM + col0 + bj * 128; xw[m][bj] = *(const u4*)(xin + o); pw[m][bj] = *(const u4*)(pp + o); } }
#pragma unroll
            for (int m = m0; m < m0 + 2; ++m) { const int r = row0 + ai * 128 + m * 16; const float rstd = rs_fin(rp[m]); float q = 0.f;
#pragma unroll
                for (int bj = 0; bj < 2; ++bj) { const size_t o = (size_t)r * DM + col0 + bj * 128;
                    accv xa, xc, pa, pc; unpack8(xw[m][bj], xa, xc); unpack8(pw[m][bj], pa, pc);
                    const accv a0 = acc[ai][bj][m][0] * rstd, a1 = acc[ai][bj][m][1] * rstd;
                    accv v0, v1;
#pragma unroll
                    for (int i = 0; i < 4; ++i) { v0[i] = xa[i] + sigm(a0[i]) * pa[i]; v1[i] = xc[i] + sigm(a1[i]) * pc[i]; }
                    *(u4*)(xb + o) = pack8(v0, v1);
                    q += ((v0[0] * v0[0] + v0[1] * v0[1]) + (v0[2] * v0[2] + v0[3] * v0[3])) + ((v1[0] * v1[0] + v1[1] * v1[1]) + (v1[2] * v1[2] + v1[3] * v1[3])); }
                q += __shfl_xor(q, 16); q += __shfl_xor(q, 32); if (fq == 0) ssq_out[(size_t)r * 32 + u.pn * 4 + wc] = q; } }
    }
};

struct EpiUVZ {
    static constexpr bool PERM = true, AFTER_DRAIN = false;
    bf16r* U; bf16r* V; const float* ssq_in; float* lns; float* lnq;
    __device__ __forceinline__ void operator()(const accv (&acc)[2][2][4][2], const Unit& u, int wr, int wc, int fr, int fq) const {
        const int seg = u.pn >> 3, pnl = u.pn & 7;
        bf16r* base = (seg == 1) ? V : U + (size_t)(seg >> 1) * TOK * DM;
        const int row0 = u.pm * 256 + wr * 64 + fr, col0 = pnl * 256 + wc * 32 + 8 * fq;

#pragma unroll
        for (int ai = 0; ai < 2; ++ai) { RsPart rp[4];
#pragma unroll
            for (int m = 0; m < 4; ++m) rp[m] = rs_load(ssq_in, row0 + ai * 128 + m * 16, fq);
#pragma unroll
            for (int m = 0; m < 4; ++m) { const int r = row0 + ai * 128 + m * 16; const float rstd = rs_fin(rp[m]); float s1 = 0.f, s2 = 0.f;
#pragma unroll
                for (int bj = 0; bj < 2; ++bj) { const size_t o = (size_t)r * DM + col0 + bj * 128;
                    const accv v0 = acc[ai][bj][m][0] * rstd, v1 = acc[ai][bj][m][1] * rstd;
                    *(u4*)(base + o) = pack8(v0, v1);
                    s1 += ((v0[0] + v0[1]) + (v0[2] + v0[3])) + ((v1[0] + v1[1]) + (v1[2] + v1[3]));
                    s2 += ((v0[0] * v0[0] + v0[1] * v0[1]) + (v0[2] * v0[2] + v0[3] * v0[3])) + ((v1[0] * v1[0] + v1[1] * v1[1]) + (v1[2] * v1[2] + v1[3] * v1[3])); }
                if (seg == 1) { s1 += __shfl_xor(s1, 16); s1 += __shfl_xor(s1, 32); s2 += __shfl_xor(s2, 16); s2 += __shfl_xor(s2, 32);
                    if (fq == 0) { lns[(size_t)r * 32 + pnl * 4 + wc] = s1; lnq[(size_t)r * 32 + pnl * 4 + wc] = s2; } } } }
    }
};

struct EpiGateFinal {
    static constexpr bool PERM = true, AFTER_DRAIN = false;
    const bf16r* xin; float* out; const bf16r* pp; const float* ssq_in; float* ssq_x; unsigned* cnt; const float* gfin;
    __device__ __forceinline__ void operator()(accv (&acc)[2][2][4][2], const Unit& u, int wr, int wc, int fr, int fq) const {
        const int row0 = u.pm * 256 + wr * 64 + fr, col0 = u.pn * 256 + wc * 32 + 8 * fq;
#pragma unroll
        for (int ah = 0; ah < 4; ++ah) { const int ai = ah >> 1, m0 = (ah & 1) * 2;
            u4 xw[4][2], pw[4][2]; RsPart rp[4];
#pragma unroll
            for (int m = m0; m < m0 + 2; ++m) { const int r = row0 + ai * 128 + m * 16; rp[m] = rs_load(ssq_in, r, fq);
#pragma unroll
                for (int bj = 0; bj < 2; ++bj) { const size_t o = (size_t)r * DM + col0 + bj * 128; xw[m][bj] = *(const u4*)(xin + o); pw[m][bj] = *(const u4*)(pp + o); } }
#pragma unroll
            for (int m = m0; m < m0 + 2; ++m) { const int r = row0 + ai * 128 + m * 16; const float rstd = rs_fin(rp[m]); float q = 0.f;
#pragma unroll
                for (int bj = 0; bj < 2; ++bj) {
                    accv xa, xc, pa, pc; unpack8(xw[m][bj], xa, xc); unpack8(pw[m][bj], pa, pc);
                    const accv a0 = acc[ai][bj][m][0] * rstd, a1 = acc[ai][bj][m][1] * rstd;
                    accv v0, v1;
#pragma unroll
                    for (int i = 0; i < 4; ++i) { v0[i] = xa[i] + sigm(a0[i]) * pa[i]; v1[i] = xc[i] + sigm(a1[i]) * pc[i]; }
                    acc[ai][bj][m][0] = v0; acc[ai][bj][m][1] = v1;
                    q += ((v0[0] * v0[0] + v0[1] * v0[1]) + (v0[2] * v0[2] + v0[3] * v0[3])) + ((v1[0] * v1[0] + v1[1] * v1[1]) + (v1[2] * v1[2] + v1[3] * v1[3])); }
                q += __shfl_xor(q, 16); q += __shfl_xor(q, 32); if (fq == 0) __hip_atomic_store((GAS unsigned*)(ssq_x + (size_t)r * 32 + u.pn * 4 + wc), __float_as_uint(q), __ATOMIC_RELAXED, __HIP_MEMORY_SCOPE_AGENT); } }
        asm volatile("s_waitcnt vmcnt(0)" ::: "memory");
        __builtin_amdgcn_s_barrier();
        if ((wr | wc) == 0) { GAS unsigned* c = (GAS unsigned*)(cnt + u.pm * 64);
            if ((fr | fq) == 0) (void)__hip_atomic_fetch_add(c, 1u, __ATOMIC_RELAXED, __HIP_MEMORY_SCOPE_AGENT);
            unsigned spins = 0; while ((unsigned)__builtin_amdgcn_readfirstlane((int)__hip_atomic_load(c, __ATOMIC_RELAXED, __HIP_MEMORY_SCOPE_AGENT)) < 8u) { __builtin_amdgcn_s_sleep(1); if (++spins > (1u << 22)) break; }
            __builtin_amdgcn_fence(__ATOMIC_ACQUIRE, "agent"); asm volatile("s_waitcnt vmcnt(0)" ::: "memory"); }
        __builtin_amdgcn_s_barrier();
        accv g[2][2];
#pragma unroll
        for (int bj = 0; bj < 2; ++bj) { g[bj][0] = *(const accv*)(gfin + col0 + bj * 128); g[bj][1] = *(const accv*)(gfin + col0 + bj * 128 + 4); }
#pragma unroll
        for (int ai = 0; ai < 2; ++ai)
#pragma unroll
            for (int m = 0; m < 4; ++m) { const int r = row0 + ai * 128 + m * 16; const float rstd = row_rstd_sc1(ssq_x, r, fq);
#pragma unroll
                for (int bj = 0; bj < 2; ++bj) { const size_t o = (size_t)r * DM + col0 + bj * 128;
                    *(accv*)(out + o) = acc[ai][bj][m][0] * rstd * g[bj][0]; *(accv*)(out + o + 4) = acc[ai][bj][m][1] * rstd * g[bj][1]; } }
    }
};

#define MFMA16(a, b, c) __builtin_amdgcn_mfma_f32_16x16x32_bf16((a), (b), (c), 0, 0, 0)
constexpr int LP = 136;

struct ConvW { f4 w[4][2]; f4 b[2]; };
__device__ __forceinline__ void conv_w_load(const float* cw, const float* cb, int col, ConvW& W) {
    W.b[0] = *(const f4*)(cb + col); W.b[1] = *(const f4*)(cb + col + 4);
#pragma unroll
    for (int j = 0; j < 4; ++j) { W.w[j][0] = *(const f4*)(cw + j * 1024 + col); W.w[j][1] = *(const f4*)(cw + j * 1024 + col + 4); }
}
__device__ __forceinline__ void conv8_ld(const bf16r* mlqk, int t0, int cpos, int l, int col, u4 (&xv)[4]) {
#pragma unroll
    for (int j = 0; j < 4; ++j) { const int tt = l - 3 + j; const bool ok = cpos + tt >= 0;
        xv[j] = *(const u4*)(mlqk + (size_t)(t0 + (ok ? tt : 0)) * 1024 + col); if (!ok) xv[j] = (u4){0u, 0u, 0u, 0u}; }
}
__device__ __forceinline__ void conv8_fin(const ConvW& W, const u4 (&xv)[4], float scale, float (&o)[8]) {
    o[0] = W.b[0].x; o[1] = W.b[0].y; o[2] = W.b[0].z; o[3] = W.b[0].w; o[4] = W.b[1].x; o[5] = W.b[1].y; o[6] = W.b[1].z; o[7] = W.b[1].w;
#pragma unroll
    for (int j = 0; j < 4; ++j) { const f4 w0 = W.w[j][0], w1 = W.w[j][1];
        o[0] += w0.x * bflo(xv[j].x); o[1] += w0.y * bfhi(xv[j].x); o[2] += w0.z * bflo(xv[j].y); o[3] += w0.w * bfhi(xv[j].y);
        o[4] += w1.x * bflo(xv[j].z); o[5] += w1.y * bfhi(xv[j].z); o[6] += w1.z * bflo(xv[j].w); o[7] += w1.w * bfhi(xv[j].w); }
#pragma unroll
    for (int i = 0; i < 8; ++i) o[i] = silu(o[i]) * scale;
}
constexpr float KSCALE = 0.08838834764831845f;
constexpr int LPV = 264;
typedef short s4v __attribute__((ext_vector_type(4)));
__device__ __forceinline__ s8v tr_frag(const LAS bf16r* base, int pitch, int fr, int fq) {
    const LAS bf16r* p = base + (8 * fq + (fr >> 2)) * pitch + 4 * (fr & 3);
    const s4v lo = __builtin_amdgcn_ds_read_tr16_b64_v4i16((LAS s4v*)p), hi = __builtin_amdgcn_ds_read_tr16_b64_v4i16((LAS s4v*)(p + 4 * pitch));
    return (s8v){lo[0], lo[1], lo[2], lo[3], hi[0], hi[1], hi[2], hi[3]};
}
__device__ __forceinline__ float wave_scan_add(float x, int lane) {
#pragma unroll
    for (int o = 1; o < 64; o <<= 1) { const float y = __shfl_up(x, o); if (lane >= o) x += y; }
    return x;
}
__device__ __forceinline__ float wave_scan_max(float x, int lane) {
#pragma unroll
    for (int o = 1; o < 64; o <<= 1) { const float y = __shfl_up(x, o); if (lane >= o) x = fmaxf(x, y); }
    return x;
}
__device__ __forceinline__ float wave_max(float v) {
#pragma unroll
    for (int o = 1; o < 64; o <<= 1) v = fmaxf(v, __shfl_xor(v, o));
    return v;
}

__device__ __forceinline__ void m1_unit(const Args& a, LAS unsigned char* lds, int unit, int tid, int lane, int wave) {
    unsigned char* ws = a.ws;
    const int b = unit >> 6, c = (unit >> 2) & 15, h = unit & 3, t0 = b * 2048 + c * 128;
    LAS bf16r* Kn = (LAS bf16r*)lds;
    LAS bf16r* Vn = (LAS bf16r*)(lds + 34816);
    LAS float* fs = (LAS float*)(lds + 104448);
    const float* IFG = (const float*)(ws + WS_IFG); float* BCUM = (float*)(ws + WS_BCUM); float* MSC = (float*)(ws + WS_MSC);
    float li = 0.f, bsum = 0.f;
    if (wave < 2) { li = IFG[(size_t)(t0 + tid) * 8 + h]; bsum = wave_scan_add(IFG[(size_t)(t0 + tid) * 8 + 4 + h], lane); if (tid == 63) fs[128] = bsum; }
    __syncthreads();
    if (wave == 1) bsum += fs[128];
    if (wave < 2) { BCUM[(size_t)(t0 + tid) * 4 + h] = bsum; if (tid == 127) fs[129] = bsum; }
    __syncthreads();
    float w = 0.f;
    if (wave < 2) { w = fs[129] - bsum + li; const float wm = wave_max(w); if (lane == 0) fs[130 + wave] = wm; }
    __syncthreads();
    if (wave < 2) { const float m = fmaxf(fs[130], fs[131]); fs[tid] = __expf(w - m); if (tid == 0) { MSC[unit * 4 + 0] = m; MSC[unit * 4 + 1] = fs[129]; } }
    __syncthreads();
    const bf16r* mlqk = (const bf16r*)(ws + WS_MLQK); const bf16r* mlv = (const bf16r*)(ws + WS_MLV);
    const float* cw = (const float*)a.in[5]; const float* cb = (const float*)a.in[6];
    { const int dg = (tid & 15) * 8, col = 512 + h * 128 + dg; ConvW W; conv_w_load(cw, cb, col, W);
      u4 xv[4][4];
#pragma unroll
      for (int n = 0; n < 4; ++n) conv8_ld(mlqk, t0, c * 128, (tid >> 4) + 32 * n, col, xv[n]);
#pragma unroll
      for (int n = 0; n < 4; ++n) { const int l = (tid >> 4) + 32 * n; float o[8]; conv8_fin(W, xv[n], KSCALE, o);
          *(LAS u4*)(Kn + l * LP + dg) = (u4){pk2(o[0], o[1]), pk2(o[2], o[3]), pk2(o[4], o[5]), pk2(o[6], o[7])}; } }
#pragma unroll
    for (int it = tid; it < 128 * 32; it += 512) { const int l = it >> 5, dg = (it & 31) * 8; const float e = fs[l];
        const u4 xv = *(const u4*)(mlv + (size_t)(t0 + l) * 1024 + h * 256 + dg);
        *(LAS u4*)(Vn + l * LPV + dg) = (u4){pk2(bflo(xv.x) * e, bfhi(xv.x) * e), pk2(bflo(xv.y) * e, bfhi(xv.y) * e), pk2(bflo(xv.z) * e, bfhi(xv.z) * e), pk2(bflo(xv.w) * e, bfhi(xv.w) * e)}; }
    __syncthreads();
    if (tid < 128) { float sacc = 0.f;
#pragma unroll 16
        for (int l = 0; l < 128; ++l) sacc += fs[l] * __uint_as_float((unsigned)Kn[l * LP + tid] << 16);
        ((float*)(ws + WS_NLOC))[unit * 128 + tid] = sacc; }
    const int fr = lane & 15, fq = lane >> 4;
    f4 acc[8][2];
#pragma unroll
    for (int mt = 0; mt < 8; ++mt) { acc[mt][0] = (f4){0.f, 0.f, 0.f, 0.f}; acc[mt][1] = (f4){0.f, 0.f, 0.f, 0.f}; }
#pragma unroll
    for (int ks = 0; ks < 4; ++ks) {
        const s8v b0 = tr_frag(Vn + 32 * ks * LPV + 32 * wave, LPV, fr, fq), b1 = tr_frag(Vn + 32 * ks * LPV + 32 * wave + 16, LPV, fr, fq);
#pragma unroll
        for (int mt = 0; mt < 8; ++mt) { const s8v av = tr_frag(Kn + 32 * ks * LP + 16 * mt, LP, fr, fq); acc[mt][0] = MFMA16(av, b0, acc[mt][0]); acc[mt][1] = MFMA16(av, b1, acc[mt][1]); } }
    float* cl = (float*)(ws + WS_CLOC) + (size_t)unit * 32768;
#pragma unroll
    for (int mt = 0; mt < 8; ++mt)
#pragma unroll
        for (int nt = 0; nt < 2; ++nt) *(f4*)(cl + (size_t)(32 * wave + 16 * nt + fr) * 128 + 16 * mt + 4 * fq) = acc[mt][nt];
    __syncthreads();
}

__device__ __forceinline__ void m2_scan(const Args& a, int tid, int G) {
    unsigned char* ws = a.ws; const int gt = blockIdx.x * 512 + tid, NT = G * 512;
    const float* MSC = (const float*)(ws + WS_MSC); float* MSCw = (float*)(ws + WS_MSC);
    const float* CL = (const float*)(ws + WS_CLOC); bf16r* CP = (bf16r*)(ws + WS_CPREV);
    for (int e = gt; e < 16 * 8192; e += NT) { const int bh = e >> 13, idx = (e & 8191) * 4, b = bh >> 2, h = bh & 3;
        f4 C = {0.f, 0.f, 0.f, 0.f}; float m = 0.f;
        for (int c = 0; c < 16; ++c) { const int u = (b * 16 + c) * 4 + h;
            *(u2*)(CP + (size_t)u * 32768 + idx) = (u2){pk2(C[0], C[1]), pk2(C[2], C[3])};
            const float ml = MSC[u * 4 + 0], g = MSC[u * 4 + 1]; const float mn = fmaxf(g + m, ml), aa = __expf(g + m - mn), cc = __expf(ml - mn);
            const f4 Cl = __builtin_nontemporal_load((const f4*)(CL + (size_t)u * 32768 + idx)); C = C * aa + Cl * cc; m = mn; } }
    const float* NL = (const float*)(ws + WS_NLOC); float* NP = (float*)(ws + WS_NPREV);
    for (int e = gt; e < 16 * 128; e += NT) { const int bh = e >> 7, dk = e & 127, b = bh >> 2, h = bh & 3; float n = 0.f, m = 0.f;
        for (int c = 0; c < 16; ++c) { const int u = (b * 16 + c) * 4 + h; NP[u * 128 + dk] = n; if (dk == 0) MSCw[u * 4 + 2] = m;
            const float ml = MSC[u * 4 + 0], g = MSC[u * 4 + 1]; const float mn = fmaxf(g + m, ml), aa = __expf(g + m - mn), cc = __expf(ml - mn);
            n = aa * n + cc * NL[u * 128 + dk]; m = mn; } }
}

template <int ONLY_STAGE = 0>
__device__ __forceinline__ void m3_unit(const Args& a, LAS unsigned char* lds, int unit, int tid, int lane, int wave) {
    unsigned char* ws = a.ws;
    const int b = unit >> 6, c = (unit >> 2) & 15, h = unit & 3, t0 = b * 2048 + c * 128;
    LAS bf16r* Qc = (LAS bf16r*)lds;
    LAS bf16r* Kc = (LAS bf16r*)(lds + 34816);
    LAS bf16r* Vn = (LAS bf16r*)(lds + 69632);
    LAS float* fs = (LAS float*)(lds + 139264);
    const float* IFG = (const float*)(ws + WS_IFG); const float* BCUM = (const float*)(ws + WS_BCUM); const float* MSC = (const float*)(ws + WS_MSC);
    const float m_prev = MSC[unit * 4 + 2];
    if (tid < 128) { const float bt = BCUM[(size_t)(t0 + tid) * 4 + h]; fs[tid] = IFG[(size_t)(t0 + tid) * 8 + h] - bt; fs[128 + tid] = bt; }
    else if (tid < 256) fs[256 + tid - 128] = ((const float*)(ws + WS_NPREV))[unit * 128 + tid - 128];
    const bf16r* mlqk = (const bf16r*)(ws + WS_MLQK); const bf16r* mlv = (const bf16r*)(ws + WS_MLV);
    const float* cw = (const float*)a.in[5]; const float* cb = (const float*)a.in[6];
    { const int isk = (tid >> 4) & 1, dg = (tid & 15) * 8, col = isk * 512 + h * 128 + dg; ConvW W; conv_w_load(cw, cb, col, W);
      LAS bf16r* dst = isk ? Kc : Qc; const float sc = isk ? KSCALE : 1.f;
#pragma unroll
      for (int hf = 0; hf < 2; ++hf) { u4 xv[4][4];
#pragma unroll
          for (int n = 0; n < 4; ++n) conv8_ld(mlqk, t0, c * 128, (tid >> 5) + 16 * (4 * hf + n), col, xv[n]);
#pragma unroll
          for (int n = 0; n < 4; ++n) { const int l = (tid >> 5) + 16 * (4 * hf + n); float o[8]; conv8_fin(W, xv[n], sc, o);
              *(LAS u4*)(dst + l * LP + dg) = (u4){pk2(o[0], o[1]), pk2(o[2], o[3]), pk2(o[4], o[5]), pk2(o[6], o[7])}; } } }
#pragma unroll
    for (int it = tid; it < 128 * 32; it += 512) { const int l = it >> 5, dg = (it & 31) * 8;
        *(LAS u4*)(Vn + l * LPV + dg) = __builtin_nontemporal_load((const u4*)(mlv + (size_t)(t0 + l) * 1024 + h * 256 + dg)); }
    const int fr = lane & 15, fq = lane >> 4, t = 16 * wave + fr;
    const bf16r* cp = (const bf16r*)(ws + WS_CPREV) + (size_t)unit * 32768 + (size_t)fr * 128 + 8 * fq;
    s8v cpa[32];
#pragma unroll
    for (int ks = 0; ks < 4; ++ks)
#pragma unroll
        for (int mt = 0; mt < 8; ++mt) cpa[ks * 8 + mt] = *(const s8v*)(cp + (size_t)(16 * mt) * 128 + 32 * ks);
    __syncthreads();
    if (ONLY_STAGE) return;
    float pmx = 0.f;
    if (wave < 2) { pmx = wave_scan_max(fs[tid], lane); if (tid == 63) fs[896] = pmx; }
    __syncthreads();
    if (wave < 2) { if (wave == 1) pmx = fmaxf(pmx, fs[896]);
        const float M = fmaxf(m_prev, pmx); fs[384 + tid] = M; fs[512 + tid] = __expf(m_prev - M); fs[640 + tid] = __expf(-(fs[128 + tid] + M));
        float qn = 0.f;
#pragma unroll 4
        for (int d8 = 0; d8 < 16; ++d8) { const u4 qv = *(const LAS u4*)(Qc + tid * LP + 8 * d8); const f4 n0 = *(const LAS f4*)(fs + 256 + 8 * d8), n1 = *(const LAS f4*)(fs + 256 + 8 * d8 + 4);
            qn += (bflo(qv.x) * n0.x + bfhi(qv.x) * n0.y) + (bflo(qv.y) * n0.z + bfhi(qv.y) * n0.w) + (bflo(qv.z) * n1.x + bfhi(qv.z) * n1.y) + (bflo(qv.w) * n1.z + bfhi(qv.w) * n1.w); }
        fs[768 + tid] = qn; }
    __syncthreads();
    f4 as[8];
#pragma unroll
    for (int mt = 0; mt < 8; ++mt) as[mt] = (f4){0.f, 0.f, 0.f, 0.f};
#pragma unroll
    for (int ks = 0; ks < 4; ++ks) { const s8v bq = *(const LAS s8v*)(Qc + t * LP + 32 * ks + 8 * fq);
#pragma unroll
        for (int mt = 0; mt < 8; ++mt) if (mt <= wave) { const s8v av = *(const LAS s8v*)(Kc + (16 * mt + fr) * LP + 32 * ks + 8 * fq); as[mt] = MFMA16(av, bq, as[mt]); } }
    __syncthreads();
    const float Mt = fs[384 + t]; float den = 0.f; const int lim = fr - 4 * fq;
#pragma unroll
    for (int mt = 0; mt < 8; ++mt) if (mt <= wave + 1) { float v[4];
        if (mt < wave) {
#pragma unroll
            for (int r = 0; r < 4; ++r) v[r] = as[mt][r] * __expf(fs[16 * mt + 4 * fq + r] - Mt);
        } else if (mt == wave) {
#pragma unroll
            for (int r = 0; r < 4; ++r) v[r] = (r <= lim) ? as[mt][r] * __expf(fs[16 * mt + 4 * fq + r] - Mt) : 0.f;
        } else { v[0] = 0.f; v[1] = 0.f; v[2] = 0.f; v[3] = 0.f; }
        den += (v[0] + v[1]) + (v[2] + v[3]);
        if (mt <= wave || (wave & 1) == 0) *(LAS u2*)(Kc + t * LP + 16 * mt + 4 * fq) = (u2){pk2(v[0], v[1]), pk2(v[2], v[3])}; }
    den += __shfl_xor(den, 16); den += __shfl_xor(den, 32);
    __syncthreads();
    f4 ao[16]; const float iw = fs[512 + t];
#pragma unroll
    for (int mt = 0; mt < 16; ++mt) ao[mt] = (f4){0.f, 0.f, 0.f, 0.f};
#pragma unroll
    for (int ks = 0; ks < 4; ++ks) { const s8v bq = *(const LAS s8v*)(Qc + t * LP + 32 * ks + 8 * fq);
#pragma unroll
        for (int mt = 0; mt < 8; ++mt) ao[mt] = MFMA16(cpa[ks * 8 + mt], bq, ao[mt]); }
#pragma unroll
    for (int ks = 0; ks < 4; ++ks)
#pragma unroll
        for (int mt = 0; mt < 8; ++mt) cpa[ks * 8 + mt] = *(const s8v*)(cp + (size_t)(16 * (mt + 8)) * 128 + 32 * ks);
#pragma unroll
    for (int ks = 0; ks < 4; ++ks) { const s8v bq = *(const LAS s8v*)(Qc + t * LP + 32 * ks + 8 * fq);
#pragma unroll
        for (int mt = 0; mt < 8; ++mt) ao[8 + mt] = MFMA16(cpa[ks * 8 + mt], bq, ao[8 + mt]); }
    const bf16r* mlo = (const bf16r*)(ws + WS_MLO) + (size_t)(t0 + t) * 1024 + h * 256 + 4 * fq; const bf16r* mlz = (const bf16r*)(ws + WS_MLZ) + (size_t)(t0 + t) * 1024 + h * 256 + 4 * fq;
    u2 ovv[16], zvv[16];
#pragma unroll
    for (int mt = 0; mt < 16; ++mt) { ovv[mt] = __builtin_nontemporal_load((const u2*)(mlo + 16 * mt)); zvv[mt] = __builtin_nontemporal_load((const u2*)(mlz + 16 * mt)); }
#pragma unroll
    for (int mt = 0; mt < 16; ++mt) ao[mt] = ao[mt] * iw;
    const int nks = (wave + 2) >> 1;
    for (int ks = 0; ks < nks; ++ks) { const s8v bs = *(const LAS s8v*)(Kc + t * LP + 32 * ks + 8 * fq);
#pragma unroll
        for (int mt = 0; mt < 16; ++mt) { const s8v av = tr_frag(Vn + 32 * ks * LPV + 16 * mt, LPV, fr, fq); ao[mt] = MFMA16(av, bs, ao[mt]); } }
    const float dt = den + iw * fs[768 + t], inv = 1.f / fmaxf(fabsf(dt), fs[640 + t]);
    float ssq = 0.f;
#pragma unroll
    for (int mt = 0; mt < 16; ++mt) { const f4 hv = ao[mt] * inv; ssq += (hv[0] * hv[0] + hv[1] * hv[1]) + (hv[2] * hv[2] + hv[3] * hv[3]); }
    ssq += __shfl_xor(ssq, 16); ssq += __shfl_xor(ssq, 32);
    const float rstd = rsqrtf(ssq * (1.f / 256.f) + EPS) * inv;
    const float* gn = (const float*)a.in[9] + h * 256 + 4 * fq;
    bf16r* ao_out = (bf16r*)(ws + WS_AO) + (size_t)(t0 + t) * 2048 + h * 256 + 4 * fq;
#pragma unroll
    for (int mt = 0; mt < 16; ++mt) { const f4 g = *(const f4*)(gn + 16 * mt); const u2 ov = ovv[mt], zv = zvv[mt];
        const float r0 = ao[mt][0] * rstd * g.x * sigm(bflo(ov.x)) * silu(bflo(zv.x)), r1 = ao[mt][1] * rstd * g.y * sigm(bfhi(ov.x)) * silu(bfhi(zv.x));
        const float r2 = ao[mt][2] * rstd * g.z * sigm(bflo(ov.y)) * silu(bflo(zv.y)), r3 = ao[mt][3] * rstd * g.w * sigm(bfhi(ov.y)) * silu(bfhi(zv.y));
        *(u2*)(ao_out + 16 * mt) = (u2){pk2(r0, r1), pk2(r2, r3)}; }
    __syncthreads();
}

__device__ __forceinline__ void da_combine(const Args& a, int lane, int wave, int G) {
    unsigned char* ws = a.ws; const int gw = blockIdx.x * 8 + wave, NGW = G * 8;
    const float* q1 = (const float*)a.in[10]; const float* k1 = (const float*)a.in[11]; const float* q2 = (const float*)a.in[12]; const float* k2 = (const float*)a.in[13];
    const float s1 = wave_sum(q1[lane] * k1[lane] + q1[lane + 64] * k1[lane + 64]), s2 = wave_sum(q2[lane] * k2[lane] + q2[lane + 64] * k2[lane + 64]);
    const float lam_init = 0.2f, lam = expf(s1) - expf(s2) + lam_init;
    const bf16r* dao = (const bf16r*)(ws + WS_DAO); const bf16r* daz = (const bf16r*)(ws + WS_DAZ); bf16r* ao = (bf16r*)(ws + WS_AO);
    const float* gn = (const float*)a.in[14];
    const int half = lane >> 5, d = (lane & 31) * 4, dv = half * 128 + d;
    for (int it0 = gw; it0 < TOK * 4; it0 += 4 * NGW) {
        u2 o0[4], o1[4], zv[4]; f4 g[4];
#pragma unroll
        for (int k = 0; k < 4; ++k) { const int it = it0 + k * NGW, tok = it >> 2, h = it & 3, b = tok >> 11, s = tok & 2047;
            o0[k] = __builtin_nontemporal_load((const u2*)(dao + ((size_t)(((b * 4 + h) * 2 + 0) * 2 + half) * 2048 + s) * 128 + d)); o1[k] = __builtin_nontemporal_load((const u2*)(dao + ((size_t)(((b * 4 + h) * 2 + 1) * 2 + half) * 2048 + s) * 128 + d));
            g[k] = *(const f4*)(gn + h * 256 + dv); zv[k] = __builtin_nontemporal_load((const u2*)(daz + (size_t)tok * 1024 + h * 256 + dv)); }
#pragma unroll
        for (int k = 0; k < 4; ++k) { const int it = it0 + k * NGW, tok = it >> 2, h = it & 3;
            const float h0 = bflo(o0[k].x) - lam * bflo(o1[k].x), h1 = bfhi(o0[k].x) - lam * bfhi(o1[k].x), h2 = bflo(o0[k].y) - lam * bflo(o1[k].y), h3 = bfhi(o0[k].y) - lam * bfhi(o1[k].y);
            const float rstd = rsqrtf(wave_sum((h0 * h0 + h1 * h1) + (h2 * h2 + h3 * h3)) * (1.f / 256.f) + EPS) * (1.f - lam_init);
            *(u2*)(ao + (size_t)tok * 2048 + 1024 + h * 256 + dv) = (u2){pk2(h0 * rstd * g[k].x * silu(bflo(zv[k].x)), h1 * rstd * g[k].y * silu(bfhi(zv[k].x))), pk2(h2 * rstd * g[k].z * silu(bflo(zv[k].y)), h3 * rstd * g[k].w * silu(bfhi(zv[k].y)))}; } }
}

__device__ __forceinline__ void sgu_unit(const Args& a, LAS unsigned char* lds, int unit, int tid, int lane, int wave) {
    unsigned char* ws = a.ws;
    const int b = unit >> 7, c = (unit >> 3) & 15, g = unit & 7, t0 = b * 2048 + c * 128;
    LAS bf16r* VLn = (LAS bf16r*)lds;
    LAS bf16r* Wt = (LAS bf16r*)(lds + 69632);
    LAS float* fs = (LAS float*)(lds + 104448);
    if (tid < 128) { const f4* p1 = (const f4*)((const float*)(ws + WS_LNS) + (size_t)(t0 + tid) * 32); const f4* p2 = (const f4*)((const float*)(ws + WS_LNQ) + (size_t)(t0 + tid) * 32); float s1 = 0.f, s2 = 0.f;
#pragma unroll
        for (int i = 0; i < 8; ++i) { const f4 x1 = p1[i], x2 = p2[i]; s1 += (x1.x + x1.y) + (x1.z + x1.w); s2 += (x2.x + x2.y) + (x2.z + x2.w); }
        const float mu = s1 * (1.f / DM), var = fmaxf(s2 * (1.f / DM) - mu * mu, 0.f); fs[tid] = mu; fs[128 + tid] = rsqrtf(var + EPS); }
    __syncthreads();
    const bf16r* V = (const bf16r*)(ws + WS_V); const float* lg = (const float*)a.in[18] + g * 256; const float* lb = (const float*)a.in[19] + g * 256;
    const int dgs = (tid & 31) * 8;
    const f4 g0 = *(const f4*)(lg + dgs), g1 = *(const f4*)(lg + dgs + 4), b0 = *(const f4*)(lb + dgs), b1 = *(const f4*)(lb + dgs + 4);
#pragma unroll
    for (int it = tid; it < 128 * 32; it += 512) { const int s = it >> 5, dg = dgs; const float mu = fs[s], rs = fs[128 + s];
        const u4 xv = __builtin_nontemporal_load((const u4*)(V + (size_t)(t0 + s) * 2048 + g * 256 + dg));
        const unsigned w0 = pk2((bflo(xv.x) - mu) * rs * g0.x + b0.x, (bfhi(xv.x) - mu) * rs * g0.y + b0.y), w1 = pk2((bflo(xv.y) - mu) * rs * g0.z + b0.z, (bfhi(xv.y) - mu) * rs * g0.w + b0.w);
        const unsigned w2 = pk2((bflo(xv.z) - mu) * rs * g1.x + b1.x, (bfhi(xv.z) - mu) * rs * g1.y + b1.y), w3 = pk2((bflo(xv.w) - mu) * rs * g1.z + b1.z, (bfhi(xv.w) - mu) * rs * g1.w + b1.w);
        *(LAS u4*)(VLn + s * LPV + dg) = (u4){w0, w1, w2, w3}; }
    const float* sw = (const float*)a.in[20] + (size_t)g * 128 * 128;
#pragma unroll
    for (int it = tid; it < 128 * 16; it += 512) { const int t = it >> 4, sg = (it & 15) * 8; f4 w0 = *(const f4*)(sw + t * 128 + sg), w1 = *(const f4*)(sw + t * 128 + sg + 4);
        if (sg + 0 > t) w0.x = 0.f; if (sg + 1 > t) w0.y = 0.f; if (sg + 2 > t) w0.z = 0.f; if (sg + 3 > t) w0.w = 0.f;
        if (sg + 4 > t) w1.x = 0.f; if (sg + 5 > t) w1.y = 0.f; if (sg + 6 > t) w1.z = 0.f; if (sg + 7 > t) w1.w = 0.f;
        *(LAS u4*)(Wt + t * LP + sg) = (u4){pk2(w0.x, w0.y), pk2(w0.z, w0.w), pk2(w1.x, w1.y), pk2(w1.z, w1.w)}; }
    __syncthreads();
    const int fr = lane & 15, fq = lane >> 4, t = 16 * wave + fr;
    f4 ac[16];
#pragma unroll
    for (int mt = 0; mt < 16; ++mt) ac[mt] = (f4){0.f, 0.f, 0.f, 0.f};
    const int nks = (wave + 2) >> 1;
    for (int ks = 0; ks < nks; ++ks) { const s8v bw = *(const LAS s8v*)(Wt + t * LP + 32 * ks + 8 * fq);
#pragma unroll
        for (int mt = 0; mt < 16; ++mt) { const s8v av = tr_frag(VLn + 32 * ks * LPV + 16 * mt, LPV, fr, fq); ac[mt] = MFMA16(av, bw, ac[mt]); } }
    __syncthreads();
    LAS float* OUTS = (LAS float*)lds;
    { const float sb = ((const float*)a.in[21])[g * 128 + t];
#pragma unroll
      for (int mt = 0; mt < 16; ++mt) *(LAS f4*)(OUTS + t * 260 + 16 * mt + 4 * fq) = ac[mt] + sb; }
    __syncthreads();
    { const int dg = (tid & 31) * 8;
      const bf16r* U = (const bf16r*)a.out + (size_t)t0 * 2048 + g * 256 + dg; const bf16r* Z = U + (size_t)TOK * DM; bf16r* MB = (bf16r*)(ws + WS_MB) + (size_t)t0 * 2048 + g * 256 + dg;
      u4 uw[8], zw[8];
#pragma unroll
      for (int n = 0; n < 8; ++n) { const int tt = (tid >> 5) + 16 * n; uw[n] = __builtin_nontemporal_load((const u4*)(U + (size_t)tt * 2048)); zw[n] = __builtin_nontemporal_load((const u4*)(Z + (size_t)tt * 2048)); }
#pragma unroll
      for (int n = 0; n < 8; ++n) { const int tt = (tid >> 5) + 16 * n; const f4 s0 = *(const LAS f4*)(OUTS + tt * 260 + dg), s1 = *(const LAS f4*)(OUTS + tt * 260 + dg + 4);
          u4 o; o.x = pk2(bflo(uw[n].x) * s0.x * silu(bflo(zw[n].x)), bfhi(uw[n].x) * s0.y * silu(bfhi(zw[n].x))); o.y = pk2(bflo(uw[n].y) * s0.z * silu(bflo(zw[n].y)), bfhi(uw[n].y) * s0.w * silu(bfhi(zw[n].y)));
          o.z = pk2(bflo(uw[n].z) * s1.x * silu(bflo(zw[n].z)), bfhi(uw[n].z) * s1.y * silu(bfhi(zw[n].z))); o.w = pk2(bflo(uw[n].w) * s1.z * silu(bflo(zw[n].w)), bfhi(uw[n].w) * s1.w * silu(bfhi(zw[n].w)));
          *(u4*)(MB + (size_t)tt * 2048) = o; } }
    __syncthreads();
}

__device__ __forceinline__ void final_norm(const Args& a, int lane, int wave, int G) {
    const int gw = blockIdx.x * 8 + wave, NGW = G * 8; const f4* gn = (const f4*)a.in[26];
    for (int m = gw; m < TOK; m += NGW) { f4* xr = (f4*)(a.out + (size_t)m * DM) + lane; f4 v[8]; float s = 0.f;
#pragma unroll
        for (int j = 0; j < 8; ++j) { v[j] = xr[64 * j]; s += (v[j].x * v[j].x + v[j].y * v[j].y) + (v[j].z * v[j].z + v[j].w * v[j].w); }
        const float rstd = rsqrtf(wave_sum(s) * (1.f / DM) + EPS);
#pragma unroll
        for (int j = 0; j < 8; ++j) xr[64 * j] = v[j] * rstd * gn[lane + 64 * j]; }
}

__device__ __forceinline__ void attn_phase(const Args& a, char* lds, int G) {
    using namespace att;
    unsigned char* ws = a.ws;
    const bf16* DQ = (const bf16*)(ws + WS_DAQ); const bf16* DK = (const bf16*)(ws + WS_DAK); const bf16* DV = (const bf16*)(ws + WS_DAV); bf16* DO = (bf16*)(ws + WS_DAO);
    const int W = 1 << 30;
    { const int L = blockIdx.x;
        const int xcd = L & 7, slot = L >> 3, grp = xcd * 2 + (slot >> 4), w = slot & 15, map = w >> 3, half = (w >> 2) & 1, x = w & 3;
        const bf16* Q = DQ + (size_t)(grp * 2 + map) * 2048 * 128; const bf16* K = DK + (size_t)(grp * 2 + map) * 2048 * 128;
        const bf16* V = DV + (size_t)(grp * 2 + half) * 2048 * 128; bf16* O = DO + (size_t)((grp * 2 + map) * 2 + half) * 2048 * 128;
        const int qb0 = x, qb1 = 7 - x;
        BlockRef<bf16, bf16> c0, c1;
        c0.Q = Q + (size_t)qb0 * QB * D; c0.K = K; c0.V = V; c0.O = O + (size_t)qb0 * QB * D; c0.P0 = qb0 * QB;
        c1.Q = Q + (size_t)qb1 * QB * D; c1.K = K; c1.V = V; c1.O = O + (size_t)qb1 * QB * D; c1.P0 = qb1 * QB;
        Seam<bf16> S;
        causal_swa_prime<bf16, bf16>(c0, W, lds, S);
        causal_swa_block<bf16, bf16>(c0, c1, 2048, W, lds, S);
        causal_swa_block<bf16, bf16>(c1, c1, 2048, W, lds, S);
        __syncthreads();
    }
}

#ifndef MK_LAUNCHES
#define MK_LAUNCHES 1
#endif
constexpr int NPHASE = 11;
__global__ void __launch_bounds__(512, 2) mk_fwd(Args args_unused) {
    extern __shared__ __attribute__((aligned(16))) unsigned char lds_raw[];
    LAS unsigned char* lds = (LAS unsigned char*)lds_raw;
    const int G = gridDim.x;
#define TIDS int tid = threadIdx.x; asm volatile("" : "+v"(tid)); const int lane = tid & 63, wave = __builtin_amdgcn_readfirstlane(tid >> 6); (void)tid; (void)lane; (void)wave
    const unsigned long long lohi = karg64(232); const int lo = (int)(unsigned)lohi, hi = (int)(unsigned)(lohi >> 32);
#define IN(k) (lo <= (k) && (k) < hi)
#if MK_LAUNCHES == 1
    if ((int)(unsigned)(karg64(232) >> 32) > NPHASE) cg::this_grid().sync();
    if (threadIdx.x < 2) ((volatile LAS unsigned*)(lds + LDS_BARST))[threadIdx.x] = 0u;
    __syncthreads();
    (void)xcd_barrier_post((unsigned*)(GAS unsigned*)(karg64(224) + WS_BAR), (volatile LAS unsigned*)(lds + LDS_BARST));
#define SEAM(k) do { if (IN(k) && IN((k) + 1)) { XcdBarrier b_; b_.bar = (unsigned*)(GAS unsigned*)(karg64(224) + WS_BAR); b_.x = xb_xcc_id(); b_.st = (volatile LAS unsigned*)(lds + LDS_BARST); xcd_barrier(b_); } } while (0)
#else
#define SEAM(k) do { } while (0)
#endif
    typedef pg8::EpiBf16<0> EpiPlain;
    if (IN(0)) { TIDS; Args args; KWS(args); KIN(args, 0); KIN(args, 1); KIN(args, 2); KIN(args, 3); KIN(args, 4); KIN(args, 7); KIN(args, 8); KIN(args, 15); KIN(args, 23); KIN(args, 24); KIN(args, 25);
        phase0<7>(args, lds, tid, lane, wave, G); }
#ifdef MK_P4_PART
    if (lo == 21) {
        if (MK_P4_PART & 1) { TIDS; Args args; KWS(args); KIN(args, 5); KIN(args, 6); KIN(args, 9);
          __syncthreads();
          for (int rr = 0; rr < MK_INNER; ++rr) for (int u = blockIdx.x; u < 256; u += G) m3_unit(args, lds, u, tid, lane, wave); }
        if (MK_P4_PART & 2) { TIDS; Args args; KWS(args); KIN(args, 10); KIN(args, 11); KIN(args, 12); KIN(args, 13); KIN(args, 14);
          da_combine(args, lane, wave, G); }
    }
#endif
#ifdef MK_P0_PART
    if (lo == 20) { TIDS; Args args; KWS(args); KIN(args, 0); KIN(args, 1); KIN(args, 2); KIN(args, 3); KIN(args, 4); KIN(args, 7); KIN(args, 8); KIN(args, 15); KIN(args, 23); KIN(args, 24); KIN(args, 25);
        phase0<MK_P0_PART>(args, lds, tid, lane, wave, G); }
#endif
    SEAM(0);
    if (IN(1)) {
        Args args; KWS(args); unsigned char* ws = args.ws;
        __syncthreads();
        { pg8::Gemm g{(const bf16r*)(ws + WS_H), (const bf16r*)(ws + WS_WIN), TOK, 8192, 2048}; pg8::StaticOrder S; S.init(TOK, 8192, G, (int)blockIdx.x);
          EpiG1 E{ws}; pg8::gemm_phase<EpiG1, pg8::StaticOrder, true, true>(lds, g, S, E); }
        __syncthreads();
        { pg8::Gemm g{(const bf16r*)(ws + WS_PB), (const bf16r*)(ws + WS_WPP0), TOK, 2048, 256}; pg8::StaticOrder S; S.init(TOK, 2048, G, (int)blockIdx.x);
          EpiPlain E{(bf16r*)(ws + WS_PP0), 2048, nullptr, 0, 0, 1.f}; pg8::gemm_phase<EpiPlain, pg8::StaticOrder, true, true>(lds, g, S, E); }
    }
    SEAM(1);
    if (IN(2)) {
        TIDS; Args args; KWS(args); KIN(args, 5); KIN(args, 6);
        __syncthreads();
        attn_phase(args, (char*)lds_raw, G);
        __syncthreads();
        for (int u = blockIdx.x; u < 256; u += G) m1_unit(args, lds, u, tid, lane, wave);
    }
    SEAM(2);
    if (IN(3)) { TIDS; Args args; KWS(args); m2_scan(args, tid, G); }
    SEAM(3);
    if (IN(4)) {
        { TIDS; Args args; KWS(args); KIN(args, 5); KIN(args, 6); KIN(args, 9);
          __syncthreads();
#ifdef MK_M3_STAGE2
          for (int rr = 0; rr < MK_M3_STAGE2; ++rr) { for (int u = blockIdx.x; u < 256; u += G) m3_unit<1>(args, lds, u, tid, lane, wave); __syncthreads(); }
#endif
          for (int u = blockIdx.x; u < 256; u += G) m3_unit(args, lds, u, tid, lane, wave); }
        { TIDS; Args args; KWS(args); KIN(args, 10); KIN(args, 11); KIN(args, 12); KIN(args, 13); KIN(args, 14);
          da_combine(args, lane, wave, G); }
    }
    SEAM(4);
    if (IN(5)) {
        TIDS; Args args; KWS(args); KOUT(args); KIN(args, 0); KIN(args, 16); KIN(args, 17); KIN(args, 22); KIN(args, 23); KIN(args, 24); KIN(args, 25); unsigned char* ws = args.ws;
        __syncthreads();
        l1_weights(args, lds, lane, wave, G);
        __syncthreads();
        pg8::Gemm g{(const bf16r*)(ws + WS_AO), (const bf16r*)(ws + WS_WOUT0), TOK, 2048, 2048}; pg8::StaticOrder S; S.init(TOK, 2048, G, (int)blockIdx.x);
        EpiRes<false> E{args.in[0], (bf16r*)(ws + WS_X1B), (float*)(ws + WS_SSQA)};
        pg8::gemm_phase<EpiRes<false>, pg8::StaticOrder, true, true>(lds, g, S, E);
    }
    SEAM(5);
    if (IN(6)) {
        Args args; KWS(args); KOUT(args); unsigned char* ws = args.ws;
        __syncthreads();
        pg8::Gemm g{(const bf16r*)(ws + WS_X1B), (const bf16r*)(ws + WS_WG0), TOK, 2048, 2048}; pg8::StaticOrder S; S.init(TOK, 2048, G, (int)blockIdx.x);
        EpiGate E{(const bf16r*)(ws + WS_X1B), (bf16r*)(ws + WS_X2B), (const bf16r*)(ws + WS_PP0), (const float*)(ws + WS_SSQA), (float*)(ws + WS_SSQB)};
        pg8::gemm_phase<EpiGate, pg8::StaticOrder, true, true>(lds, g, S, E);
    }
    SEAM(6);
    if (IN(7)) {
        Args args; KWS(args); KOUT(args); unsigned char* ws = args.ws;
        __syncthreads();
        { pg8::Gemm g{(const bf16r*)(ws + WS_X2B), (const bf16r*)(ws + WS_WCIN), TOK, 6144, 2048}; pg8::StaticOrder S; S.init(TOK, 6144, G, (int)blockIdx.x);
          EpiUVZ E{(bf16r*)args.out, (bf16r*)(ws + WS_V), (const float*)(ws + WS_SSQB), (float*)(ws + WS_LNS), (float*)(ws + WS_LNQ)};
          pg8::gemm_phase<EpiUVZ, pg8::StaticOrder, true, true>(lds, g, S, E); }
        __syncthreads();
        { pg8::Gemm g{(const bf16r*)(ws + WS_PB) + (size_t)TOK * 256, (const bf16r*)(ws + WS_WPP1), TOK, 2048, 256}; pg8::StaticOrder S; S.init(TOK, 2048, G, (int)blockIdx.x);
          EpiPlain E{(bf16r*)(ws + WS_PP1), 2048, nullptr, 0, 0, 1.f}; pg8::gemm_phase<EpiPlain, pg8::StaticOrder, true, true>(lds, g, S, E); }
    }
    SEAM(7);
    if (IN(8)) {
        TIDS; Args args; KWS(args); KOUT(args); KIN(args, 18); KIN(args, 19); KIN(args, 20); KIN(args, 21);
        __syncthreads();
        for (int u = blockIdx.x; u < 512; u += G) sgu_unit(args, lds, u, tid, lane, wave);
    }
    SEAM(8);
    if (IN(9)) {
        Args args; KWS(args); KOUT(args); unsigned char* ws = args.ws;
        __syncthreads();
        pg8::Gemm g{(const bf16r*)(ws + WS_MB), (const bf16r*)(ws + WS_WCOUT), TOK, 2048, 2048}; pg8::StaticOrder S; S.init(TOK, 2048, G, (int)blockIdx.x);
        EpiRes<true> E{(const void*)(ws + WS_X2B), (bf16r*)(ws + WS_X3B), (float*)(ws + WS_SSQC)};
        pg8::gemm_phase<EpiRes<true>, pg8::StaticOrder, true, true>(lds, g, S, E);
    }
    SEAM(9);
    if (IN(10)) {
        Args args; KWS(args); KOUT(args); KIN(args, 26); unsigned char* ws = args.ws;
        __syncthreads();
        pg8::Gemm g{(const bf16r*)(ws + WS_X3B), (const bf16r*)(ws + WS_WG1), TOK, 2048, 2048}; pg8::StaticOrder S; S.init(TOK, 2048, G, (int)blockIdx.x);
        EpiGateFinal E{(const bf16r*)(ws + WS_X3B), args.out, (const bf16r*)(ws + WS_PP1), (const float*)(ws + WS_SSQC), (float*)(ws + WS_SSQA), (unsigned*)(ws + WS_BAR + 16384), (const float*)args.in[26]};
        pg8::gemm_phase<EpiGateFinal, pg8::StaticOrder, true, true>(lds, g, S, E);
    }
#undef IN
#undef SEAM
}

extern "C" void kernel_launch(void* const* d_in, const int* in_sizes, int n_in, void* d_out, int out_size, void* d_ws, size_t ws_size, hipStream_t stream) {
    static int grid = 0;
    if (grid == 0) {
        if (n_in != 27 || out_size != TOK * DM || ws_size < WS_END) { fprintf(stderr, "kernel_launch: unexpected shapes (n_in %d out %d ws %zu)\n", n_in, out_size, ws_size); grid = -1; return; }
        int dev = 0, cus = 0, per_cu = 0;
        (void)hipGetDevice(&dev); (void)hipDeviceGetAttribute(&cus, hipDeviceAttributeMultiprocessorCount, dev);
        (void)hipFuncSetAttribute((const void*)mk_fwd, hipFuncAttributeMaxDynamicSharedMemorySize, LDS_BYTES);
        (void)hipOccupancyMaxActiveBlocksPerMultiprocessor(&per_cu, (const void*)mk_fwd, 512, LDS_BYTES);
        if (per_cu < 1) { fprintf(stderr, "kernel_launch: occupancy query says %d blocks per CU\n", per_cu); per_cu = 1; }
        if (cus != 256) { fprintf(stderr, "kernel_launch: built for a 256-CU device (got %d)\n", cus); grid = -1; return; }
        grid = 256;
        (void)hipGetLastError();
    }
    if (grid < 0) return;
    Args a{};
    for (int i = 0; i < 27; ++i) a.in[i] = d_in[i];
    (void)hipMemsetAsync((unsigned char*)d_ws + WS_BAR, 0, 32768, stream);
    a.out = (float*)d_out; a.ws = (unsigned char*)d_ws;
#if MK_LAUNCHES == 1
    a.ph_lo = 0; a.ph_hi = NPHASE;
    void* kargs[] = {&a};
    hipError_t e = hipLaunchCooperativeKernel((const void*)mk_fwd, dim3(grid), dim3(512), kargs, LDS_BYTES, stream);
    if (e != hipSuccess) fprintf(stderr, "cooperative launch failed: %s (grid %d)\n", hipGetErrorString(e), grid);
#else
    for (int p = 0; p < NPHASE; ++p) { a.ph_lo = p; a.ph_hi = p + 1; hipLaunchKernelGGL(mk_fwd, dim3(grid), dim3(512), LDS_BYTES, stream, a);
#ifdef MK_REP_PHASE
#if defined(MK_P4_PART)
        if (p == 4) { a.ph_lo = 21; a.ph_hi = 22; for (int r = 0; r < MK_REP_N; ++r) hipLaunchKernelGGL(mk_fwd, dim3(grid), dim3(512), LDS_BYTES, stream, a); }
#elif defined(MK_P0_PART)
        if (p == 0) { a.ph_lo = 20; a.ph_hi = 21; for (int r = 0; r < MK_REP_N; ++r) hipLaunchKernelGGL(mk_fwd, dim3(grid), dim3(512), LDS_BYTES, stream, a); }
#else
        if (p == MK_REP_PHASE) for (int r = 0; r < MK_REP_N; ++r) hipLaunchKernelGGL(mk_fwd, dim3(grid), dim3(512), LDS_BYTES, stream, a);
#endif
#endif
    }
#endif
}
```

```cpp
#include <hip/hip_runtime.h>
#include <hip/hip_bf16.h>
#include <hip/hip_cooperative_groups.h>
#include <cstdio>
#include <cstdint>
namespace cg = cooperative_groups;
__device__ __forceinline__ int mk_tid() { int t = (int)threadIdx.x; asm volatile("" : "+v"(t)); return t; }
namespace pg8 {
#define PG8_LAS __attribute__((address_space(3)))
typedef unsigned short bf16_t;
typedef short bf16x8 __attribute__((ext_vector_type(8)));
typedef float f32x4 __attribute__((ext_vector_type(4)));
typedef unsigned u32x4 __attribute__((ext_vector_type(4)));
constexpr int BM = 256, BK = 64, HALF = 128, HTB = HALF * BK * 2  , STAGE_BYTES = 8 * HTB, NXCD = 8, WGM = 8;

__host__ __device__ __forceinline__ int lds_byte(int r, int c) { const int st = (r >> 4) * 2 + (c >> 5), rr = r & 15, cc = c & 31, ob = rr * 64 + cc * 2; return st * 1024 + (ob ^ (((ob >> 9) & 1) << 5)); }
__host__ __device__ __forceinline__ void stage_rc(int b, int& R, int& C) { const int st = b / 1024, sb = b % 1024, swz = sb ^ (((sb >> 9) & 1) << 5); R = (st >> 1) * 16 + swz / 64; C = (st & 1) * 32 + (swz % 64) / 2; }
__host__ __device__ __forceinline__ int perm32(int rho) { const int n = rho >> 4, i = rho & 15; return 8 * (i >> 2) + 4 * n + (i & 3); }

struct Unit { int pm, pn; };
struct Gemm { const bf16_t* A; const bf16_t* Bt; int M, N, K; };

struct StaticOrder {
    int nM, nN, nwg, G, c;
    __host__ __device__ void init(int M, int N, int G_, int c_) { nM = M / BM; nN = N / BM; nwg = nM * nN; G = G_; c = c_; }
    __host__ __device__ bool next(int i, Unit& u) const {
        const long L = (long)i * G + c; if (L >= nwg) return false;
        int wgid = (int)L; { const int q = nwg / NXCD, r = nwg % NXCD, xcd = wgid % NXCD, off = wgid / NXCD; wgid = (xcd < r ? xcd * (q + 1) : r * (q + 1) + (xcd - r) * q) + off; }
        const int nig = WGM * nN, gid = wgid / nig, fm = gid * WGM, gsz = (nM - fm) < WGM ? (nM - fm) : WGM;
        u.pm = fm + ((wgid % nig) % gsz); u.pn = (wgid % nig) / gsz; return true;
    }
    __device__ __forceinline__ void a_ready(const Unit&) const {}
    __device__ __forceinline__ void done(const Unit&) const {}
};

__device__ __forceinline__ unsigned cvt_pk_bf16(float lo, float hi) { unsigned r; asm volatile("v_cvt_pk_bf16_f32 %0, %1, %2" : "=v"(r) : "v"(lo), "v"(hi)); return r; }
typedef float f32x2 __attribute__((ext_vector_type(2)));
__device__ __forceinline__ f32x2 gelu_pk(f32x2 v) {
    const f32x2 av = __builtin_elementwise_abs(v), d = av * 0.2316418882f + 1.0f;
    f32x2 t; t.x = __builtin_amdgcn_rcpf(d.x); t.y = __builtin_amdgcn_rcpf(d.y);
    f32x2 q = t * 0.5307027145f + (-0.7265760135f); q = q * t + 0.7107068705f; q = q * t + (-0.142248368f); q = q * t + 0.127414796f; q = q * t;
    const f32x2 s = (v * v) * (-0.72134752044f);
    f32x2 e; e.x = __builtin_amdgcn_exp2f(s.x); e.y = __builtin_amdgcn_exp2f(s.y);
    const f32x2 m = v * (q * e), r = v - m;
    f32x2 o; o.x = v.x < 0.f ? m.x : r.x; o.y = v.y < 0.f ? m.y : r.y; return o;
}

template <int ACT  > struct EpiBf16 {
    static constexpr bool PERM = true, AFTER_DRAIN = false; static_assert(ACT == 0 || ACT == 1, "EpiBf16: ACT is 0 (none) or 1 (gelu_pk)");
    bf16_t* O; int ldc; const float* bias; int split_cols; size_t split_stride; float scale0;
    __device__ __forceinline__ void operator()(const f32x4 (&acc)[2][2][4][2], const Unit& u, int wr, int wc, int fr, int fq) const {
        const int row0 = u.pm * BM + wr * 64 + fr; int colt = u.pn * BM; bf16_t* base = O;
        float sc = 1.f; if (split_cols) { const int t = colt / split_cols; base += (size_t)t * split_stride; colt -= t * split_cols; if (t == 0) sc = scale0; }
        const int col0 = colt + wc * 32 + 8 * fq, bcol0 = u.pn * BM + wc * 32 + 8 * fq;
        f32x4 bv[2][2];
#pragma unroll
        for (int bj = 0; bj < 2; ++bj)
#pragma unroll
            for (int n = 0; n < 2; ++n) bv[bj][n] = bias ? *(const f32x4*)(bias + bcol0 + bj * HALF + 4 * n) : (f32x4){0.f, 0.f, 0.f, 0.f};
#pragma unroll
        for (int ai = 0; ai < 2; ++ai)
#pragma unroll
            for (int m = 0; m < 4; ++m) { bf16_t* rowp = base + (size_t)(row0 + ai * HALF + m * 16) * ldc + col0;
#pragma unroll
                for (int bj = 0; bj < 2; ++bj) { f32x4 v0 = acc[ai][bj][m][0] + bv[bj][0], v1 = acc[ai][bj][m][1] + bv[bj][1];
                    if (ACT == 1) { f32x2 a = gelu_pk((f32x2){v0[0], v0[1]}), b = gelu_pk((f32x2){v0[2], v0[3]}), c = gelu_pk((f32x2){v1[0], v1[1]}), d = gelu_pk((f32x2){v1[2], v1[3]});
                        v0 = (f32x4){a.x, a.y, b.x, b.y}; v1 = (f32x4){c.x, c.y, d.x, d.y}; }
                    v0 = v0 * sc; v1 = v1 * sc; u32x4 w; w.x = cvt_pk_bf16(v0[0], v0[1]); w.y = cvt_pk_bf16(v0[2], v0[3]); w.z = cvt_pk_bf16(v1[0], v1[1]); w.w = cvt_pk_bf16(v1[2], v1[3]);
                    *(u32x4*)(rowp + bj * HALF) = w; } }
    }
};

template <class Epi, class Sched, bool ALIGN_EPI = false, bool SP2 = false>
__device__ __forceinline__ void gemm_phase(PG8_LAS unsigned char* lds, const Gemm g, const Sched& S, const Epi& E) {
    const int tid = mk_tid(), wid = __builtin_amdgcn_readfirstlane(tid >> 6), lane = tid & 63, wr = wid >> 2, wc = wid & 3, fr = lane & 15, fq = lane >> 4;
    const int K = g.K, nt = K / BK;
    unsigned voffA[2], voffB[2];
#pragma unroll
    for (int i = 0; i < 2; ++i) { int R, C; stage_rc(tid * 16 + i * 8192, R, C); const int Rb = Epi::PERM ? ((R & ~31) + perm32(R & 31)) : R;
        voffA[i] = (unsigned)(R * K + C) * 2u; voffB[i] = (unsigned)(Rb * K + C) * 2u; }
    const size_t kstep = (size_t)(BK * 2);
    const size_t hstep = (size_t)HALF * K * 2;
    const size_t tstep = 2 * hstep;
    const unsigned ldsw = (unsigned)wid * 1024u;
    const int aoff = lds_byte(wr * 64 + fr, fq * 8), boff = lds_byte(wc * 32 + fr, fq * 8);
#define PG8_SA(b, h) (((b) * 2 + (h)) * HTB)
#define PG8_SB(b, h) ((4 + (b) * 2 + (h)) * HTB)
#define PG8_STAGE(bufoff, gbase, voff) do { _Pragma("unroll") for (int _i = 0; _i < 2; ++_i) \
        __builtin_amdgcn_global_load_lds((const unsigned*)((const char*)(gbase) + (voff)[_i]), (PG8_LAS unsigned*)(lds + (bufoff) + ldsw + _i * 8192), 16, 0, 0); } while (0)
#define PG8_LDA(dst, b, h) do { _Pragma("unroll") for (int m = 0; m < 4; ++m) _Pragma("unroll") for (int k = 0; k < 2; ++k) dst[m][k] = *(const PG8_LAS bf16x8*)(lds + PG8_SA(b, h) + aoff + m * 2048 + k * 1024); } while (0)
#define PG8_LDB(dst, b, h) do { _Pragma("unroll") for (int n = 0; n < 2; ++n) _Pragma("unroll") for (int k = 0; k < 2; ++k) dst[n][k] = *(const PG8_LAS bf16x8*)(lds + PG8_SB(b, h) + boff + n * 2048 + k * 1024); } while (0)
#define PG8_MMA(ai, bj, At, Bt) do { __builtin_amdgcn_s_setprio(1); _Pragma("unroll") for (int m = 0; m < 4; ++m) _Pragma("unroll") for (int n = 0; n < 2; ++n) _Pragma("unroll") for (int k = 0; k < 2; ++k) \
        acc[ai][bj][m][n] = __builtin_amdgcn_mfma_f32_16x16x32_bf16(Bt[n][k], At[m][k], acc[ai][bj][m][n], 0, 0, 0); __builtin_amdgcn_s_setprio(0); } while (0)
#define PG8_WAIT_V(n) asm volatile("s_waitcnt vmcnt(" #n ")" ::: "memory")
#define PG8_WAIT_L(n) asm volatile("s_waitcnt lgkmcnt(" #n ")" ::: "memory")
#define PG8_BAR __builtin_amdgcn_s_barrier()
#define PG8_SCHED __builtin_amdgcn_sched_barrier(0)
    Unit cur, nxt; int ui = 0;
    if (!S.next(0, cur)) return;
    f32x4 acc[2][2][4][2];
#pragma unroll
    for (int a = 0; a < 2; ++a)
#pragma unroll
        for (int b = 0; b < 2; ++b)
#pragma unroll
            for (int m = 0; m < 4; ++m)
#pragma unroll
                for (int n = 0; n < 2; ++n) acc[a][b][m][n] = (f32x4){0.f, 0.f, 0.f, 0.f};
    bf16x8 At[4][2], B0[2][2], B1[2][2];
    const char* cA = (const char*)g.A + (size_t)cur.pm * tstep; const char* cB = (const char*)g.Bt + (size_t)cur.pn * tstep;
    S.a_ready(cur);
    if constexpr (SP2) {
        PG8_STAGE(PG8_SB(0, 0), cB, voffB); PG8_STAGE(PG8_SB(0, 1), cB + hstep, voffB); PG8_STAGE(PG8_SA(0, 0), cA, voffA); PG8_STAGE(PG8_SA(0, 1), cA + hstep, voffA);
        if (wr == 1) PG8_BAR;
        PG8_WAIT_V(2); PG8_BAR;
        PG8_STAGE(PG8_SB(1, 0), cB + kstep, voffB); PG8_STAGE(PG8_SA(1, 0), cA + kstep, voffA); PG8_STAGE(PG8_SB(1, 1), cB + hstep + kstep, voffB);
        PG8_WAIT_V(6); PG8_BAR;
    } else {
        PG8_STAGE(PG8_SB(0, 0), cB, voffB); PG8_STAGE(PG8_SA(0, 0), cA, voffA); PG8_STAGE(PG8_SB(0, 1), cB + hstep, voffB); PG8_STAGE(PG8_SA(0, 1), cA + hstep, voffA);
        if (wr == 1) PG8_BAR;
        PG8_WAIT_V(4); PG8_BAR;
        PG8_STAGE(PG8_SB(1, 0), cB + kstep, voffB); PG8_STAGE(PG8_SA(1, 0), cA + kstep, voffA); PG8_STAGE(PG8_SB(1, 1), cB + hstep + kstep, voffB);
        PG8_WAIT_V(6); PG8_BAR;
    }
    for (;;) {
        const bool has_next = S.next(ui + 1, nxt);
        const char* nA = has_next ? (const char*)g.A + (size_t)nxt.pm * tstep : cA; const char* nB = has_next ? (const char*)g.Bt + (size_t)nxt.pn * tstep : cB;
        for (int t = 0; t < nt; t += 2) {
            const bool last = (t == nt - 2);
            const char* a1 = cA + (size_t)(t + 1) * kstep;
            const char* a2 = last ? nA : cA + (size_t)(t + 2) * kstep; const char* b2 = last ? nB : cB + (size_t)(t + 2) * kstep;
            const char* a3 = a2 + kstep; const char* b3 = b2 + kstep;
            if (last && has_next) S.a_ready(nxt);
            if constexpr (SP2) {
            PG8_LDB(B0, 0, 0); PG8_LDB(B1, 0, 1); PG8_SCHED; PG8_LDA(At, 0, 0); PG8_STAGE(PG8_SA(1, 1), a1 + hstep, voffA);
            PG8_WAIT_V(8); PG8_WAIT_L(0); PG8_BAR; PG8_MMA(0, 0, At, B0); PG8_MMA(0, 1, At, B1); PG8_BAR; PG8_SCHED;
            PG8_LDA(At, 0, 1); PG8_STAGE(PG8_SB(0, 0), b2, voffB); PG8_STAGE(PG8_SB(0, 1), b2 + hstep, voffB); PG8_STAGE(PG8_SA(0, 0), a2, voffA);
            PG8_WAIT_V(8); PG8_WAIT_L(0); PG8_BAR; PG8_MMA(1, 0, At, B0); PG8_MMA(1, 1, At, B1); PG8_BAR; PG8_SCHED;
            PG8_LDB(B0, 1, 0); PG8_LDB(B1, 1, 1); PG8_SCHED; PG8_LDA(At, 1, 0); PG8_STAGE(PG8_SA(0, 1), a2 + hstep, voffA);
            PG8_WAIT_V(8); PG8_WAIT_L(0); PG8_BAR; PG8_MMA(0, 0, At, B0); PG8_MMA(0, 1, At, B1); PG8_BAR; PG8_SCHED;
            PG8_LDA(At, 1, 1); PG8_STAGE(PG8_SB(1, 0), b3, voffB); PG8_STAGE(PG8_SB(1, 1), b3 + hstep, voffB); PG8_STAGE(PG8_SA(1, 0), a3, voffA);
            PG8_WAIT_V(8); PG8_WAIT_L(0); PG8_BAR; PG8_MMA(1, 0, At, B0); PG8_MMA(1, 1, At, B1); PG8_BAR; PG8_SCHED;
            } else {
            PG8_LDB(B0, 0, 0); PG8_SCHED; PG8_LDA(At, 0, 0); PG8_STAGE(PG8_SA(1, 1), a1 + hstep, voffA);
            PG8_WAIT_L(8); PG8_BAR; PG8_WAIT_L(0); PG8_MMA(0, 0, At, B0); PG8_BAR; PG8_SCHED;
            PG8_LDB(B1, 0, 1); PG8_STAGE(PG8_SB(0, 0), b2, voffB);
            PG8_BAR; PG8_WAIT_L(0); PG8_MMA(0, 1, At, B1); PG8_BAR;
            PG8_LDA(At, 0, 1); PG8_STAGE(PG8_SA(0, 0), a2, voffA);
            PG8_BAR; PG8_WAIT_L(0); PG8_MMA(1, 0, At, B0); PG8_BAR; PG8_SCHED;
            PG8_STAGE(PG8_SB(0, 1), b2 + hstep, voffB);
            PG8_WAIT_V(6); PG8_BAR; PG8_MMA(1, 1, At, B1); PG8_BAR;
            PG8_LDB(B0, 1, 0); PG8_SCHED; PG8_LDA(At, 1, 0); PG8_STAGE(PG8_SA(0, 1), a2 + hstep, voffA);
            PG8_WAIT_L(8); PG8_BAR; PG8_WAIT_L(0); PG8_MMA(0, 0, At, B0); PG8_BAR; PG8_SCHED;
            PG8_LDB(B1, 1, 1); PG8_STAGE(PG8_SB(1, 0), b3, voffB);
            PG8_BAR; PG8_WAIT_L(0); PG8_MMA(0, 1, At, B1); PG8_BAR;
            PG8_LDA(At, 1, 1); PG8_STAGE(PG8_SA(1, 0), a3, voffA);
            PG8_BAR; PG8_WAIT_L(0); PG8_MMA(1, 0, At, B0); PG8_BAR; PG8_SCHED;
            PG8_STAGE(PG8_SB(1, 1), b3 + hstep, voffB);
            PG8_WAIT_V(6); PG8_BAR; PG8_MMA(1, 1, At, B1); PG8_BAR;
            }
        }
        if constexpr (ALIGN_EPI) { if (wr == 0) PG8_BAR; }
        if constexpr (!Epi::AFTER_DRAIN) { E(acc, cur, wr, wc, fr, fq); S.done(cur); }
        if (!has_next) break;
#pragma unroll
        for (int a = 0; a < 2; ++a)
#pragma unroll
            for (int b = 0; b < 2; ++b)
#pragma unroll
                for (int m = 0; m < 4; ++m)
#pragma unroll
                    for (int n = 0; n < 2; ++n) acc[a][b][m][n] = (f32x4){0.f, 0.f, 0.f, 0.f};
        cur = nxt; cA = nA; cB = nB; ++ui;
        if constexpr (ALIGN_EPI) { if (wr == 1) PG8_BAR; }
    }
    PG8_WAIT_V(0);
    if constexpr (!ALIGN_EPI) { if (wr == 0) PG8_BAR; }
    PG8_BAR;
    if constexpr (Epi::AFTER_DRAIN) { E.fused(acc, cur, wr, wc, fr, fq, lds, wid, lane); S.done(cur); }
#undef PG8_SA
#undef PG8_SB
#undef PG8_STAGE
#undef PG8_LDA
#undef PG8_LDB
#undef PG8_MMA
#undef PG8_WAIT_V
#undef PG8_WAIT_L
#undef PG8_BAR
#undef PG8_SCHED
}
}

namespace att {
constexpr int D = 128;
constexpr float THR = 8.f;
constexpr bool WSKIP = false;
constexpr float SCALE = 0.08838834764831845f;
constexpr int NW = 8, QBLK = 32, KVBLK = 64, QB = NW * QBLK;
constexpr int SHM_V = KVBLK * D * 2, SHM_K = KVBLK * D * 2;
constexpr int LDS_BYTES = 2 * SHM_V + 2 * SHM_K + NW * 64 * 4;

using bf16 = __hip_bfloat16;
typedef short bf16x8 __attribute__((ext_vector_type(8)));
typedef short s16x4 __attribute__((ext_vector_type(4)));
typedef float f32x16 __attribute__((ext_vector_type(16)));
typedef float f32x4 __attribute__((ext_vector_type(4)));
typedef unsigned u32x4 __attribute__((ext_vector_type(4)));
template <class A, class Bt> struct same_t { static constexpr bool v = false; };
template <class A> struct same_t<A, A> { static constexpr bool v = true; };

#define KSWZ(row, colB) ((row) * 256 + ((colB) ^ (((row) & 7) << 4)))
#define SBAR() __builtin_amdgcn_sched_barrier(0)
__device__ __forceinline__ int v_st(int k, int c) { const int kk = (k & ~0xC) | ((k & 4) << 1) | ((k & 8) >> 1); return ((kk >> 3) * 4 + (c >> 5)) * 512 + ((kk & 7) * 32 + (c & 31)) * 2; }
__device__ __forceinline__ int v_rd_base(int lane) { return ((lane & 3) << 3) | (((lane >> 2) & 3) << 6) | (((lane >> 4) & 1) << 5) | (((lane >> 5) & 1) << 8); }
constexpr int v_rd_off(int d0, int ks, int half) { return d0 * 512 + ks * 4096 + half * 2048; }
__device__ __forceinline__ int crow(int r, int hi) { return (r & 3) + 8 * (r >> 2) + 4 * hi; }
__device__ __forceinline__ unsigned cvtpk(float lo, float hi) {
    unsigned r; asm volatile("v_cvt_pk_bf16_f32 %0, %1, %2" : "=v"(r) : "v"(lo), "v"(hi)); return r;
}
__device__ __forceinline__ bf16x8 pack8(f32x4 a, f32x4 b) {
    u32x4 w = {cvtpk(a[0], a[1]), cvtpk(a[2], a[3]), cvtpk(b[0], b[1]), cvtpk(b[2], b[3])};
    return *reinterpret_cast<bf16x8*>(&w);
}
template <class T> __device__ __forceinline__ bf16x8 load8(const T* p) {
    if constexpr (same_t<T, float>::v) { return pack8(*(const f32x4*)p, *(const f32x4*)(p + 4)); }
    else { return *reinterpret_cast<const bf16x8*>(p); }
}
__device__ __forceinline__ void mask_tile(f32x16& p0, f32x16& p1, int dq, unsigned W) {
    const float NEG = -__builtin_inff();
#pragma unroll
    for (int r = 0; r < 16; ++r) {
        const int c = (r & 3) + 8 * (r >> 2);
        if ((unsigned)(dq - c) >= W) p0[r] = NEG;
        if ((unsigned)(dq - c - 32) >= W) p1[r] = NEG;
    }
}
__device__ __forceinline__ void partialSM(f32x16& p0, f32x16& p1, float& m_reg, float& mn, float& alpha) {
    float pmax = p0[0]; for (int r = 1; r < 16; ++r) pmax = fmaxf(pmax, p0[r]); for (int r = 0; r < 16; ++r) pmax = fmaxf(pmax, p1[r]);
    { auto rr = __builtin_amdgcn_permlane32_swap(__float_as_uint(pmax), __float_as_uint(pmax), false, false);
      pmax = fmaxf(__uint_as_float(rr[0]), __uint_as_float(rr[1])); }
    constexpr float C2 = 1.4426950408889634f * SCALE;
    if (__builtin_expect(__all((pmax - m_reg) * SCALE <= THR), 1)) { mn = m_reg; alpha = 1.f; }
    else { mn = fmaxf(m_reg, pmax); alpha = __builtin_amdgcn_exp2f((m_reg - mn) * C2); m_reg = mn; }
    const float mnL = -mn * C2;
    for (int r = 0; r < 16; ++r) p0[r] = fmaf(p0[r], C2, mnL); for (int r = 0; r < 16; ++r) p1[r] = fmaf(p1[r], C2, mnL);
    for (int r = 0; r < 16; ++r) p0[r] = __builtin_amdgcn_exp2f(p0[r]);
}
__device__ __forceinline__ void finishSM(f32x16& p0, f32x16& p1, float alpha, float& l_reg, bf16x8& pa0, bf16x8& pa1, bf16x8& pa2, bf16x8& pa3) {
    for (int r = 0; r < 16; ++r) p1[r] = __builtin_amdgcn_exp2f(p1[r]);
    float ps = 0; for (int r = 0; r < 16; ++r) ps += p0[r]; for (int r = 0; r < 16; ++r) ps += p1[r];
    { auto rr = __builtin_amdgcn_permlane32_swap(__float_as_uint(ps), __float_as_uint(ps), false, false);
      ps = __uint_as_float(rr[0]) + __uint_as_float(rr[1]); }
    l_reg = l_reg * alpha + ps;
#define PK4(P, B_, OUT) do { unsigned a0 = cvtpk(P[B_+0], P[B_+1]), a1 = cvtpk(P[B_+2], P[B_+3]);                          \
        unsigned b0 = cvtpk(P[B_+4], P[B_+5]), b1 = cvtpk(P[B_+6], P[B_+7]);                                             \
        auto r0 = __builtin_amdgcn_permlane32_swap(a0, b0, false, false); auto r1 = __builtin_amdgcn_permlane32_swap(a1, b1, false, false); \
        u32x4 w = {r0[0], r1[0], r0[1], r1[1]}; OUT = *reinterpret_cast<bf16x8*>(&w); } while (0)
    PK4(p0, 0, pa0); PK4(p0, 8, pa1); PK4(p1, 0, pa2); PK4(p1, 8, pa3);
#undef PK4
}
template <int KB, bool SK>
__device__ __forceinline__ void qkt(f32x16& p0, f32x16& p1, const char* K_lds, int r32, int hi, const bf16x8* qr, bool act) {
    if (SK && !act) { const float NEG = -__builtin_inff();
#pragma unroll
        for (int r = 0; r < 16; ++r) { p0[r] = NEG; p1[r] = NEG; } return; }
    p0 = f32x16{}; p1 = f32x16{};
    const char* kb[4];
#pragma unroll
    for (int dd = 0; dd < 4; ++dd) kb[dd] = K_lds + KB * SHM_K + KSWZ(r32, (dd * 16 + hi * 8) * 2);
#pragma unroll
    for (int d0 = 0; d0 < 8; ++d0) { const char* a = kb[d0 & 3] + (d0 >> 2) * 128;
        bf16x8 b0 = *reinterpret_cast<const bf16x8*>(a);
        bf16x8 b1 = *reinterpret_cast<const bf16x8*>(a + 32 * 256);
        p0 = __builtin_amdgcn_mfma_f32_32x32x16_bf16(b0, qr[d0], p0, 0, 0, 0);
        p1 = __builtin_amdgcn_mfma_f32_32x32x16_bf16(b1, qr[d0], p1, 0, 0, 0); }
}
template <int VB, bool SK>
__device__ __forceinline__ void pv_tile(f32x16* o, int vb0, bf16x8 pa0, bf16x8 pa1, bf16x8 pa2, bf16x8 pa3, bool act) {
    if (SK && !act) return;
#define TRRD(dst, off) asm volatile("ds_read_b64_tr_b16 %0, %1 offset:%2" : "=&v"(dst) : "v"(vb0), "i"(off) : "memory")
#define PV_D0(d0) do { s16x4 l0, l1, l2, l3, h0, h1, h2, h3; constexpr int b_ = VB * SHM_V + v_rd_off(d0, 0, 0);     \
        TRRD(l0, b_); TRRD(h0, b_ + 2048); TRRD(l1, b_ + 4096); TRRD(h1, b_ + 6144); TRRD(l2, b_ + 8192); TRRD(h2, b_ + 10240); TRRD(l3, b_ + 12288); TRRD(h3, b_ + 14336); \
        asm volatile("s_waitcnt lgkmcnt(0)" ::: "memory"); SBAR();                 \
        o[d0] = __builtin_amdgcn_mfma_f32_32x32x16_bf16(pa0, (bf16x8){l0[0], l0[1], l0[2], l0[3], h0[0], h0[1], h0[2], h0[3]}, o[d0], 0, 0, 0);   \
        o[d0] = __builtin_amdgcn_mfma_f32_32x32x16_bf16(pa1, (bf16x8){l1[0], l1[1], l1[2], l1[3], h1[0], h1[1], h1[2], h1[3]}, o[d0], 0, 0, 0);   \
        o[d0] = __builtin_amdgcn_mfma_f32_32x32x16_bf16(pa2, (bf16x8){l2[0], l2[1], l2[2], l2[3], h2[0], h2[1], h2[2], h2[3]}, o[d0], 0, 0, 0);   \
        o[d0] = __builtin_amdgcn_mfma_f32_32x32x16_bf16(pa3, (bf16x8){l3[0], l3[1], l3[2], l3[3], h3[0], h3[1], h3[2], h3[3]}, o[d0], 0, 0, 0); } while (0)
    PV_D0(0); PV_D0(1); PV_D0(2); PV_D0(3);
#undef PV_D0
#undef TRRD
}

template <class TIn, class TOut> struct BlockRef { const TIn* Q; const TIn* K; const TIn* V; TOut* O; int P0; };
template <class TIn> struct Seam {
    bf16x8 qr[8];
    bf16x8 st_v0, st_v1, st_k0, st_k1; f32x4 sf0, sf1, sf2, sf3;
    f32x4 tq[16];
};
__device__ __forceinline__ int swa_jlo(int P0, int W) { const int lowk = P0 - W + 1; return lowk > 0 ? lowk / KVBLK : 0; }
#define ROW(p, k0, rr) ((p) + (size_t)((k0) + (rr)) * D + sc)
#define VMW() asm volatile("s_waitcnt vmcnt(0)" ::: "memory")
#define VMWN(n) asm volatile("s_waitcnt vmcnt(%0)" :: "i"(n) : "memory")
#define SLOAD_H(Kp, Vp, k0) do { S.st_v0 = load8<TIn>(ROW(Vp, k0, sr)); S.st_v1 = load8<TIn>(ROW(Vp, k0, 32 + sr));              \
                         S.st_k0 = load8<TIn>(ROW(Kp, k0, sr)); S.st_k1 = load8<TIn>(ROW(Kp, k0, 32 + sr)); } while (0)
#define SWRITE_HK(bf) do { *(bf16x8*)(K_lds + (bf) * SHM_K + kws) = S.st_k0; *(bf16x8*)(K_lds + (bf) * SHM_K + kws + 32 * 256) = S.st_k1; } while (0)
#define SWRITE_HV(bf) do { *(bf16x8*)(V_lds + (bf) * SHM_V + vst0) = S.st_v0; *(bf16x8*)(V_lds + (bf) * SHM_V + vst1) = S.st_v1; } while (0)
#define SWRITE_H(bf) do { SWRITE_HV(bf); SWRITE_HK(bf); } while (0)
#define SLOAD_F(p, k0) do { S.sf0 = *(const f32x4*)ROW(p, k0, sr); S.sf1 = *(const f32x4*)(ROW(p, k0, sr) + 4);                \
                            S.sf2 = *(const f32x4*)ROW(p, k0, 32 + sr); S.sf3 = *(const f32x4*)(ROW(p, k0, 32 + sr) + 4); } while (0)
#define SWRITE_KF(bf) do { *(bf16x8*)(K_lds + (bf) * SHM_K + kws) = pack8(S.sf0, S.sf1); *(bf16x8*)(K_lds + (bf) * SHM_K + kws + 32 * 256) = pack8(S.sf2, S.sf3); } while (0)
#define SWRITE_VF(bf) do { *(bf16x8*)(V_lds + (bf) * SHM_V + vst0) = pack8(S.sf0, S.sf1); *(bf16x8*)(V_lds + (bf) * SHM_V + vst1) = pack8(S.sf2, S.sf3); } while (0)
template <class TIn, class TOut>
__device__ __forceinline__ void causal_swa_prime(const BlockRef<TIn, TOut>& cur, int W, char* lds, Seam<TIn>& S) {
    constexpr bool F32 = same_t<TIn, float>::v;
    const int tid = mk_tid(), wid = __builtin_amdgcn_readfirstlane(tid >> 6), lane = tid & 63, r32 = lane & 31, hi = lane >> 5;
    const int sr = tid >> 4, sc = (tid & 15) * 8, kws = KSWZ(sr, sc * 2); char* K_lds = lds + 2 * SHM_V;
    const int kb0 = swa_jlo(cur.P0, W) * KVBLK;
    for (int d0 = 0; d0 < 8; ++d0) S.qr[d0] = load8<TIn>(cur.Q + (size_t)(wid * QBLK + r32) * D + d0 * 16 + hi * 8);
    if constexpr (F32) { SLOAD_F((const float*)cur.K, kb0); VMW(); SWRITE_KF(0); SBAR(); SLOAD_F((const float*)cur.V, kb0); }
    else { SLOAD_H(cur.K, cur.V, kb0); VMW(); SWRITE_HK(0); }
    __syncthreads();
}
template <class TIn, class TOut>
__device__ __forceinline__ void causal_swa_block(const BlockRef<TIn, TOut>& cur, const BlockRef<TIn, TOut>& nxt, int skv, int W, char* lds, Seam<TIn>& S) {
    constexpr bool F32 = same_t<TIn, float>::v;
    const int tid = mk_tid(), wid = __builtin_amdgcn_readfirstlane(tid >> 6), lane = tid & 63, r32 = lane & 31, hi = lane >> 5;
    const int j_lo = swa_jlo(cur.P0, W);
    int j_hi = (cur.P0 + QB - 1) / KVBLK + 1; if (j_hi > skv / KVBLK) j_hi = skv / KVBLK;
    const int NT = j_hi - j_lo;
    const int kbn = swa_jlo(nxt.P0, W) * KVBLK;
    const int qlo = cur.P0 + wid * QBLK, qm = qlo + r32 - 4 * hi;
    char* V_lds = lds; char* K_lds = lds + 2 * SHM_V;
    float* ws = (float*)(lds + 2 * SHM_V + 2 * SHM_K) + wid * 64; float* li_l = ws, * al_l = ws + 32;
    float m_reg = -1e30f, l_reg = 0; f32x16 o[4] = {};
    const int sr = tid >> 4, sc = (tid & 15) * 8, vst0 = v_st(sr, sc), vst1 = v_st(32 + sr, sc), kws = KSWZ(sr, sc * 2);
    const int vb0 = (int)(uintptr_t)V_lds + v_rd_base(lane);
    const TIn* Kh = cur.K; const TIn* Vh = cur.V;
#define RESC(a) do { if (__any((a) < 1.f)) { if (hi == 0) al_l[r32] = (a); asm volatile("s_waitcnt lgkmcnt(0)" ::: "memory");              \
                     for (int d_ = 0; d_ < 4; ++d_) for (int r = 0; r < 16; ++r) o[d_][r] *= al_l[crow(r, hi)]; } } while (0)
#define KBASE(t) ((j_lo + (t)) * KVBLK)
#define ACT(t) (KBASE(t) <= qlo + QBLK - 1 && KBASE(t) + KVBLK - 1 >= qlo - W + 1)
#define MASKT(P0_, P1_, t) do { const int kb_ = KBASE(t); if ((!SK || ACT(t)) && (kb_ + KVBLK - 1 > qlo || kb_ <= qlo + QBLK - 1 - W)) mask_tile(P0_, P1_, qm - kb_, (unsigned)W); } while (0)
    constexpr int NQL = F32 ? 16 : 8;
    constexpr bool SK = WSKIP && !F32;
#define SEAM_K0() do { VMWN(NQL); if constexpr (F32) { SWRITE_KF(0); SBAR(); SLOAD_F((const float*)nxt.V, kbn); } else { SWRITE_HK(0); } SBAR(); } while (0)
    f32x16 pA0, pA1, pB0, pB1; float mnA, mnB, alA, alB; bf16x8 pa0, pa1, pa2, pa3;
    if constexpr (F32) { VMW(); SWRITE_VF(0); SBAR(); } else { SWRITE_HV(0); SBAR(); }
    if (NT > 1) { if constexpr (F32) SLOAD_F((const float*)Kh, KBASE(1)); else SLOAD_H(Kh, Vh, KBASE(1)); }
    SBAR(); qkt<0, SK>(pA0, pA1, K_lds, r32, hi, S.qr, ACT(0));
    if constexpr (F32) { if (NT > 1) { VMW(); SWRITE_KF(1); SBAR(); SLOAD_F((const float*)Vh, KBASE(1)); } }
    MASKT(pA0, pA1, 0); partialSM(pA0, pA1, m_reg, mnA, alA);
    if (NT > 1) { VMW(); if constexpr (F32) { SWRITE_VF(1); SBAR(); if (NT > 2) SLOAD_F((const float*)Kh, KBASE(2)); } else SWRITE_H(1); }
    __syncthreads();
#define HALF_STEP(PX0, PX1, mnX, alX, PY0, PY1, alY, t, KB, VB, SB) do {                                                      \
        SBAR(); qkt<KB, SK>(PX0, PX1, K_lds, r32, hi, S.qr, ACT(t));                                             \
        finishSM(PY0, PY1, alY, l_reg, pa0, pa1, pa2, pa3); SBAR();                                                           \
        if ((t) + 1 < NT) { if constexpr (F32) { VMW(); SWRITE_KF(SB); SBAR(); SLOAD_F((const float*)Vh, KBASE((t) + 1)); }  \
                            else { SLOAD_H(Kh, Vh, KBASE((t) + 1)); } SBAR(); }                                               \
        pv_tile<VB, SK>(o, vb0, pa0, pa1, pa2, pa3, ACT((t) - 1)); MASKT(PX0, PX1, (t)); partialSM(PX0, PX1, m_reg, mnX, alX);                                        \
        __syncthreads();                                                                                                      \
        if ((t) + 1 < NT) { VMW(); if constexpr (F32) { SWRITE_VF(SB); SBAR(); if ((t) + 2 < NT) SLOAD_F((const float*)Kh, KBASE((t) + 2)); } \
                            else { SWRITE_H(SB); } }                                                                          \
        RESC(alX); __syncthreads(); } while (0)
    for (int t = 1; t + 1 < NT; t += 2) {
        HALF_STEP(pB0, pB1, mnB, alB, pA0, pA1, alA, t, 1, 0, 0);
        HALF_STEP(pA0, pA1, mnA, alA, pB0, pB1, alB, t + 1, 0, 1, 1);
    }
    const bool even = (NT & 1) == 0;
    if (even) { SBAR(); qkt<1, SK>(pB0, pB1, K_lds, r32, hi, S.qr, ACT(NT - 1)); SBAR(); }
#define QROW(e) (nxt.Q + (size_t)(wid * QBLK + r32) * D + ((e) >> 1) * 16 + hi * 8 + ((e) & 1) * 4)
    if constexpr (F32) { SLOAD_F((const float*)nxt.K, kbn); SBAR();
#pragma unroll
        for (int e = 0; e < 8; ++e) S.tq[e] = *(const f32x4*)QROW(e); }
    else { SLOAD_H(nxt.K, nxt.V, kbn); SBAR();
#pragma unroll
        for (int d0 = 0; d0 < 8; ++d0) S.qr[d0] = load8<TIn>(nxt.Q + (size_t)(wid * QBLK + r32) * D + d0 * 16 + hi * 8); }
    SBAR();
    finishSM(pA0, pA1, alA, l_reg, pa0, pa1, pa2, pa3); SBAR();
    if constexpr (F32) {
#pragma unroll
        for (int e = 8; e < 16; ++e) S.tq[e] = *(const f32x4*)QROW(e); SBAR(); }
#undef QROW
    pv_tile<0, SK>(o, vb0, pa0, pa1, pa2, pa3, ACT(even ? NT - 2 : NT - 1));
    if (even) { MASKT(pB0, pB1, NT - 1); partialSM(pB0, pB1, m_reg, mnB, alB); __syncthreads(); RESC(alB);
        finishSM(pB0, pB1, alB, l_reg, pa0, pa1, pa2, pa3); SBAR(); pv_tile<1, SK>(o, vb0, pa0, pa1, pa2, pa3, ACT(NT - 1)); }
    SBAR(); SEAM_K0();
    if (hi == 0) li_l[r32] = l_reg; asm volatile("s_waitcnt lgkmcnt(0)" ::: "memory");
    float rli[16];
#pragma unroll
    for (int r = 0; r < 16; ++r) rli[r] = __builtin_amdgcn_rcpf(li_l[crow(r, hi)]);
    TOut* Ow = cur.O + (size_t)(wid * QBLK) * D;
#pragma unroll
    for (int r = 0; r < 16; ++r) { const int orow = crow(r, hi);
#pragma unroll
        for (int d0 = 0; d0 < 4; ++d0) { const float v = o[d0][r] * rli[r];
            if constexpr (same_t<TOut, float>::v) { Ow[(size_t)orow * D + d0 * 32 + r32] = v; }
            else { const float vn = __shfl_xor(v, 1);
                   if ((r32 & 1) == 0) *(unsigned*)(Ow + (size_t)orow * D + d0 * 32 + r32) = cvtpk(v, vn); } } }
    if constexpr (F32) {
#pragma unroll
        for (int d0 = 0; d0 < 8; ++d0) S.qr[d0] = pack8(S.tq[2 * d0], S.tq[2 * d0 + 1]); }
    __syncthreads();
#undef RESC
#undef KBASE
#undef ACT
#undef MASKT
#undef SEAM_K0
#undef HALF_STEP
}
#undef ROW
#undef VMW
#undef VMWN
#undef SLOAD_H
#undef SWRITE_HK
#undef SWRITE_HV
#undef SWRITE_H
#undef SLOAD_F
#undef SWRITE_KF
#undef SWRITE_VF
}

#define GAS __attribute__((address_space(1)))
#define LAS __attribute__((address_space(3)))
typedef unsigned short bf16r;
typedef float f4 __attribute__((ext_vector_type(4)));
typedef unsigned u4 __attribute__((ext_vector_type(4)));
typedef unsigned u2 __attribute__((ext_vector_type(2)));
typedef short s8v __attribute__((ext_vector_type(8)));

constexpr int TOK = 8192, DM = 2048;
constexpr float EPS = 1e-6f;
constexpr size_t MiB = 1u << 20;
constexpr size_t WS_WIN = 0;
constexpr size_t WS_WOUT0 = 32 * MiB, WS_WG0 = 40 * MiB, WS_WPP0 = 48 * MiB;
constexpr size_t WS_ROPE = 49 * MiB;
constexpr size_t WS_IFG = 53 * MiB;
constexpr size_t WS_BCUM = WS_IFG + 256 * 1024;
constexpr size_t WS_NLOC = WS_BCUM + 128 * 1024;
constexpr size_t WS_NPREV = WS_NLOC + 128 * 1024;
constexpr size_t WS_MSC = WS_NPREV + 128 * 1024;
constexpr size_t WS_SSQA = 54 * MiB, WS_SSQB = 55 * MiB, WS_SSQC = 56 * MiB, WS_LNS = 57 * MiB, WS_LNQ = 58 * MiB;
constexpr size_t WS_H = 60 * MiB;
constexpr size_t WS_PB = 92 * MiB;
constexpr size_t WS_G1 = 100 * MiB;
constexpr size_t WS_MLQK = WS_G1, WS_MLV = WS_G1 + 16 * MiB, WS_MLO = WS_G1 + 32 * MiB, WS_MLZ = WS_G1 + 48 * MiB, WS_DAZ = WS_G1 + 64 * MiB,
                 WS_DAQ = WS_G1 + 80 * MiB, WS_DAK = WS_G1 + 96 * MiB, WS_DAV = WS_G1 + 112 * MiB;
constexpr size_t WS_PP0 = 228 * MiB;
constexpr size_t WS_CPREV = WS_DAQ;
constexpr size_t WS_AO = WS_DAK;
constexpr size_t WS_WCIN = 100 * MiB, WS_WCOUT = 124 * MiB, WS_WG1 = 132 * MiB, WS_WPP1 = 140 * MiB;
constexpr size_t WS_X2B = 141 * MiB;
constexpr size_t WS_PP1 = 205 * MiB;
constexpr size_t WS_V = WS_H, WS_MB = 0, WS_X1B = WS_H, WS_X3B = WS_H, WS_DAO = WS_H, WS_CLOC = 0;
constexpr size_t WS_END = 260 * MiB;
constexpr int LDS_BYTES = 147456;
constexpr size_t WS_BAR = 59 * MiB;
constexpr int LDS_BARST = 147440;

struct Args { const void* in[27]; float* out; unsigned char* ws; int ph_lo, ph_hi; };
__device__ __forceinline__ unsigned long long karg64(int off) {
    unsigned long long r;
    asm volatile("s_load_dwordx2 %0, %1, %2\n\ts_waitcnt lgkmcnt(0)" : "=s"(r) : "s"(__builtin_amdgcn_kernarg_segment_ptr()), "n"(off) : "memory");
    return r;
}
#define KIN(a_, k) (a_).in[k] = (const void*)(GAS const void*)karg64(8 * (k))
#define KOUT(a_) (a_).out = (float*)(GAS float*)karg64(216)
#define KWS(a_) (a_).ws = (unsigned char*)(GAS unsigned char*)karg64(224)

__device__ __forceinline__ unsigned pk2(float lo, float hi) { return pg8::cvt_pk_bf16(lo, hi); }
__device__ __forceinline__ float bflo(unsigned w) { return __uint_as_float(w << 16); }
__device__ __forceinline__ float bfhi(unsigned w) { return __uint_as_float(w & 0xffff0000u); }
__device__ __forceinline__ float wave_sum(float v) {
#pragma unroll
    for (int o = 1; o < 64; o <<= 1) v += __shfl_xor(v, o);
    return v;
}
__device__ __forceinline__ float sigm(float x) { return __builtin_amdgcn_rcpf(1.f + __expf(-x)); }
__device__ __forceinline__ float silu(float x) { return x * __builtin_amdgcn_rcpf(1.f + __expf(-x)); }
#define LDS_WAIT() asm volatile("s_waitcnt lgkmcnt(0)" ::: "memory")

__device__ __forceinline__ int ropeperm(int r) { const int blk = r & ~127, p = r & 127; return blk + 64 * ((p >> 2) & 1) + 16 * (p >> 5) + 4 * ((p >> 3) & 3) + (p & 3); }
__device__ __forceinline__ int win_src_col(int nd) {
    const int seg = nd >> 10, r = nd & 1023;
    if (seg < 2) return nd;
    if (seg == 2) return 2056 + r;
    if (seg == 3) return 3080 + r;
    if (seg == 4) return 4104 + ropeperm(r);
    if (seg == 5) return 5128 + ropeperm(r);
    if (seg == 6) return 6152 + r;
    return 7176 + r;
}
template <bool WINMAP>
__device__ __forceinline__ void transpose_item(const float* W, int K, int Nsrc, int Ndst, const float* gs, bf16r* WT, LAS unsigned* scr, int item, int lane) {
    const int nblk = Ndst >> 6, kb = item / nblk, nb = item - kb * nblk, k0 = kb * 64, n0 = nb * 64;
    const int nd = n0 + lane; const int src = WINMAP ? win_src_col(nd) : nd;
    const float* wp = W + (size_t)k0 * Nsrc + src;
    float v[64];
#pragma unroll
    for (int i = 0; i < 64; ++i) v[i] = __builtin_nontemporal_load(wp + (size_t)i * Nsrc);
    if (gs) {
#pragma unroll
        for (int i = 0; i < 64; ++i) v[i] *= gs[k0 + i];
    }
#pragma unroll
    for (int c = 0; c < 8; ++c) { u4 o; o.x = pk2(v[8 * c], v[8 * c + 1]); o.y = pk2(v[8 * c + 2], v[8 * c + 3]); o.z = pk2(v[8 * c + 4], v[8 * c + 5]); o.w = pk2(v[8 * c + 6], v[8 * c + 7]); *(LAS u4*)(scr + lane * 36 + 4 * c) = o; }
    LDS_WAIT();
    bf16r* op = WT + (size_t)(n0 + (lane >> 3)) * K + k0 + 8 * (lane & 7);
#pragma unroll
    for (int j = 0; j < 8; ++j) *(u4*)(op + (size_t)(8 * j) * K) = *(const LAS u4*)(scr + ((lane >> 3) + 8 * j) * 36 + 4 * (lane & 7));
    LDS_WAIT();
}

template <int PARTS = 7>
__device__ __forceinline__ void phase0(const Args& a, LAS unsigned char* lds, int tid, int lane, int wave, int G) {
    const float* x = (const float*)a.in[0]; const float* Win = (const float*)a.in[4]; const float* gn = (const float*)a.in[3];
    unsigned char* ws = a.ws;
    LAS float* wif = (LAS float*)lds;
    if (PARTS & 1) for (int k = tid; k < 2048; k += 512) { const f4 w0 = *(const f4*)(Win + (size_t)k * 8200 + 2048), w1 = *(const f4*)(Win + (size_t)k * 8200 + 2052); const float g = gn[k];
        wif[k] = w0.x * g; wif[2048 + k] = w0.y * g; wif[4096 + k] = w0.z * g; wif[6144 + k] = w0.w * g; wif[8192 + k] = w1.x * g; wif[10240 + k] = w1.y * g; wif[12288 + k] = w1.z * g; wif[14336 + k] = w1.w * g; }
    __syncthreads();
    const int gw = blockIdx.x * 8 + wave, NGW = G * 8;
    bf16r* H = (bf16r*)(ws + WS_H); float* IFG = (float*)(ws + WS_IFG);
    const float* ib = (const float*)a.in[7]; const float* fb = (const float*)a.in[8];
    f4 vnx[8];
    if (PARTS & 1) { const f4* xr0 = (const f4*)(x + (size_t)(gw < TOK ? gw : 0) * DM) + lane;
#pragma unroll
        for (int j = 0; j < 8; ++j) vnx[j] = __builtin_nontemporal_load(xr0 + 64 * j); }
    if (PARTS & 1) for (int m = gw; m < TOK; m += NGW) {
        f4 v[8]; float s = 0.f;
#pragma unroll
        for (int j = 0; j < 8; ++j) { v[j] = vnx[j]; s += (v[j].x * v[j].x + v[j].y * v[j].y) + (v[j].z * v[j].z + v[j].w * v[j].w); }
        { const int mn = m + NGW < TOK ? m + NGW : m; const f4* xr = (const f4*)(x + (size_t)mn * DM) + lane;
#pragma unroll
          for (int j = 0; j < 8; ++j) vnx[j] = __builtin_nontemporal_load(xr + 64 * j); }
        const float rstd = rsqrtf(wave_sum(s) * (1.f / DM) + EPS);
        u2* hp = (u2*)(H + (size_t)m * DM) + lane;
        float acc[8];
#pragma unroll
        for (int c = 0; c < 8; ++c) acc[c] = 0.f;
#pragma unroll
        for (int j = 0; j < 8; ++j) { const f4 g = *((const f4*)gn + lane + 64 * j); const f4 hv = v[j] * rstd * g; hp[64 * j] = (u2){pk2(hv.x, hv.y), pk2(hv.z, hv.w)};
#pragma unroll
            for (int c = 0; c < 8; ++c) { const f4 w = *(const LAS f4*)(wif + c * 2048 + 4 * lane + 256 * j); acc[c] += (v[j].x * w.x + v[j].y * w.y) + (v[j].z * w.z + v[j].w * w.w); } }
#pragma unroll
        for (int c = 0; c < 8; ++c) acc[c] = wave_sum(acc[c]) * rstd;
        float val = acc[0];
#pragma unroll
        for (int c = 1; c < 8; ++c) if (lane == c) val = acc[c];
        if (lane < 4) IFG[(size_t)m * 8 + lane] = val + ib[lane];
        else if (lane < 8) { const float xf = val + fb[lane - 4]; IFG[(size_t)m * 8 + lane] = fminf(xf, 0.f) - log1pf(expf(-fabsf(xf))); }
    }
    LAS unsigned* scr = (LAS unsigned*)(lds + 65536 + wave * 9216);
    constexpr int I_WIN = 32 * 128, I_SQ = 32 * 32, I_PP = 4 * 32, I_G0A = I_SQ - 128;
    if (PARTS & 2) for (int it = gw; it < I_WIN + I_SQ + I_G0A + I_PP; it += NGW) {
        int r = it;
        if (r < I_WIN) { transpose_item<true>(Win, 2048, 8200, 8192, nullptr, (bf16r*)(ws + WS_WIN), scr, r, lane); continue; } r -= I_WIN;
        if (r < I_SQ) { transpose_item<false>((const float*)a.in[15], 2048, 2048, 2048, nullptr, (bf16r*)(ws + WS_WOUT0), scr, r, lane); continue; } r -= I_SQ;
        if (r < I_G0A) { transpose_item<false>((const float*)a.in[24], 2048, 2048, 2048, (const float*)a.in[23], (bf16r*)(ws + WS_WG0), scr, r, lane); continue; } r -= I_G0A;
        transpose_item<false>((const float*)a.in[25], 256, 2048, 2048, nullptr, (bf16r*)(ws + WS_WPP0), scr, r, lane);
    }
    constexpr int NITEMS0 = 32 * 128 + 2 * 32 * 32 + 4 * 32 - 128;
    const int NX = NITEMS0 % NGW;
    if ((PARTS & 4) && gw >= NX) { const int gt = (gw - NX) * 64 + lane, NT = (NGW - NX) * 64;
        const f4* p4 = (const f4*)a.in[1]; u2* pb = (u2*)(ws + WS_PB);
        for (int e0 = gt; e0 < 2 * TOK * 256 / 4; e0 += 4 * NT) { f4 v[4];
#pragma unroll
            for (int k = 0; k < 4; ++k) { const int e = e0 + k * NT; v[k] = __builtin_nontemporal_load(p4 + (e < 2 * TOK * 256 / 4 ? e : e0)); }
#pragma unroll
            for (int k = 0; k < 4; ++k) { const int e = e0 + k * NT; if (e < 2 * TOK * 256 / 4) pb[e] = (u2){pk2(v[k].x, v[k].y), pk2(v[k].z, v[k].w)}; } }
        const int* pos = (const int*)a.in[2]; float2* rt = (float2*)(ws + WS_ROPE);
        for (int e = gt; e < TOK * 64; e += NT) { const int tok = e >> 6, j = e & 63; const float freq = exp2f(-(float)j * (13.287712379549449f / 64.f));
            const float ang = (float)pos[tok] * freq; float sn, cs; sincosf(ang, &sn, &cs); rt[e] = make_float2(cs, sn); } }
}

__device__ __forceinline__ void l1_weights(const Args& a, LAS unsigned char* lds, int lane, int wave, int G) {
    unsigned char* ws = a.ws; const int gw = blockIdx.x * 8 + wave, NGW = G * 8;
    LAS unsigned* scr = (LAS unsigned*)(lds + wave * 9216);
    constexpr int I_CIN = 32 * 96, I_SQ = 32 * 32, I_PP = 4 * 32;
    for (int it = gw; it < I_CIN + 2 * I_SQ + I_PP + 128; it += NGW) {
        int r = it;
        if (r < 128) { transpose_item<false>((const float*)a.in[24], 2048, 2048, 2048, (const float*)a.in[23], (bf16r*)(ws + WS_WG0), scr, I_SQ - 128 + r, lane); continue; } r -= 128;
        if (r < I_CIN) { transpose_item<false>((const float*)a.in[17], 2048, 6144, 6144, (const float*)a.in[16], (bf16r*)(ws + WS_WCIN), scr, r, lane); continue; } r -= I_CIN;
        if (r < I_SQ) { transpose_item<false>((const float*)a.in[22], 2048, 2048, 2048, nullptr, (bf16r*)(ws + WS_WCOUT), scr, r, lane); continue; } r -= I_SQ;
        if (r < I_SQ) { transpose_item<false>((const float*)a.in[24] + (size_t)2048 * 2048, 2048, 2048, 2048, (const float*)a.in[23] + 2048, (bf16r*)(ws + WS_WG1), scr, r, lane); continue; } r -= I_SQ;
        transpose_item<false>((const float*)a.in[25] + (size_t)256 * 2048, 256, 2048, 2048, nullptr, (bf16r*)(ws + WS_WPP1), scr, r, lane);
    }
}

#define XB_TMO      128
#define XB_XCNT(j)  (256  + 64 * (j))
#define XB_XSUB(j)  (1280 + 64 * (j))
#define XB_XGEN(j)  (2304 + 64 * (j))
#define XB_TOP      3328
#define XB_TOPGEN   3392
#define XCD_BAR_WORDS 3456
#define XB_SPIN_CAP (1u << 18)

__device__ __forceinline__ unsigned xb_ld(unsigned* p)              { return __hip_atomic_load(p, __ATOMIC_RELAXED, __HIP_MEMORY_SCOPE_AGENT); }
__device__ __forceinline__ unsigned xb_add(unsigned* p, unsigned v) { return __hip_atomic_fetch_add(p, v, __ATOMIC_RELAXED, __HIP_MEMORY_SCOPE_AGENT); }
__device__ __forceinline__ unsigned xb_xcc_id() { return (unsigned)__builtin_amdgcn_s_getreg((3 << 11) | 20) & 0xFu; }
#define XB_SPIN(cond, bar) do { unsigned _sp = 0; while (cond) { __builtin_amdgcn_s_sleep(1); \
    if ((++_sp & 255u) == 0u) { if (xb_ld(&(bar)[XB_TMO])) break; if (_sp > XB_SPIN_CAP) { atomicAdd(&(bar)[XB_TMO], 1u); break; } } } } while (0)

struct XcdBarrier {
    unsigned* bar; unsigned x;
    volatile LAS unsigned* st;
};

__device__ __forceinline__ XcdBarrier xcd_barrier_post(unsigned* bar, volatile LAS unsigned* st) {
    XcdBarrier b; b.bar = bar; b.x = xb_xcc_id(); b.st = st;
    if (threadIdx.x == 0) (void)xb_add(&bar[XB_XCNT(b.x)], 1u);
    return b;
}
__device__ __forceinline__ void xcd_barrier_complete(unsigned* bar, unsigned x, unsigned& nloc, unsigned& nx) {
    const unsigned G = gridDim.x * gridDim.y * gridDim.z;
    unsigned sum, cnt, mine, sp = 0u;
    for (;;) {
        sum = 0u; cnt = 0u; mine = 0u;
#pragma unroll
        for (unsigned j = 0; j < 16; ++j) { const unsigned c = xb_ld(&bar[XB_XCNT(j)]); sum += c; cnt += (c > 0u) ? 1u : 0u; mine = (j == x) ? c : mine; }
        if (sum == G) break;
        __builtin_amdgcn_s_sleep(1);
        if ((++sp & 255u) == 0u) { if (xb_ld(&bar[XB_TMO])) break; if (sp > XB_SPIN_CAP) { atomicAdd(&bar[XB_TMO], 1u); break; } }
    }
    nloc = mine > 0u ? mine : 1u; nx = cnt > 0u ? cnt : 1u;
}

__device__ __forceinline__ void xcd_barrier(const XcdBarrier& b) {
    asm volatile("s_waitcnt vmcnt(0)" ::: "memory");
    __syncthreads();
    if (threadIdx.x == 0) {
        unsigned* bar = b.bar;
        __builtin_amdgcn_s_waitcnt(0);
        unsigned nloc = b.st[0], nx = b.st[1];
        if (nloc == 0u) { xcd_barrier_complete(bar, b.x, nloc, nx); b.st[0] = nloc; b.st[1] = nx; }
        const unsigned old = xb_add(&bar[XB_XSUB(b.x)], 1u);
        const unsigned gen = old / nloc;
        if (old + 1u == (gen + 1u) * nloc) {
            __builtin_amdgcn_fence(__ATOMIC_RELEASE, "agent");
            asm volatile("s_waitcnt vmcnt(0)" ::: "memory");
            const unsigned og = xb_add(&bar[XB_TOP], 1u);
            const unsigned tg = og / nx;
            if (og + 1u == (tg + 1u) * nx) xb_add(&bar[XB_TOPGEN], 1u);
            else XB_SPIN(xb_ld(&bar[XB_TOPGEN]) == tg, bar);
            __builtin_amdgcn_fence(__ATOMIC_ACQUIRE, "agent");
            xb_add(&bar[XB_XGEN(b.x)], 1u);
            asm volatile("s_waitcnt vmcnt(0)" ::: "memory");
        } else {
            XB_SPIN(xb_ld(&bar[XB_XGEN(b.x)]) == gen, bar);
            __builtin_amdgcn_fence(__ATOMIC_ACQUIRE, "agent");
            asm volatile("s_waitcnt vmcnt(0)" ::: "memory");
        }
    }
    __syncthreads();
}


using pg8::Unit;
typedef pg8::f32x4 accv;

__device__ __forceinline__ u4 pack8(const accv& a, const accv& b) { u4 w; w.x = pk2(a[0], a[1]); w.y = pk2(a[2], a[3]); w.z = pk2(b[0], b[1]); w.w = pk2(b[2], b[3]); return w; }
__device__ __forceinline__ float row_rstd(const float* ssq, int r, int fq) {
    const f4 p0 = *(const f4*)(ssq + (size_t)r * 32 + 8 * fq), p1 = *(const f4*)(ssq + (size_t)r * 32 + 8 * fq + 4);
    float s = ((p0.x + p0.y) + (p0.z + p0.w)) + ((p1.x + p1.y) + (p1.z + p1.w));
    s += __shfl_xor(s, 16); s += __shfl_xor(s, 32);
    return rsqrtf(s * (1.f / DM) + EPS);
}

__device__ __forceinline__ float row_rstd_sc1(const float* ssq, int r, int fq) {
    GAS unsigned long long* p = (GAS unsigned long long*)(ssq + (size_t)r * 32 + 8 * fq); float s = 0.f;
#pragma unroll
    for (int i = 0; i < 4; ++i) { const unsigned long long w = __hip_atomic_load(p + i, __ATOMIC_RELAXED, __HIP_MEMORY_SCOPE_AGENT); s += __uint_as_float((unsigned)w) + __uint_as_float((unsigned)(w >> 32)); }
    s += __shfl_xor(s, 16); s += __shfl_xor(s, 32);
    return rsqrtf(s * (1.f / DM) + EPS);
}

__device__ __forceinline__ void unpack8(const u4& w, accv& a, accv& b) { a[0] = bflo(w.x); a[1] = bfhi(w.x); a[2] = bflo(w.y); a[3] = bfhi(w.y); b[0] = bflo(w.z); b[1] = bfhi(w.z); b[2] = bflo(w.w); b[3] = bfhi(w.w); }

struct RsPart { f4 p0, p1; };
__device__ __forceinline__ RsPart rs_load(const float* ssq, int r, int fq) { RsPart p; p.p0 = *(const f4*)(ssq + (size_t)r * 32 + 8 * fq); p.p1 = *(const f4*)(ssq + (size_t)r * 32 + 8 * fq + 4); return p; }
__device__ __forceinline__ float rs_fin(const RsPart& p) {
    float s = ((p.p0.x + p.p0.y) + (p.p0.z + p.p0.w)) + ((p.p1.x + p.p1.y) + (p.p1.z + p.p1.w));
    s += __shfl_xor(s, 16); s += __shfl_xor(s, 32);
    return rsqrtf(s * (1.f / DM) + EPS);
}

struct EpiG1 {
    static constexpr bool PERM = true, AFTER_DRAIN = false;
    unsigned char* ws;
    __device__ __forceinline__ void operator()(const accv (&acc)[2][2][4][2], const Unit& u, int wr, int wc, int fr, int fq) const {
        const int seg = u.pn >> 2, q4 = u.pn & 3;
        const int row0 = u.pm * 256 + wr * 64 + fr, cl = wc * 32 + 8 * fq;
        if (seg < 4 || seg == 7) {
            const int reg = seg == 7 ? 4 : seg;
            bf16r* base = (bf16r*)(ws + WS_G1 + (size_t)reg * 16 * MiB);
#pragma unroll
            for (int ai = 0; ai < 2; ++ai)
#pragma unroll
                for (int m = 0; m < 4; ++m) { bf16r* rowp = base + (size_t)(row0 + ai * 128 + m * 16) * 1024 + q4 * 256 + cl;
#pragma unroll
                    for (int bj = 0; bj < 2; ++bj) *(u4*)(rowp + bj * 128) = pack8(acc[ai][bj][m][0], acc[ai][bj][m][1]); }
        } else if (seg == 6) {
            bf16r* base = (bf16r*)(ws + WS_DAV);
#pragma unroll
            for (int ai = 0; ai < 2; ++ai)
#pragma unroll
                for (int m = 0; m < 4; ++m) { const int r = row0 + ai * 128 + m * 16, b = r >> 11, s = r & 2047;
#pragma unroll
                    for (int bj = 0; bj < 2; ++bj) *(u4*)(base + ((size_t)((b * 4 + q4) * 2 + bj) * 2048 + s) * 128 + cl) = pack8(acc[ai][bj][m][0], acc[ai][bj][m][1]); }
        } else {
            bf16r* base = (bf16r*)(ws + (seg == 4 ? WS_DAQ : WS_DAK));
            const float* rope = (const float*)(ws + WS_ROPE);
            const int j0 = 16 * wc + 4 * fq;
#pragma unroll
            for (int ai = 0; ai < 2; ++ai)
#pragma unroll
                for (int m = 0; m < 4; ++m) { const int r = row0 + ai * 128 + m * 16, b = r >> 11, s = r & 2047;
                    const f4 t0 = *(const f4*)(rope + ((size_t)r * 64 + j0) * 2), t1 = *(const f4*)(rope + ((size_t)r * 64 + j0) * 2 + 4);
                    const accv cs = {t0.x, t0.z, t1.x, t1.z}, sn = {t0.y, t0.w, t1.y, t1.w};
#pragma unroll
                    for (int bj = 0; bj < 2; ++bj) { const accv x1 = acc[ai][bj][m][0], x2 = acc[ai][bj][m][1];
                        const accv o1 = x1 * cs - x2 * sn, o2 = x1 * sn + x2 * cs;
                        *(u4*)(base + ((size_t)((b * 4 + q4) * 2 + bj) * 2048 + s) * 128 + cl) = pack8(o1, o2); } }
        }
    }
};

template <bool XBF>
struct EpiRes {
    static constexpr bool PERM = true, AFTER_DRAIN = false;
    const void* xin; bf16r* xb; float* ssq;
    __device__ __forceinline__ void operator()(const accv (&acc)[2][2][4][2], const Unit& u, int wr, int wc, int fr, int fq) const {
        const int row0 = u.pm * 256 + wr * 64 + fr, col0 = u.pn * 256 + wc * 32 + 8 * fq;
#pragma unroll
        for (int ah = 0; ah < 4; ++ah) { const int ai = ah >> 1, m0 = (ah & 1) * 2;
            accv xa[4][2], xc[4][2];
#pragma unroll
            for (int m = m0; m < m0 + 2; ++m)
#pragma unroll
                for (int bj = 0; bj < 2; ++bj) { const size_t o = (size_t)(row0 + ai * 128 + m * 16) * DM + col0 + bj * 128;
                    if constexpr (XBF) { unpack8(*(const u4*)((const bf16r*)xin + o), xa[m][bj], xc[m][bj]); } else { xa[m][bj] = __builtin_nontemporal_load((const accv*)((const float*)xin + o)); xc[m][bj] = __builtin_nontemporal_load((const accv*)((const float*)xin + o + 4)); } }
#pragma unroll
            for (int m = m0; m < m0 + 2; ++m) { const int r = row0 + ai * 128 + m * 16; float q = 0.f;
#pragma unroll
                for (int bj = 0; bj < 2; ++bj) { const size_t o = (size_t)r * DM + col0 + bj * 128;
                    const accv v0 = acc[ai][bj][m][0] + xa[m][bj], v1 = acc[ai][bj][m][1] + xc[m][bj];
                    *(u4*)(xb + o) = pack8(v0, v1);
                    q += ((v0[0] * v0[0] + v0[1] * v0[1]) + (v0[2] * v0[2] + v0[3] * v0[3])) + ((v1[0] * v1[0] + v1[1] * v1[1]) + (v1[2] * v1[2] + v1[3] * v1[3])); }
                q += __shfl_xor(q, 16); q += __shfl_xor(q, 32);
                if (fq == 0) ssq[(size_t)r * 32 + u.pn * 4 + wc] = q; } }
    }
};

struct EpiGate {
    static constexpr bool PERM = true, AFTER_DRAIN = false;
    const bf16r* xin; bf16r* xb; const bf16r* pp; const float* ssq_in; float* ssq_out;
    __device__ __forceinline__ void operator()(const accv (&acc)[2][2][4][2], const Unit& u, int wr, int wc, int fr, int fq) const {
        const int row0 = u.pm * 256 + wr * 64 + fr, col0 = u.pn * 256 + wc * 32 + 8 * fq;
#pragma unroll
        for (int ah = 0; ah < 4; ++ah) { const int ai = ah >> 1, m0 = (ah & 1) * 2;
            u4 xw[4][2], pw[4][2]; RsPart rp[4];
#pragma unroll
            for (int m = m0; m < m0 + 2; ++m) { const int r = row0 + ai * 128 + m * 16; rp[m] = rs_load(ssq_in, r, fq);
#pragma unroll
                for (int bj = 0; bj < 2; ++bj) { const size_t o = (size_t)r * DM + col0 + bj * 128; xw[m][bj] = *(const u4*)(xin + o); pw[m][bj] = *(const u4*)(pp + o); } }
#pragma unroll
            for (int m = m0; m < m0 + 2; ++m) { const int r = row0 + ai * 128 + m * 16; const float rstd = rs_fin(rp[m]); float q = 0.f;
#pragma unroll
                for (int bj = 0; bj < 2; ++bj) { const size_t o = (size_t)r * DM + col0 + bj * 128;
                    accv xa, xc, pa, pc; unpack8(xw[m][bj], xa, xc); unpack8(pw[m][bj], pa, pc);
                    const accv a0 = acc[ai][bj][m][0] * rstd, a1 = acc[ai][bj][m][1] * rstd;
                    accv v0, v1;
#pragma unroll
                    for (int i = 0; i < 4; ++i) { v0[i] = xa[i] + sigm(a0[i]) * pa[i]; v1[i] = xc[i] + sigm(a1[i]) * pc[i]; }
                    *(u4*)(xb + o) = pack8(v0, v1);
                    q += ((v0[0] * v0[0] + v0[1] * v0[1]) + (v0[2] * v0[2] + v0[3] * v0[3])) + ((v1[0] * v1[0] + v1[1] * v1[1]) + (v1[2] * v1[2] + v1[3] * v1[3])); }
                q += __shfl_xor(q, 16); q += __shfl_xor(q, 32); if (fq == 0) ssq_out[(size_t)r * 32 + u.pn * 4 + wc] = q; } }
    }
};

struct EpiUVZ {
    static constexpr bool PERM = true, AFTER_DRAIN = false;
    bf16r* U; bf16r* V; const float* ssq_in; float* lns; float* lnq;
    __device__ __forceinline__ void operator()(const accv (&acc)[2][2][4][2], const Unit& u, int wr, int wc, int fr, int fq) const {
        const int seg = u.pn >> 3, pnl = u.pn & 7;
        bf16r* base = (seg == 1) ? V : U + (size_t)(seg >> 1) * TOK * DM;
        const int row0 = u.pm * 256 + wr * 64 + fr, col0 = pnl * 256 + wc * 32 + 8 * fq;

#pragma unroll
        for (int ai = 0; ai < 2; ++ai) { RsPart rp[4];
#pragma unroll
            for (int m = 0; m < 4; ++m) rp[m] = rs_load(ssq_in, row0 + ai * 128 + m * 16, fq);
#pragma unroll
            for (int m = 0; m < 4; ++m) { const int r = row0 + ai * 128 + m * 16; const float rstd = rs_fin(rp[m]); float s1 = 0.f, s2 = 0.f;
#pragma unroll
                for (int bj = 0; bj < 2; ++bj) { const size_t o = (size_t)r * DM + col0 + bj * 128;
                    const accv v0 = acc[ai][bj][m][0] * rstd, v1 = acc[ai][bj][m][1] * rstd;
                    *(u4*)(base + o) = pack8(v0, v1);
                    s1 += ((v0[0] + v0[1]) + (v0[2] + v0[3])) + ((v1[0] + v1[1]) + (v1[2] + v1[3]));
                    s2 += ((v0[0] * v0[0] + v0[1] * v0[1]) + (v0[2] * v0[2] + v0[3] * v0[3])) + ((v1[0] * v1[0] + v1[1] * v1[1]) + (v1[2] * v1[2] + v1[3] * v1[3])); }
                if (seg == 1) { s1 += __shfl_xor(s1, 16); s1 += __shfl_xor(s1, 32); s2 += __shfl_xor(s2, 16); s2 += __shfl_xor(s2, 32);
                    if (fq == 0) { lns[(size_t)r * 32 + pnl * 4 + wc] = s1; lnq[(size_t)r * 32 + pnl * 4 + wc] = s2; } } } }
    }
};

struct EpiGateFinal {
    static constexpr bool PERM = true, AFTER_DRAIN = false;
    const bf16r* xin; float* out; const bf16r* pp; const float* ssq_in; float* ssq_x; unsigned* cnt; const float* gfin;
    __device__ __forceinline__ void operator()(accv (&acc)[2][2][4][2], const Unit& u, int wr, int wc, int fr, int fq) const {
        const int row0 = u.pm * 256 + wr * 64 + fr, col0 = u.pn * 256 + wc * 32 + 8 * fq;
#pragma unroll
        for (int ah = 0; ah < 4; ++ah) { const int ai = ah >> 1, m0 = (ah & 1) * 2;
            u4 xw[4][2], pw[4][2]; RsPart rp[4];
#pragma unroll
            for (int m = m0; m < m0 + 2; ++m) { const int r = row0 + ai * 128 + m * 16; rp[m] = rs_load(ssq_in, r, fq);
#pragma unroll
                for (int bj = 0; bj < 2; ++bj) { const size_t o = (size_t)r * DM + col0 + bj * 128; xw[m][bj] = *(const u4*)(xin + o); pw[m][bj] = *(const u4*)(pp + o); } }
#pragma unroll
            for (int m = m0; m < m0 + 2; ++m) { const int r = row0 + ai * 128 + m * 16; const float rstd = rs_fin(rp[m]); float q = 0.f;
#pragma unroll
                for (int bj = 0; bj < 2; ++bj) {
                    accv xa, xc, pa, pc; unpack8(xw[m][bj], xa, xc); unpack8(pw[m][bj], pa, pc);
                    const accv a0 = acc[ai][bj][m][0] * rstd, a1 = acc[ai][bj][m][1] * rstd;
                    accv v0, v1;
#pragma unroll
                    for (int i = 0; i < 4; ++i) { v0[i] = xa[i] + sigm(a0[i]) * pa[i]; v1[i] = xc[i] + sigm(a1[i]) * pc[i]; }
                    acc[ai][bj][m][0] = v0; acc[ai][bj][m][1] = v1;
                    q += ((v0[0] * v0[0] + v0[1] * v0[1]) + (v0[2] * v0[2] + v0[3] * v0[3])) + ((v1[0] * v1[0] + v1[1] * v1[1]) + (v1[2] * v1[2] + v1[3] * v1[3])); }
                q += __shfl_xor(q, 16); q += __shfl_xor(q, 32); if (fq == 0) __hip_atomic_store((GAS unsigned*)(ssq_x + (size_t)r * 32 + u.pn * 4 + wc), __float_as_uint(q), __ATOMIC_RELAXED, __HIP_MEMORY_SCOPE_AGENT); } }
        asm volatile("s_waitcnt vmcnt(0)" ::: "memory");
        __builtin_amdgcn_s_barrier();
        if ((wr | wc) == 0) { GAS unsigned* c = (GAS unsigned*)(cnt + u.pm * 64);
            if ((fr | fq) == 0) (void)__hip_atomic_fetch_add(c, 1u, __ATOMIC_RELAXED, __HIP_MEMORY_SCOPE_AGENT);
            unsigned spins = 0; while ((unsigned)__builtin_amdgcn_readfirstlane((int)__hip_atomic_load(c, __ATOMIC_RELAXED, __HIP_MEMORY_SCOPE_AGENT)) < 8u) { __builtin_amdgcn_s_sleep(1); if (++spins > (1u << 22)) break; }
            __builtin_amdgcn_fence(__ATOMIC_ACQUIRE, "agent"); asm volatile("s_waitcnt vmcnt(0)" ::: "memory"); }
        __builtin_amdgcn_s_barrier();
        accv g[2][2];
#pragma unroll
        for (int bj = 0; bj < 2; ++bj) { g[bj][0] = *(const accv*)(gfin + col0 + bj * 128); g[bj][1] = *(const accv*)(gfin + col0 + bj * 128 + 4); }
#pragma unroll
        for (int ai = 0; ai < 2; ++ai)
#pragma unroll
            for (int m = 0; m < 4; ++m) { const int r = row0 + ai * 128 + m * 16; const float rstd = row_rstd_sc1(ssq_x, r, fq);
#pragma unroll
                for (int bj = 0; bj < 2; ++bj) { const size_t o = (size_t)r * DM + col0 + bj * 128;
                    __builtin_nontemporal_store(acc[ai][bj][m][0] * rstd * g[bj][0], (accv*)(out + o)); __builtin_nontemporal_store(acc[ai][bj][m][1] * rstd * g[bj][1], (accv*)(out + o + 4)); } }
    }
};

#define MFMA16(a, b, c) __builtin_amdgcn_mfma_f32_16x16x32_bf16((a), (b), (c), 0, 0, 0)
constexpr int LP = 136;

struct ConvW { f4 w[4][2]; f4 b[2]; };
__device__ __forceinline__ void conv_w_load(const float* cw, const float* cb, int col, ConvW& W) {
    W.b[0] = *(const f4*)(cb + col); W.b[1] = *(const f4*)(cb + col + 4);
#pragma unroll
    for (int j = 0; j < 4; ++j) { W.w[j][0] = *(const f4*)(cw + j * 1024 + col); W.w[j][1] = *(const f4*)(cw + j * 1024 + col + 4); }
}
__device__ __forceinline__ void conv8_ld(const bf16r* mlqk, int t0, int cpos, int l, int col, u4 (&xv)[4]) {
#pragma unroll
    for (int j = 0; j < 4; ++j) { const int tt = l - 3 + j; const bool ok = cpos + tt >= 0;
        xv[j] = *(const u4*)(mlqk + (size_t)(t0 + (ok ? tt : 0)) * 1024 + col); if (!ok) xv[j] = (u4){0u, 0u, 0u, 0u}; }
}
__device__ __forceinline__ void conv8_fin(const ConvW& W, const u4 (&xv)[4], float scale, float (&o)[8]) {
    o[0] = W.b[0].x; o[1] = W.b[0].y; o[2] = W.b[0].z; o[3] = W.b[0].w; o[4] = W.b[1].x; o[5] = W.b[1].y; o[6] = W.b[1].z; o[7] = W.b[1].w;
#pragma unroll
    for (int j = 0; j < 4; ++j) { const f4 w0 = W.w[j][0], w1 = W.w[j][1];
        o[0] += w0.x * bflo(xv[j].x); o[1] += w0.y * bfhi(xv[j].x); o[2] += w0.z * bflo(xv[j].y); o[3] += w0.w * bfhi(xv[j].y);
        o[4] += w1.x * bflo(xv[j].z); o[5] += w1.y * bfhi(xv[j].z); o[6] += w1.z * bflo(xv[j].w); o[7] += w1.w * bfhi(xv[j].w); }
#pragma unroll
    for (int i = 0; i < 8; ++i) o[i] = silu(o[i]) * scale;
}
constexpr float KSCALE = 0.08838834764831845f;
constexpr int LPV = 264;
typedef short s4v __attribute__((ext_vector_type(4)));
__device__ __forceinline__ s8v tr_frag(const LAS bf16r* base, int pitch, int fr, int fq) {
    const LAS bf16r* p = base + (8 * fq + (fr >> 2)) * pitch + 4 * (fr & 3);
    const s4v lo = __builtin_amdgcn_ds_read_tr16_b64_v4i16((LAS s4v*)p), hi = __builtin_amdgcn_ds_read_tr16_b64_v4i16((LAS s4v*)(p + 4 * pitch));
    return (s8v){lo[0], lo[1], lo[2], lo[3], hi[0], hi[1], hi[2], hi[3]};
}
__device__ __forceinline__ float wave_scan_add(float x, int lane) {
#pragma unroll
    for (int o = 1; o < 64; o <<= 1) { const float y = __shfl_up(x, o); if (lane >= o) x += y; }
    return x;
}
__device__ __forceinline__ float wave_scan_max(float x, int lane) {
#pragma unroll
    for (int o = 1; o < 64; o <<= 1) { const float y = __shfl_up(x, o); if (lane >= o) x = fmaxf(x, y); }
    return x;
}
__device__ __forceinline__ float wave_max(float v) {
#pragma unroll
    for (int o = 1; o < 64; o <<= 1) v = fmaxf(v, __shfl_xor(v, o));
    return v;
}

__device__ __forceinline__ void m1_unit(const Args& a, LAS unsigned char* lds, int unit, int tid, int lane, int wave) {
    unsigned char* ws = a.ws;
    const int b = unit >> 6, c = (unit >> 2) & 15, h = unit & 3, t0 = b * 2048 + c * 128;
    LAS bf16r* Kn = (LAS bf16r*)lds;
    LAS bf16r* Vn = (LAS bf16r*)(lds + 34816);
    LAS float* fs = (LAS float*)(lds + 104448);
    const float* IFG = (const float*)(ws + WS_IFG); float* BCUM = (float*)(ws + WS_BCUM); float* MSC = (float*)(ws + WS_MSC);
    float li = 0.f, bsum = 0.f;
    if (wave < 2) { li = IFG[(size_t)(t0 + tid) * 8 + h]; bsum = wave_scan_add(IFG[(size_t)(t0 + tid) * 8 + 4 + h], lane); if (tid == 63) fs[128] = bsum; }
    __syncthreads();
    if (wave == 1) bsum += fs[128];
    if (wave < 2) { BCUM[(size_t)(t0 + tid) * 4 + h] = bsum; if (tid == 127) fs[129] = bsum; }
    __syncthreads();
    float w = 0.f;
    if (wave < 2) { w = fs[129] - bsum + li; const float wm = wave_max(w); if (lane == 0) fs[130 + wave] = wm; }
    __syncthreads();
    if (wave < 2) { const float m = fmaxf(fs[130], fs[131]); fs[tid] = __expf(w - m); if (tid == 0) { MSC[unit * 4 + 0] = m; MSC[unit * 4 + 1] = fs[129]; } }
    __syncthreads();
    const bf16r* mlqk = (const bf16r*)(ws + WS_MLQK); const bf16r* mlv = (const bf16r*)(ws + WS_MLV);
    const float* cw = (const float*)a.in[5]; const float* cb = (const float*)a.in[6];
    { const int dg = (tid & 15) * 8, col = 512 + h * 128 + dg; ConvW W; conv_w_load(cw, cb, col, W);
      u4 xv[4][4];
#pragma unroll
      for (int n = 0; n < 4; ++n) conv8_ld(mlqk, t0, c * 128, (tid >> 4) + 32 * n, col, xv[n]);
#pragma unroll
      for (int n = 0; n < 4; ++n) { const int l = (tid >> 4) + 32 * n; float o[8]; conv8_fin(W, xv[n], KSCALE, o);
          *(LAS u4*)(Kn + l * LP + dg) = (u4){pk2(o[0], o[1]), pk2(o[2], o[3]), pk2(o[4], o[5]), pk2(o[6], o[7])}; } }
#pragma unroll
    for (int it = tid; it < 128 * 32; it += 512) { const int l = it >> 5, dg = (it & 31) * 8; const float e = fs[l];
        const u4 xv = *(const u4*)(mlv + (size_t)(t0 + l) * 1024 + h * 256 + dg);
        *(LAS u4*)(Vn + l * LPV + dg) = (u4){pk2(bflo(xv.x) * e, bfhi(xv.x) * e), pk2(bflo(xv.y) * e, bfhi(xv.y) * e), pk2(bflo(xv.z) * e, bfhi(xv.z) * e), pk2(bflo(xv.w) * e, bfhi(xv.w) * e)}; }
    __syncthreads();
    if (tid < 128) { float sacc = 0.f;
#pragma unroll 16
        for (int l = 0; l < 128; ++l) sacc += fs[l] * __uint_as_float((unsigned)Kn[l * LP + tid] << 16);
        ((float*)(ws + WS_NLOC))[unit * 128 + tid] = sacc; }
    const int fr = lane & 15, fq = lane >> 4;
    f4 acc[8][2];
#pragma unroll
    for (int mt = 0; mt < 8; ++mt) { acc[mt][0] = (f4){0.f, 0.f, 0.f, 0.f}; acc[mt][1] = (f4){0.f, 0.f, 0.f, 0.f}; }
#pragma unroll
    for (int ks = 0; ks < 4; ++ks) {
        const s8v b0 = tr_frag(Vn + 32 * ks * LPV + 32 * wave, LPV, fr, fq), b1 = tr_frag(Vn + 32 * ks * LPV + 32 * wave + 16, LPV, fr, fq);
#pragma unroll
        for (int mt = 0; mt < 8; ++mt) { const s8v av = tr_frag(Kn + 32 * ks * LP + 16 * mt, LP, fr, fq); acc[mt][0] = MFMA16(av, b0, acc[mt][0]); acc[mt][1] = MFMA16(av, b1, acc[mt][1]); } }
    float* cl = (float*)(ws + WS_CLOC) + (size_t)unit * 32768;
#pragma unroll
    for (int mt = 0; mt < 8; ++mt)
#pragma unroll
        for (int nt = 0; nt < 2; ++nt) *(f4*)(cl + (size_t)(32 * wave + 16 * nt + fr) * 128 + 16 * mt + 4 * fq) = acc[mt][nt];
    __syncthreads();
}

__device__ __forceinline__ void m2_scan(const Args& a, int tid, int G) {
    unsigned char* ws = a.ws; const int gt = blockIdx.x * 512 + tid, NT = G * 512;
    const float* MSC = (const float*)(ws + WS_MSC); float* MSCw = (float*)(ws + WS_MSC);
    const float* CL = (const float*)(ws + WS_CLOC); bf16r* CP = (bf16r*)(ws + WS_CPREV);
    for (int e = gt; e < 16 * 8192; e += NT) { const int bh = e >> 13, idx = (e & 8191) * 4, b = bh >> 2, h = bh & 3;
        f4 C = {0.f, 0.f, 0.f, 0.f}; float m = 0.f;
        for (int c = 0; c < 16; ++c) { const int u = (b * 16 + c) * 4 + h;
            *(u2*)(CP + (size_t)u * 32768 + idx) = (u2){pk2(C[0], C[1]), pk2(C[2], C[3])};
            const float ml = MSC[u * 4 + 0], g = MSC[u * 4 + 1]; const float mn = fmaxf(g + m, ml), aa = __expf(g + m - mn), cc = __expf(ml - mn);
            const f4 Cl = __builtin_nontemporal_load((const f4*)(CL + (size_t)u * 32768 + idx)); C = C * aa + Cl * cc; m = mn; } }
    const float* NL = (const float*)(ws + WS_NLOC); float* NP = (float*)(ws + WS_NPREV);
    for (int e = gt; e < 16 * 128; e += NT) { const int bh = e >> 7, dk = e & 127, b = bh >> 2, h = bh & 3; float n = 0.f, m = 0.f;
        for (int c = 0; c < 16; ++c) { const int u = (b * 16 + c) * 4 + h; NP[u * 128 + dk] = n; if (dk == 0) MSCw[u * 4 + 2] = m;
            const float ml = MSC[u * 4 + 0], g = MSC[u * 4 + 1]; const float mn = fmaxf(g + m, ml), aa = __expf(g + m - mn), cc = __expf(ml - mn);
            n = aa * n + cc * NL[u * 128 + dk]; m = mn; } }
}

template <int ONLY_STAGE = 0>
__device__ __forceinline__ void m3_unit(const Args& a, LAS unsigned char* lds, int unit, int tid, int lane, int wave) {
    unsigned char* ws = a.ws;
    const int b = unit >> 6, c = (unit >> 2) & 15, h = unit & 3, t0 = b * 2048 + c * 128;
    LAS bf16r* Qc = (LAS bf16r*)lds;
    LAS bf16r* Kc = (LAS bf16r*)(lds + 34816);
    LAS bf16r* Vn = (LAS bf16r*)(lds + 69632);
    LAS float* fs = (LAS float*)(lds + 139264);
    const float* IFG = (const float*)(ws + WS_IFG); const float* BCUM = (const float*)(ws + WS_BCUM); const float* MSC = (const float*)(ws + WS_MSC);
    const float m_prev = MSC[unit * 4 + 2];
    if (tid < 128) { const float bt = BCUM[(size_t)(t0 + tid) * 4 + h]; fs[tid] = IFG[(size_t)(t0 + tid) * 8 + h] - bt; fs[128 + tid] = bt; }
    else if (tid < 256) fs[256 + tid - 128] = ((const float*)(ws + WS_NPREV))[unit * 128 + tid - 128];
    const bf16r* mlqk = (const bf16r*)(ws + WS_MLQK); const bf16r* mlv = (const bf16r*)(ws + WS_MLV);
    const float* cw = (const float*)a.in[5]; const float* cb = (const float*)a.in[6];
    { const int isk = (tid >> 4) & 1, dg = (tid & 15) * 8, col = isk * 512 + h * 128 + dg; ConvW W; conv_w_load(cw, cb, col, W);
      LAS bf16r* dst = isk ? Kc : Qc; const float sc = isk ? KSCALE : 1.f;
#pragma unroll
      for (int hf = 0; hf < 2; ++hf) { u4 xv[4][4];
#pragma unroll
          for (int n = 0; n < 4; ++n) conv8_ld(mlqk, t0, c * 128, (tid >> 5) + 16 * (4 * hf + n), col, xv[n]);
#pragma unroll
          for (int n = 0; n < 4; ++n) { const int l = (tid >> 5) + 16 * (4 * hf + n); float o[8]; conv8_fin(W, xv[n], sc, o);
              *(LAS u4*)(dst + l * LP + dg) = (u4){pk2(o[0], o[1]), pk2(o[2], o[3]), pk2(o[4], o[5]), pk2(o[6], o[7])}; } } }
#pragma unroll
    for (int it = tid; it < 128 * 32; it += 512) { const int l = it >> 5, dg = (it & 31) * 8;
        *(LAS u4*)(Vn + l * LPV + dg) = __builtin_nontemporal_load((const u4*)(mlv + (size_t)(t0 + l) * 1024 + h * 256 + dg)); }
    const int fr = lane & 15, fq = lane >> 4, t = 16 * wave + fr;
    const bf16r* cp = (const bf16r*)(ws + WS_CPREV) + (size_t)unit * 32768 + (size_t)fr * 128 + 8 * fq;
    s8v cpa[32];
#pragma unroll
    for (int ks = 0; ks < 4; ++ks)
#pragma unroll
        for (int mt = 0; mt < 8; ++mt) cpa[ks * 8 + mt] = *(const s8v*)(cp + (size_t)(16 * mt) * 128 + 32 * ks);
    __syncthreads();
    if (ONLY_STAGE) return;
    float pmx = 0.f;
    if (wave < 2) { pmx = wave_scan_max(fs[tid], lane); if (tid == 63) fs[896] = pmx; }
    __syncthreads();
    if (wave < 2) { if (wave == 1) pmx = fmaxf(pmx, fs[896]);
        const float M = fmaxf(m_prev, pmx); fs[384 + tid] = M; fs[512 + tid] = __expf(m_prev - M); fs[640 + tid] = __expf(-(fs[128 + tid] + M));
        float qn = 0.f;
#pragma unroll 4
        for (int d8 = 0; d8 < 16; ++d8) { const u4 qv = *(const LAS u4*)(Qc + tid * LP + 8 * d8); const f4 n0 = *(const LAS f4*)(fs + 256 + 8 * d8), n1 = *(const LAS f4*)(fs + 256 + 8 * d8 + 4);
            qn += (bflo(qv.x) * n0.x + bfhi(qv.x) * n0.y) + (bflo(qv.y) * n0.z + bfhi(qv.y) * n0.w) + (bflo(qv.z) * n1.x + bfhi(qv.z) * n1.y) + (bflo(qv.w) * n1.z + bfhi(qv.w) * n1.w); }
        fs[768 + tid] = qn; }
    __syncthreads();
    f4 as[8];
#pragma unroll
    for (int mt = 0; mt < 8; ++mt) as[mt] = (f4){0.f, 0.f, 0.f, 0.f};
#pragma unroll
    for (int ks = 0; ks < 4; ++ks) { const s8v bq = *(const LAS s8v*)(Qc + t * LP + 32 * ks + 8 * fq);
#pragma unroll
        for (int mt = 0; mt < 8; ++mt) if (mt <= wave) { const s8v av = *(const LAS s8v*)(Kc + (16 * mt + fr) * LP + 32 * ks + 8 * fq); as[mt] = MFMA16(av, bq, as[mt]); } }
    __syncthreads();
    const float Mt = fs[384 + t]; float den = 0.f; const int lim = fr - 4 * fq;
#pragma unroll
    for (int mt = 0; mt < 8; ++mt) if (mt <= wave + 1) { float v[4];
        if (mt < wave) {
#pragma unroll
            for (int r = 0; r < 4; ++r) v[r] = as[mt][r] * __expf(fs[16 * mt + 4 * fq + r] - Mt);
        } else if (mt == wave) {
#pragma unroll
            for (int r = 0; r < 4; ++r) v[r] = (r <= lim) ? as[mt][r] * __expf(fs[16 * mt + 4 * fq + r] - Mt) : 0.f;
        } else { v[0] = 0.f; v[1] = 0.f; v[2] = 0.f; v[3] = 0.f; }
        den += (v[0] + v[1]) + (v[2] + v[3]);
        if (mt <= wave || (wave & 1) == 0) *(LAS u2*)(Kc + t * LP + 16 * mt + 4 * fq) = (u2){pk2(v[0], v[1]), pk2(v[2], v[3])}; }
    den += __shfl_xor(den, 16); den += __shfl_xor(den, 32);
    __syncthreads();
    f4 ao[16]; const float iw = fs[512 + t];
#pragma unroll
    for (int mt = 0; mt < 16; ++mt) ao[mt] = (f4){0.f, 0.f, 0.f, 0.f};
#pragma unroll
    for (int ks = 0; ks < 4; ++ks) { const s8v bq = *(const LAS s8v*)(Qc + t * LP + 32 * ks + 8 * fq);
#pragma unroll
        for (int mt = 0; mt < 8; ++mt) ao[mt] = MFMA16(cpa[ks * 8 + mt], bq, ao[mt]); }
#pragma unroll
    for (int ks = 0; ks < 4; ++ks)
#pragma unroll
        for (int mt = 0; mt < 8; ++mt) cpa[ks * 8 + mt] = *(const s8v*)(cp + (size_t)(16 * (mt + 8)) * 128 + 32 * ks);
#pragma unroll
    for (int ks = 0; ks < 4; ++ks) { const s8v bq = *(const LAS s8v*)(Qc + t * LP + 32 * ks + 8 * fq);
#pragma unroll
        for (int mt = 0; mt < 8; ++mt) ao[8 + mt] = MFMA16(cpa[ks * 8 + mt], bq, ao[8 + mt]); }
    const bf16r* mlo = (const bf16r*)(ws + WS_MLO) + (size_t)(t0 + t) * 1024 + h * 256 + 4 * fq; const bf16r* mlz = (const bf16r*)(ws + WS_MLZ) + (size_t)(t0 + t) * 1024 + h * 256 + 4 * fq;
    u2 ovv[16], zvv[16];
#pragma unroll
    for (int mt = 0; mt < 16; ++mt) { ovv[mt] = __builtin_nontemporal_load((const u2*)(mlo + 16 * mt)); zvv[mt] = __builtin_nontemporal_load((const u2*)(mlz + 16 * mt)); }
#pragma unroll
    for (int mt = 0; mt < 16; ++mt) ao[mt] = ao[mt] * iw;
    const int nks = (wave + 2) >> 1;
    for (int ks = 0; ks < nks; ++ks) { const s8v bs = *(const LAS s8v*)(Kc + t * LP + 32 * ks + 8 * fq);
#pragma unroll
        for (int mt = 0; mt < 16; ++mt) { const s8v av = tr_frag(Vn + 32 * ks * LPV + 16 * mt, LPV, fr, fq); ao[mt] = MFMA16(av, bs, ao[mt]); } }
    const float dt = den + iw * fs[768 + t], inv = 1.f / fmaxf(fabsf(dt), fs[640 + t]);
    float ssq = 0.f;
#pragma unroll
    for (int mt = 0; mt < 16; ++mt) { const f4 hv = ao[mt] * inv; ssq += (hv[0] * hv[0] + hv[1] * hv[1]) + (hv[2] * hv[2] + hv[3] * hv[3]); }
    ssq += __shfl_xor(ssq, 16); ssq += __shfl_xor(ssq, 32);
    const float rstd = rsqrtf(ssq * (1.f / 256.f) + EPS) * inv;
    const float* gn = (const float*)a.in[9] + h * 256 + 4 * fq;
    bf16r* ao_out = (bf16r*)(ws + WS_AO) + (size_t)(t0 + t) * 2048 + h * 256 + 4 * fq;
#pragma unroll
    for (int mt = 0; mt < 16; ++mt) { const f4 g = *(const f4*)(gn + 16 * mt); const u2 ov = ovv[mt], zv = zvv[mt];
        const float r0 = ao[mt][0] * rstd * g.x * sigm(bflo(ov.x)) * silu(bflo(zv.x)), r1 = ao[mt][1] * rstd * g.y * sigm(bfhi(ov.x)) * silu(bfhi(zv.x));
        const float r2 = ao[mt][2] * rstd * g.z * sigm(bflo(ov.y)) * silu(bflo(zv.y)), r3 = ao[mt][3] * rstd * g.w * sigm(bfhi(ov.y)) * silu(bfhi(zv.y));
        *(u2*)(ao_out + 16 * mt) = (u2){pk2(r0, r1), pk2(r2, r3)}; }
    __syncthreads();
}

__device__ __forceinline__ void da_combine(const Args& a, int lane, int wave, int G) {
    unsigned char* ws = a.ws; const int gw = blockIdx.x * 8 + wave, NGW = G * 8;
    const float* q1 = (const float*)a.in[10]; const float* k1 = (const float*)a.in[11]; const float* q2 = (const float*)a.in[12]; const float* k2 = (const float*)a.in[13];
    const float s1 = wave_sum(q1[lane] * k1[lane] + q1[lane + 64] * k1[lane + 64]), s2 = wave_sum(q2[lane] * k2[lane] + q2[lane + 64] * k2[lane + 64]);
    const float lam_init = 0.2f, lam = expf(s1) - expf(s2) + lam_init;
    const bf16r* dao = (const bf16r*)(ws + WS_DAO); const bf16r* daz = (const bf16r*)(ws + WS_DAZ); bf16r* ao = (bf16r*)(ws + WS_AO);
    const float* gn = (const float*)a.in[14];
    const int half = lane >> 5, d = (lane & 31) * 4, dv = half * 128 + d;
    for (int it0 = gw; it0 < TOK * 4; it0 += 4 * NGW) {
        u2 o0[4], o1[4], zv[4]; f4 g[4];
#pragma unroll
        for (int k = 0; k < 4; ++k) { const int it = it0 + k * NGW, tok = it >> 2, h = it & 3, b = tok >> 11, s = tok & 2047;
            o0[k] = __builtin_nontemporal_load((const u2*)(dao + ((size_t)(((b * 4 + h) * 2 + 0) * 2 + half) * 2048 + s) * 128 + d)); o1[k] = __builtin_nontemporal_load((const u2*)(dao + ((size_t)(((b * 4 + h) * 2 + 1) * 2 + half) * 2048 + s) * 128 + d));
            g[k] = *(const f4*)(gn + h * 256 + dv); zv[k] = __builtin_nontemporal_load((const u2*)(daz + (size_t)tok * 1024 + h * 256 + dv)); }
#pragma unroll
        for (int k = 0; k < 4; ++k) { const int it = it0 + k * NGW, tok = it >> 2, h = it & 3;
            const float h0 = bflo(o0[k].x) - lam * bflo(o1[k].x), h1 = bfhi(o0[k].x) - lam * bfhi(o1[k].x), h2 = bflo(o0[k].y) - lam * bflo(o1[k].y), h3 = bfhi(o0[k].y) - lam * bfhi(o1[k].y);
            const float rstd = rsqrtf(wave_sum((h0 * h0 + h1 * h1) + (h2 * h2 + h3 * h3)) * (1.f / 256.f) + EPS) * (1.f - lam_init);
            *(u2*)(ao + (size_t)tok * 2048 + 1024 + h * 256 + dv) = (u2){pk2(h0 * rstd * g[k].x * silu(bflo(zv[k].x)), h1 * rstd * g[k].y * silu(bfhi(zv[k].x))), pk2(h2 * rstd * g[k].z * silu(bflo(zv[k].y)), h3 * rstd * g[k].w * silu(bfhi(zv[k].y)))}; } }
}

__device__ __forceinline__ void sgu_unit(const Args& a, LAS unsigned char* lds, int unit, int tid, int lane, int wave) {
    unsigned char* ws = a.ws;
    const int b = unit >> 7, c = (unit >> 3) & 15, g = unit & 7, t0 = b * 2048 + c * 128;
    LAS bf16r* VLn = (LAS bf16r*)lds;
    LAS bf16r* Wt = (LAS bf16r*)(lds + 69632);
    LAS float* fs = (LAS float*)(lds + 104448);
    if (tid < 128) { const f4* p1 = (const f4*)((const float*)(ws + WS_LNS) + (size_t)(t0 + tid) * 32); const f4* p2 = (const f4*)((const float*)(ws + WS_LNQ) + (size_t)(t0 + tid) * 32); float s1 = 0.f, s2 = 0.f;
#pragma unroll
        for (int i = 0; i < 8; ++i) { const f4 x1 = p1[i], x2 = p2[i]; s1 += (x1.x + x1.y) + (x1.z + x1.w); s2 += (x2.x + x2.y) + (x2.z + x2.w); }
        const float mu = s1 * (1.f / DM), var = fmaxf(s2 * (1.f / DM) - mu * mu, 0.f); fs[tid] = mu; fs[128 + tid] = rsqrtf(var + EPS); }
    __syncthreads();
    const bf16r* V = (const bf16r*)(ws + WS_V); const float* lg = (const float*)a.in[18] + g * 256; const float* lb = (const float*)a.in[19] + g * 256;
    const int dgs = (tid & 31) * 8;
    const f4 g0 = *(const f4*)(lg + dgs), g1 = *(const f4*)(lg + dgs + 4), b0 = *(const f4*)(lb + dgs), b1 = *(const f4*)(lb + dgs + 4);
#pragma unroll
    for (int it = tid; it < 128 * 32; it += 512) { const int s = it >> 5, dg = dgs; const float mu = fs[s], rs = fs[128 + s];
        const u4 xv = __builtin_nontemporal_load((const u4*)(V + (size_t)(t0 + s) * 2048 + g * 256 + dg));
        const unsigned w0 = pk2((bflo(xv.x) - mu) * rs * g0.x + b0.x, (bfhi(xv.x) - mu) * rs * g0.y + b0.y), w1 = pk2((bflo(xv.y) - mu) * rs * g0.z + b0.z, (bfhi(xv.y) - mu) * rs * g0.w + b0.w);
        const unsigned w2 = pk2((bflo(xv.z) - mu) * rs * g1.x + b1.x, (bfhi(xv.z) - mu) * rs * g1.y + b1.y), w3 = pk2((bflo(xv.w) - mu) * rs * g1.z + b1.z, (bfhi(xv.w) - mu) * rs * g1.w + b1.w);
        *(LAS u4*)(VLn + s * LPV + dg) = (u4){w0, w1, w2, w3}; }
    const float* sw = (const float*)a.in[20] + (size_t)g * 128 * 128;
#pragma unroll
    for (int it = tid; it < 128 * 16; it += 512) { const int t = it >> 4, sg = (it & 15) * 8; f4 w0 = *(const f4*)(sw + t * 128 + sg), w1 = *(const f4*)(sw + t * 128 + sg + 4);
        if (sg + 0 > t) w0.x = 0.f; if (sg + 1 > t) w0.y = 0.f; if (sg + 2 > t) w0.z = 0.f; if (sg + 3 > t) w0.w = 0.f;
        if (sg + 4 > t) w1.x = 0.f; if (sg + 5 > t) w1.y = 0.f; if (sg + 6 > t) w1.z = 0.f; if (sg + 7 > t) w1.w = 0.f;
        *(LAS u4*)(Wt + t * LP + sg) = (u4){pk2(w0.x, w0.y), pk2(w0.z, w0.w), pk2(w1.x, w1.y), pk2(w1.z, w1.w)}; }
    __syncthreads();
    const int fr = lane & 15, fq = lane >> 4, t = 16 * wave + fr;
    f4 ac[16];
#pragma unroll
    for (int mt = 0; mt < 16; ++mt) ac[mt] = (f4){0.f, 0.f, 0.f, 0.f};
    const int nks = (wave + 2) >> 1;
    for (int ks = 0; ks < nks; ++ks) { const s8v bw = *(const LAS s8v*)(Wt + t * LP + 32 * ks + 8 * fq);
#pragma unroll
        for (int mt = 0; mt < 16; ++mt) { const s8v av = tr_frag(VLn + 32 * ks * LPV + 16 * mt, LPV, fr, fq); ac[mt] = MFMA16(av, bw, ac[mt]); } }
    __syncthreads();
    LAS float* OUTS = (LAS float*)lds;
    { const float sb = ((const float*)a.in[21])[g * 128 + t];
#pragma unroll
      for (int mt = 0; mt < 16; ++mt) *(LAS f4*)(OUTS + t * 260 + 16 * mt + 4 * fq) = ac[mt] + sb; }
    __syncthreads();
    { const int dg = (tid & 31) * 8;
      const bf16r* U = (const bf16r*)a.out + (size_t)t0 * 2048 + g * 256 + dg; const bf16r* Z = U + (size_t)TOK * DM; bf16r* MB = (bf16r*)(ws + WS_MB) + (size_t)t0 * 2048 + g * 256 + dg;
      u4 uw[8], zw[8];
#pragma unroll
      for (int n = 0; n < 8; ++n) { const int tt = (tid >> 5) + 16 * n; uw[n] = __builtin_nontemporal_load((const u4*)(U + (size_t)tt * 2048)); zw[n] = __builtin_nontemporal_load((const u4*)(Z + (size_t)tt * 2048)); }
#pragma unroll
      for (int n = 0; n < 8; ++n) { const int tt = (tid >> 5) + 16 * n; const f4 s0 = *(const LAS f4*)(OUTS + tt * 260 + dg), s1 = *(const LAS f4*)(OUTS + tt * 260 + dg + 4);
          u4 o; o.x = pk2(bflo(uw[n].x) * s0.x * silu(bflo(zw[n].x)), bfhi(uw[n].x) * s0.y * silu(bfhi(zw[n].x))); o.y = pk2(bflo(uw[n].y) * s0.z * silu(bflo(zw[n].y)), bfhi(uw[n].y) * s0.w * silu(bfhi(zw[n].y)));
          o.z = pk2(bflo(uw[n].z) * s1.x * silu(bflo(zw[n].z)), bfhi(uw[n].z) * s1.y * silu(bfhi(zw[n].z))); o.w = pk2(bflo(uw[n].w) * s1.z * silu(bflo(zw[n].w)), bfhi(uw[n].w) * s1.w * silu(bfhi(zw[n].w)));
          *(u4*)(MB + (size_t)tt * 2048) = o; } }
    __syncthreads();
}

__device__ __forceinline__ void final_norm(const Args& a, int lane, int wave, int G) {
    const int gw = blockIdx.x * 8 + wave, NGW = G * 8; const f4* gn = (const f4*)a.in[26];
    for (int m = gw; m < TOK; m += NGW) { f4* xr = (f4*)(a.out + (size_t)m * DM) + lane; f4 v[8]; float s = 0.f;
#pragma unroll
        for (int j = 0; j < 8; ++j) { v[j] = xr[64 * j]; s += (v[j].x * v[j].x + v[j].y * v[j].y) + (v[j].z * v[j].z + v[j].w * v[j].w); }
        const float rstd = rsqrtf(wave_sum(s) * (1.f / DM) + EPS);
#pragma unroll
        for (int j = 0; j < 8; ++j) xr[64 * j] = v[j] * rstd * gn[lane + 64 * j]; }
}

__device__ __forceinline__ void attn_phase(const Args& a, char* lds, int G) {
    using namespace att;
    unsigned char* ws = a.ws;
    const bf16* DQ = (const bf16*)(ws + WS_DAQ); const bf16* DK = (const bf16*)(ws + WS_DAK); const bf16* DV = (const bf16*)(ws + WS_DAV); bf16* DO = (bf16*)(ws + WS_DAO);
    const int W = 1 << 30;
    { const int L = blockIdx.x;
        const int xcd = L & 7, slot = L >> 3, grp = xcd * 2 + (slot >> 4), w = slot & 15, map = w >> 3, half = (w >> 2) & 1, x = w & 3;
        const bf16* Q = DQ + (size_t)(grp * 2 + map) * 2048 * 128; const bf16* K = DK + (size_t)(grp * 2 + map) * 2048 * 128;
        const bf16* V = DV + (size_t)(grp * 2 + half) * 2048 * 128; bf16* O = DO + (size_t)((grp * 2 + map) * 2 + half) * 2048 * 128;
        const int qb0 = x, qb1 = 7 - x;
        BlockRef<bf16, bf16> c0, c1;
        c0.Q = Q + (size_t)qb0 * QB * D; c0.K = K; c0.V = V; c0.O = O + (size_t)qb0 * QB * D; c0.P0 = qb0 * QB;
        c1.Q = Q + (size_t)qb1 * QB * D; c1.K = K; c1.V = V; c1.O = O + (size_t)qb1 * QB * D; c1.P0 = qb1 * QB;
        Seam<bf16> S;
        causal_swa_prime<bf16, bf16>(c0, W, lds, S);
        causal_swa_block<bf16, bf16>(c0, c1, 2048, W, lds, S);
        causal_swa_block<bf16, bf16>(c1, c1, 2048, W, lds, S);
        __syncthreads();
    }
}

#ifndef MK_LAUNCHES
#define MK_LAUNCHES 1
#endif
constexpr int NPHASE = 11;
__global__ void __launch_bounds__(512, 2) mk_fwd(Args args_unused) {
    extern __shared__ __attribute__((aligned(16))) unsigned char lds_raw[];
    LAS unsigned char* lds = (LAS unsigned char*)lds_raw;
    const int G = gridDim.x;
#define TIDS int tid = threadIdx.x; asm volatile("" : "+v"(tid)); const int lane = tid & 63, wave = __builtin_amdgcn_readfirstlane(tid >> 6); (void)tid; (void)lane; (void)wave
    const unsigned long long lohi = karg64(232); const int lo = (int)(unsigned)lohi, hi = (int)(unsigned)(lohi >> 32);
#define IN(k) (lo <= (k) && (k) < hi)
#if MK_LAUNCHES == 1
    if ((int)(unsigned)(karg64(232) >> 32) > NPHASE) cg::this_grid().sync();
    if (threadIdx.x < 2) ((volatile LAS unsigned*)(lds + LDS_BARST))[threadIdx.x] = 0u;
    __syncthreads();
    (void)xcd_barrier_post((unsigned*)(GAS unsigned*)(karg64(224) + WS_BAR), (volatile LAS unsigned*)(lds + LDS_BARST));
#define SEAM(k) do { if (IN(k) && IN((k) + 1)) { XcdBarrier b_; b_.bar = (unsigned*)(GAS unsigned*)(karg64(224) + WS_BAR); b_.x = xb_xcc_id(); b_.st = (volatile LAS unsigned*)(lds + LDS_BARST); xcd_barrier(b_); } } while (0)
#else
#define SEAM(k) do { } while (0)
#endif
    typedef pg8::EpiBf16<0> EpiPlain;
    if (IN(0)) { TIDS; Args args; KWS(args); KIN(args, 0); KIN(args, 1); KIN(args, 2); KIN(args, 3); KIN(args, 4); KIN(args, 7); KIN(args, 8); KIN(args, 15); KIN(args, 23); KIN(args, 24); KIN(args, 25);
        phase0<7>(args, lds, tid, lane, wave, G); }
#ifdef MK_P4_PART
    if (lo == 21) {
        if (MK_P4_PART & 1) { TIDS; Args args; KWS(args); KIN(args, 5); KIN(args, 6); KIN(args, 9);
          __syncthreads();
          for (int rr = 0; rr < MK_INNER; ++rr) for (int u = blockIdx.x; u < 256; u += G) m3_unit(args, lds, u, tid, lane, wave); }
        if (MK_P4_PART & 2) { TIDS; Args args; KWS(args); KIN(args, 10); KIN(args, 11); KIN(args, 12); KIN(args, 13); KIN(args, 14);
          da_combine(args, lane, wave, G); }
    }
#endif
#ifdef MK_P0_PART
    if (lo == 20) { TIDS; Args args; KWS(args); KIN(args, 0); KIN(args, 1); KIN(args, 2); KIN(args, 3); KIN(args, 4); KIN(args, 7); KIN(args, 8); KIN(args, 15); KIN(args, 23); KIN(args, 24); KIN(args, 25);
        phase0<MK_P0_PART>(args, lds, tid, lane, wave, G); }
#endif
    SEAM(0);
    if (IN(1)) {
        Args args; KWS(args); unsigned char* ws = args.ws;
        __syncthreads();
        { pg8::Gemm g{(const bf16r*)(ws + WS_H), (const bf16r*)(ws + WS_WIN), TOK, 8192, 2048}; pg8::StaticOrder S; S.init(TOK, 8192, G, (int)blockIdx.x);
          EpiG1 E{ws}; pg8::gemm_phase<EpiG1, pg8::StaticOrder, true, true>(lds, g, S, E); }
        __syncthreads();
        { pg8::Gemm g{(const bf16r*)(ws + WS_PB), (const bf16r*)(ws + WS_WPP0), TOK, 2048, 256}; pg8::StaticOrder S; S.init(TOK, 2048, G, (int)blockIdx.x);
          EpiPlain E{(bf16r*)(ws + WS_PP0), 2048, nullptr, 0, 0, 1.f}; pg8::gemm_phase<EpiPlain, pg8::StaticOrder, true, true>(lds, g, S, E); }
    }
    SEAM(1);
    if (IN(2)) {
        TIDS; Args args; KWS(args); KIN(args, 5); KIN(args, 6);
        __syncthreads();
        attn_phase(args, (char*)lds_raw, G);
        __syncthreads();
        for (int u = blockIdx.x; u < 256; u += G) m1_unit(args, lds, u, tid, lane, wave);
    }
    SEAM(2);
    if (IN(3)) { TIDS; Args args; KWS(args); m2_scan(args, tid, G); }
    SEAM(3);
    if (IN(4)) {
        { TIDS; Args args; KWS(args); KIN(args, 5); KIN(args, 6); KIN(args, 9);
          __syncthreads();
#ifdef MK_M3_STAGE2
          for (int rr = 0; rr < MK_M3_STAGE2; ++rr) { for (int u = blockIdx.x; u < 256; u += G) m3_unit<1>(args, lds, u, tid, lane, wave); __syncthreads(); }
#endif
          for (int u = blockIdx.x; u < 256; u += G) m3_unit(args, lds, u, tid, lane, wave); }
        { TIDS; Args args; KWS(args); KIN(args, 10); KIN(args, 11); KIN(args, 12); KIN(args, 13); KIN(args, 14);
          da_combine(args, lane, wave, G); }
    }
    SEAM(4);
    if (IN(5)) {
        TIDS; Args args; KWS(args); KOUT(args); KIN(args, 0); KIN(args, 16); KIN(args, 17); KIN(args, 22); KIN(args, 23); KIN(args, 24); KIN(args, 25); unsigned char* ws = args.ws;
        __syncthreads();
        l1_weights(args, lds, lane, wave, G);
        __syncthreads();
        pg8::Gemm g{(const bf16r*)(ws + WS_AO), (const bf16r*)(ws + WS_WOUT0), TOK, 2048, 2048}; pg8::StaticOrder S; S.init(TOK, 2048, G, (int)blockIdx.x);
        EpiRes<false> E{args.in[0], (bf16r*)(ws + WS_X1B), (float*)(ws + WS_SSQA)};
        pg8::gemm_phase<EpiRes<false>, pg8::StaticOrder, true, true>(lds, g, S, E);
    }
    SEAM(5);
    if (IN(6)) {
        Args args; KWS(args); KOUT(args); unsigned char* ws = args.ws;
        __syncthreads();
        pg8::Gemm g{(const bf16r*)(ws + WS_X1B), (const bf16r*)(ws + WS_WG0), TOK, 2048, 2048}; pg8::StaticOrder S; S.init(TOK, 2048, G, (int)blockIdx.x);
        EpiGate E{(const bf16r*)(ws + WS_X1B), (bf16r*)(ws + WS_X2B), (const bf16r*)(ws + WS_PP0), (const float*)(ws + WS_SSQA), (float*)(ws + WS_SSQB)};
        pg8::gemm_phase<EpiGate, pg8::StaticOrder, true, true>(lds, g, S, E);
    }
    SEAM(6);
    if (IN(7)) {
        Args args; KWS(args); KOUT(args); unsigned char* ws = args.ws;
        __syncthreads();
        { pg8::Gemm g{(const bf16r*)(ws + WS_X2B), (const bf16r*)(ws + WS_WCIN), TOK, 6144, 2048}; pg8::StaticOrder S; S.init(TOK, 6144, G, (int)blockIdx.x);
          EpiUVZ E{(bf16r*)args.out, (bf16r*)(ws + WS_V), (const float*)(ws + WS_SSQB), (float*)(ws + WS_LNS), (float*)(ws + WS_LNQ)};
          pg8::gemm_phase<EpiUVZ, pg8::StaticOrder, true, true>(lds, g, S, E); }
        __syncthreads();
        { pg8::Gemm g{(const bf16r*)(ws + WS_PB) + (size_t)TOK * 256, (const bf16r*)(ws + WS_WPP1), TOK, 2048, 256}; pg8::StaticOrder S; S.init(TOK, 2048, G, (int)blockIdx.x);
          EpiPlain E{(bf16r*)(ws + WS_PP1), 2048, nullptr, 0, 0, 1.f}; pg8::gemm_phase<EpiPlain, pg8::StaticOrder, true, true>(lds, g, S, E); }
    }
    SEAM(7);
    if (IN(8)) {
        TIDS; Args args; KWS(args); KOUT(args); KIN(args, 18); KIN(args, 19); KIN(args, 20); KIN(args, 21);
        __syncthreads();
        for (int u = blockIdx.x; u < 512; u += G) sgu_unit(args, lds, u, tid, lane, wave);
    }
    SEAM(8);
    if (IN(9)) {
        Args args; KWS(args); KOUT(args); unsigned char* ws = args.ws;
        __syncthreads();
        pg8::Gemm g{(const bf16r*)(ws + WS_MB), (const bf16r*)(ws + WS_WCOUT), TOK, 2048, 2048}; pg8::StaticOrder S; S.init(TOK, 2048, G, (int)blockIdx.x);
        EpiRes<true> E{(const void*)(ws + WS_X2B), (bf16r*)(ws + WS_X3B), (float*)(ws + WS_SSQC)};
        pg8::gemm_phase<EpiRes<true>, pg8::StaticOrder, true, true>(lds, g, S, E);
    }
    SEAM(9);
    if (IN(10)) {
        Args args; KWS(args); KOUT(args); KIN(args, 26); unsigned char* ws = args.ws;
        __syncthreads();
        pg8::Gemm g{(const bf16r*)(ws + WS_X3B), (const bf16r*)(ws + WS_WG1), TOK, 2048, 2048}; pg8::StaticOrder S; S.init(TOK, 2048, G, (int)blockIdx.x);
        EpiGateFinal E{(const bf16r*)(ws + WS_X3B), args.out, (const bf16r*)(ws + WS_PP1), (const float*)(ws + WS_SSQC), (float*)(ws + WS_SSQA), (unsigned*)(ws + WS_BAR + 16384), (const float*)args.in[26]};
        pg8::gemm_phase<EpiGateFinal, pg8::StaticOrder, true, true>(lds, g, S, E);
    }
#undef IN
#undef SEAM
}

extern "C" void kernel_launch(void* const* d_in, const int* in_sizes, int n_in, void* d_out, int out_size, void* d_ws, size_t ws_size, hipStream_t stream) {
    static int grid = 0;
    if (grid == 0) {
        if (n_in != 27 || out_size != TOK * DM || ws_size < WS_END) { fprintf(stderr, "kernel_launch: unexpected shapes (n_in %d out %d ws %zu)\n", n_in, out_size, ws_size); grid = -1; return; }
        int dev = 0, cus = 0, per_cu = 0;
        (void)hipGetDevice(&dev); (void)hipDeviceGetAttribute(&cus, hipDeviceAttributeMultiprocessorCount, dev);
        (void)hipFuncSetAttribute((const void*)mk_fwd, hipFuncAttributeMaxDynamicSharedMemorySize, LDS_BYTES);
        (void)hipOccupancyMaxActiveBlocksPerMultiprocessor(&per_cu, (const void*)mk_fwd, 512, LDS_BYTES);
        if (per_cu < 1) { fprintf(stderr, "kernel_launch: occupancy query says %d blocks per CU\n", per_cu); per_cu = 1; }
        if (cus != 256) { fprintf(stderr, "kernel_launch: built for a 256-CU device (got %d)\n", cus); grid = -1; return; }
        grid = 256;
        (void)hipGetLastError();
    }
    if (grid < 0) return;
    Args a{};
    for (int i = 0; i < 27; ++i) a.in[i] = d_in[i];
    (void)hipMemsetAsync((unsigned char*)d_ws + WS_BAR, 0, 32768, stream);
    a.out = (float*)d_out; a.ws = (unsigned char*)d_ws;
#if MK_LAUNCHES == 1
    a.ph_lo = 0; a.ph_hi = NPHASE;
    void* kargs[] = {&a};
    hipError_t e = hipLaunchCooperativeKernel((const void*)mk_fwd, dim3(grid), dim3(512), kargs, LDS_BYTES, stream);
    if (e != hipSuccess) fprintf(stderr, "cooperative launch failed: %s (grid %d)\n", hipGetErrorString(e), grid);
#else
    for (int p = 0; p < NPHASE; ++p) { a.ph_lo = p; a.ph_hi = p + 1; hipLaunchKernelGGL(mk_fwd, dim3(grid), dim3(512), LDS_BYTES, stream, a);
#ifdef MK_REP_PHASE
#if defined(MK_P4_PART)
        if (p == 4) { a.ph_lo = 21; a.ph_hi = 22; for (int r = 0; r < MK_REP_N; ++r) hipLaunchKernelGGL(mk_fwd, dim3(grid), dim3(512), LDS_BYTES, stream, a); }
#elif defined(MK_P0_PART)
        if (p == 0) { a.ph_lo = 20; a.ph_hi = 21; for (int r = 0; r < MK_REP_N; ++r) hipLaunchKernelGGL(mk_fwd, dim3(grid), dim3(512), LDS_BYTES, stream, a); }
#else
        if (p == MK_REP_PHASE) for (int r = 0; r < MK_REP_N; ++r) hipLaunchKernelGGL(mk_fwd, dim3(grid), dim3(512), LDS_BYTES, stream, a);
#endif
#endif
    }
#endif
}
```

```cpp
#include <hip/hip_runtime.h>
#include <hip/hip_bf16.h>
#include <hip/hip_cooperative_groups.h>
#include <cstdio>
#include <cstdint>
namespace cg = cooperative_groups;
__device__ __forceinline__ int mk_tid() { int t = (int)threadIdx.x; asm volatile("" : "+v"(t)); return t; }
namespace pg8 {
#define PG8_LAS __attribute__((address_space(3)))
typedef unsigned short bf16_t;
typedef short bf16x8 __attribute__((ext_vector_type(8)));
typedef float f32x4 __attribute__((ext_vector_type(4)));
typedef unsigned u32x4 __attribute__((ext_vector_type(4)));
constexpr int BM = 256, BK = 64, HALF = 128, HTB = HALF * BK * 2  , STAGE_BYTES = 8 * HTB, NXCD = 8, WGM = 8;

__host__ __device__ __forceinline__ int lds_byte(int r, int c) { const int st = (r >> 4) * 2 + (c >> 5), rr = r & 15, cc = c & 31, ob = rr * 64 + cc * 2; return st * 1024 + (ob ^ (((ob >> 9) & 1) << 5)); }
__host__ __device__ __forceinline__ void stage_rc(int b, int& R, int& C) { const int st = b / 1024, sb = b % 1024, swz = sb ^ (((sb >> 9) & 1) << 5); R = (st >> 1) * 16 + swz / 64; C = (st & 1) * 32 + (swz % 64) / 2; }
__host__ __device__ __forceinline__ int perm32(int rho) { const int n = rho >> 4, i = rho & 15; return 8 * (i >> 2) + 4 * n + (i & 3); }

struct Unit { int pm, pn; };
struct Gemm { const bf16_t* A; const bf16_t* Bt; int M, N, K; };

struct StaticOrder {
    int nM, nN, nwg, G, c;
    __host__ __device__ void init(int M, int N, int G_, int c_) { nM = M / BM; nN = N / BM; nwg = nM * nN; G = G_; c = c_; }
    __host__ __device__ bool next(int i, Unit& u) const {
        const long L = (long)i * G + c; if (L >= nwg) return false;
        int wgid = (int)L; { const int q = nwg / NXCD, r = nwg % NXCD, xcd = wgid % NXCD, off = wgid / NXCD; wgid = (xcd < r ? xcd * (q + 1) : r * (q + 1) + (xcd - r) * q) + off; }
        const int nig = WGM * nN, gid = wgid / nig, fm = gid * WGM, gsz = (nM - fm) < WGM ? (nM - fm) : WGM;
        u.pm = fm + ((wgid % nig) % gsz); u.pn = (wgid % nig) / gsz; return true;
    }
    __device__ __forceinline__ void a_ready(const Unit&) const {}
    __device__ __forceinline__ void done(const Unit&) const {}
};

__device__ __forceinline__ unsigned cvt_pk_bf16(float lo, float hi) { unsigned r; asm volatile("v_cvt_pk_bf16_f32 %0, %1, %2" : "=v"(r) : "v"(lo), "v"(hi)); return r; }
typedef float f32x2 __attribute__((ext_vector_type(2)));
__device__ __forceinline__ f32x2 gelu_pk(f32x2 v) {
    const f32x2 av = __builtin_elementwise_abs(v), d = av * 0.2316418882f + 1.0f;
    f32x2 t; t.x = __builtin_amdgcn_rcpf(d.x); t.y = __builtin_amdgcn_rcpf(d.y);
    f32x2 q = t * 0.5307027145f + (-0.7265760135f); q = q * t + 0.7107068705f; q = q * t + (-0.142248368f); q = q * t + 0.127414796f; q = q * t;
    const f32x2 s = (v * v) * (-0.72134752044f);
    f32x2 e; e.x = __builtin_amdgcn_exp2f(s.x); e.y = __builtin_amdgcn_exp2f(s.y);
    const f32x2 m = v * (q * e), r = v - m;
    f32x2 o; o.x = v.x < 0.f ? m.x : r.x; o.y = v.y < 0.f ? m.y : r.y; return o;
}

template <int ACT  > struct EpiBf16 {
    static constexpr bool PERM = true, AFTER_DRAIN = false; static_assert(ACT == 0 || ACT == 1, "EpiBf16: ACT is 0 (none) or 1 (gelu_pk)");
    bf16_t* O; int ldc; const float* bias; int split_cols; size_t split_stride; float scale0;
    __device__ __forceinline__ void operator()(const f32x4 (&acc)[2][2][4][2], const Unit& u, int wr, int wc, int fr, int fq) const {
        const int row0 = u.pm * BM + wr * 64 + fr; int colt = u.pn * BM; bf16_t* base = O;
        float sc = 1.f; if (split_cols) { const int t = colt / split_cols; base += (size_t)t * split_stride; colt -= t * split_cols; if (t == 0) sc = scale0; }
        const int col0 = colt + wc * 32 + 8 * fq, bcol0 = u.pn * BM + wc * 32 + 8 * fq;
        f32x4 bv[2][2];
#pragma unroll
        for (int bj = 0; bj < 2; ++bj)
#pragma unroll
            for (int n = 0; n < 2; ++n) bv[bj][n] = bias ? *(const f32x4*)(bias + bcol0 + bj * HALF + 4 * n) : (f32x4){0.f, 0.f, 0.f, 0.f};
#pragma unroll
        for (int ai = 0; ai < 2; ++ai)
#pragma unroll
            for (int m = 0; m < 4; ++m) { bf16_t* rowp = base + (size_t)(row0 + ai * HALF + m * 16) * ldc + col0;
#pragma unroll
                for (int bj = 0; bj < 2; ++bj) { f32x4 v0 = acc[ai][bj][m][0] + bv[bj][0], v1 = acc[ai][bj][m][1] + bv[bj][1];
                    if (ACT == 1) { f32x2 a = gelu_pk((f32x2){v0[0], v0[1]}), b = gelu_pk((f32x2){v0[2], v0[3]}), c = gelu_pk((f32x2){v1[0], v1[1]}), d = gelu_pk((f32x2){v1[2], v1[3]});
                        v0 = (f32x4){a.x, a.y, b.x, b.y}; v1 = (f32x4){c.x, c.y, d.x, d.y}; }
                    v0 = v0 * sc; v1 = v1 * sc; u32x4 w; w.x = cvt_pk_bf16(v0[0], v0[1]); w.y = cvt_pk_bf16(v0[2], v0[3]); w.z = cvt_pk_bf16(v1[0], v1[1]); w.w = cvt_pk_bf16(v1[2], v1[3]);
                    *(u32x4*)(rowp + bj * HALF) = w; } }
    }
};

template <class Epi, class Sched, bool ALIGN_EPI = false, bool SP2 = false>
__device__ __forceinline__ void gemm_phase(PG8_LAS unsigned char* lds, const Gemm g, const Sched& S, const Epi& E) {
    const int tid = mk_tid(), wid = __builtin_amdgcn_readfirstlane(tid >> 6), lane = tid & 63, wr = wid >> 2, wc = wid & 3, fr = lane & 15, fq = lane >> 4;
    const int K = g.K, nt = K / BK;
    unsigned voffA[2], voffB[2];
#pragma unroll
    for (int i = 0; i < 2; ++i) { int R, C; stage_rc(tid * 16 + i * 8192, R, C); const int Rb = Epi::PERM ? ((R & ~31) + perm32(R & 31)) : R;
        voffA[i] = (unsigned)(R * K + C) * 2u; voffB[i] = (unsigned)(Rb * K + C) * 2u; }
    const size_t kstep = (size_t)(BK * 2);
    const size_t hstep = (size_t)HALF * K * 2;
    const size_t tstep = 2 * hstep;
    const unsigned ldsw = (unsigned)wid * 1024u;
    const int aoff = lds_byte(wr * 64 + fr, fq * 8), boff = lds_byte(wc * 32 + fr, fq * 8);
#define PG8_SA(b, h) (((b) * 2 + (h)) * HTB)
#define PG8_SB(b, h) ((4 + (b) * 2 + (h)) * HTB)
#define PG8_STAGE(bufoff, gbase, voff) do { _Pragma("unroll") for (int _i = 0; _i < 2; ++_i) \
        __builtin_amdgcn_global_load_lds((const unsigned*)((const char*)(gbase) + (voff)[_i]), (PG8_LAS unsigned*)(lds + (bufoff) + ldsw + _i * 8192), 16, 0, 0); } while (0)
#define PG8_LDA(dst, b, h) do { _Pragma("unroll") for (int m = 0; m < 4; ++m) _Pragma("unroll") for (int k = 0; k < 2; ++k) dst[m][k] = *(const PG8_LAS bf16x8*)(lds + PG8_SA(b, h) + aoff + m * 2048 + k * 1024); } while (0)
#define PG8_LDB(dst, b, h) do { _Pragma("unroll") for (int n = 0; n < 2; ++n) _Pragma("unroll") for (int k = 0; k < 2; ++k) dst[n][k] = *(const PG8_LAS bf16x8*)(lds + PG8_SB(b, h) + boff + n * 2048 + k * 1024); } while (0)
#define PG8_MMA(ai, bj, At, Bt) do { __builtin_amdgcn_s_setprio(1); _Pragma("unroll") for (int m = 0; m < 4; ++m) _Pragma("unroll") for (int n = 0; n < 2; ++n) _Pragma("unroll") for (int k = 0; k < 2; ++k) \
        acc[ai][bj][m][n] = __builtin_amdgcn_mfma_f32_16x16x32_bf16(Bt[n][k], At[m][k], acc[ai][bj][m][n], 0, 0, 0); __builtin_amdgcn_s_setprio(0); } while (0)
#define PG8_WAIT_V(n) asm volatile("s_waitcnt vmcnt(" #n ")" ::: "memory")
#define PG8_WAIT_L(n) asm volatile("s_waitcnt lgkmcnt(" #n ")" ::: "memory")
#define PG8_BAR __builtin_amdgcn_s_barrier()
#define PG8_SCHED __builtin_amdgcn_sched_barrier(0)
    Unit cur, nxt; int ui = 0;
    if (!S.next(0, cur)) return;
    f32x4 acc[2][2][4][2];
#pragma unroll
    for (int a = 0; a < 2; ++a)
#pragma unroll
        for (int b = 0; b < 2; ++b)
#pragma unroll
            for (int m = 0; m < 4; ++m)
#pragma unroll
                for (int n = 0; n < 2; ++n) acc[a][b][m][n] = (f32x4){0.f, 0.f, 0.f, 0.f};
    bf16x8 At[4][2], B0[2][2], B1[2][2];
    const char* cA = (const char*)g.A + (size_t)cur.pm * tstep; const char* cB = (const char*)g.Bt + (size_t)cur.pn * tstep;
    S.a_ready(cur);
    if constexpr (SP2) {
        PG8_STAGE(PG8_SB(0, 0), cB, voffB); PG8_STAGE(PG8_SB(0, 1), cB + hstep, voffB); PG8_STAGE(PG8_SA(0, 0), cA, voffA); PG8_STAGE(PG8_SA(0, 1), cA + hstep, voffA);
        if (wr == 1) PG8_BAR;
        PG8_WAIT_V(2); PG8_BAR;
        PG8_STAGE(PG8_SB(1, 0), cB + kstep, voffB); PG8_STAGE(PG8_SA(1, 0), cA + kstep, voffA); PG8_STAGE(PG8_SB(1, 1), cB + hstep + kstep, voffB);
        PG8_WAIT_V(6); PG8_BAR;
    } else {
        PG8_STAGE(PG8_SB(0, 0), cB, voffB); PG8_STAGE(PG8_SA(0, 0), cA, voffA); PG8_STAGE(PG8_SB(0, 1), cB + hstep, voffB); PG8_STAGE(PG8_SA(0, 1), cA + hstep, voffA);
        if (wr == 1) PG8_BAR;
        PG8_WAIT_V(4); PG8_BAR;
        PG8_STAGE(PG8_SB(1, 0), cB + kstep, voffB); PG8_STAGE(PG8_SA(1, 0), cA + kstep, voffA); PG8_STAGE(PG8_SB(1, 1), cB + hstep + kstep, voffB);
        PG8_WAIT_V(6); PG8_BAR;
    }
    for (;;) {
        const bool has_next = S.next(ui + 1, nxt);
        const char* nA = has_next ? (const char*)g.A + (size_t)nxt.pm * tstep : cA; const char* nB = has_next ? (const char*)g.Bt + (size_t)nxt.pn * tstep : cB;
        for (int t = 0; t < nt; t += 2) {
            const bool last = (t == nt - 2);
            const char* a1 = cA + (size_t)(t + 1) * kstep;
            const char* a2 = last ? nA : cA + (size_t)(t + 2) * kstep; const char* b2 = last ? nB : cB + (size_t)(t + 2) * kstep;
            const char* a3 = a2 + kstep; const char* b3 = b2 + kstep;
            if (last && has_next) S.a_ready(nxt);
            if constexpr (SP2) {
            PG8_LDB(B0, 0, 0); PG8_LDB(B1, 0, 1); PG8_SCHED; PG8_LDA(At, 0, 0); PG8_STAGE(PG8_SA(1, 1), a1 + hstep, voffA);
            PG8_WAIT_V(8); PG8_WAIT_L(0); PG8_BAR; PG8_MMA(0, 0, At, B0); PG8_MMA(0, 1, At, B1); PG8_BAR; PG8_SCHED;
            PG8_LDA(At, 0, 1); PG8_STAGE(PG8_SB(0, 0), b2, voffB); PG8_STAGE(PG8_SB(0, 1), b2 + hstep, voffB); PG8_STAGE(PG8_SA(0, 0), a2, voffA);
            PG8_WAIT_V(8); PG8_WAIT_L(0); PG8_BAR; PG8_MMA(1, 0, At, B0); PG8_MMA(1, 1, At, B1); PG8_BAR; PG8_SCHED;
            PG8_LDB(B0, 1, 0); PG8_LDB(B1, 1, 1); PG8_SCHED; PG8_LDA(At, 1, 0); PG8_STAGE(PG8_SA(0, 1), a2 + hstep, voffA);
            PG8_WAIT_V(8); PG8_WAIT_L(0); PG8_BAR; PG8_MMA(0, 0, At, B0); PG8_MMA(0, 1, At, B1); PG8_BAR; PG8_SCHED;
            PG8_LDA(At, 1, 1); PG8_STAGE(PG8_SB(1, 0), b3, voffB); PG8_STAGE(PG8_SB(1, 1), b3 + hstep, voffB); PG8_STAGE(PG8_SA(1, 0), a3, voffA);
            PG8_WAIT_V(8); PG8_WAIT_L(0); PG8_BAR; PG8_MMA(1, 0, At, B0); PG8_MMA(1, 1, At, B1); PG8_BAR; PG8_SCHED;
            } else {
            PG8_LDB(B0, 0, 0); PG8_SCHED; PG8_LDA(At, 0, 0); PG8_STAGE(PG8_SA(1, 1), a1 + hstep, voffA);
            PG8_WAIT_L(8); PG8_BAR; PG8_WAIT_L(0); PG8_MMA(0, 0, At, B0); PG8_BAR; PG8_SCHED;
            PG8_LDB(B1, 0, 1); PG8_STAGE(PG8_SB(0, 0), b2, voffB);
            PG8_BAR; PG8_WAIT_L(0); PG8_MMA(0, 1, At, B1); PG8_BAR;
            PG8_LDA(At, 0, 1); PG8_STAGE(PG8_SA(0, 0), a2, voffA);
            PG8_BAR; PG8_WAIT_L(0); PG8_MMA(1, 0, At, B0); PG8_BAR; PG8_SCHED;
            PG8_STAGE(PG8_SB(0, 1), b2 + hstep, voffB);
            PG8_WAIT_V(6); PG8_BAR; PG8_MMA(1, 1, At, B1); PG8_BAR;
            PG8_LDB(B0, 1, 0); PG8_SCHED; PG8_LDA(At, 1, 0); PG8_STAGE(PG8_SA(0, 1), a2 + hstep, voffA);
            PG8_WAIT_L(8); PG8_BAR; PG8_WAIT_L(0); PG8_MMA(0, 0, At, B0); PG8_BAR; PG8_SCHED;
            PG8_LDB(B1, 1, 1); PG8_STAGE(PG8_SB(1, 0), b3, voffB);
            PG8_BAR; PG8_WAIT_L(0); PG8_MMA(0, 1, At, B1); PG8_BAR;
            PG8_LDA(At, 1, 1); PG8_STAGE(PG8_SA(1, 0), a3, voffA);
            PG8_BAR; PG8_WAIT_L(0); PG8_MMA(1, 0, At, B0); PG8_BAR; PG8_SCHED;
            PG8_STAGE(PG8_SB(1, 1), b3 + hstep, voffB);
            PG8_WAIT_V(6); PG8_BAR; PG8_MMA(1, 1, At, B1); PG8_BAR;
            }
        }
        if constexpr (ALIGN_EPI) { if (wr == 0) PG8_BAR; }
        if constexpr (!Epi::AFTER_DRAIN) { E(acc, cur, wr, wc, fr, fq); S.done(cur); }
        if (!has_next) break;
#pragma unroll
        for (int a = 0; a < 2; ++a)
#pragma unroll
            for (int b = 0; b < 2; ++b)
#pragma unroll
                for (int m = 0; m < 4; ++m)
#pragma unroll
                    for (int n = 0; n < 2; ++n) acc[a][b][m][n] = (f32x4){0.f, 0.f, 0.f, 0.f};
        cur = nxt; cA = nA; cB = nB; ++ui;
        if constexpr (ALIGN_EPI) { if (wr == 1) PG8_BAR; }
    }
    PG8_WAIT_V(0);
    if constexpr (!ALIGN_EPI) { if (wr == 0) PG8_BAR; }
    PG8_BAR;
    if constexpr (Epi::AFTER_DRAIN) { E.fused(acc, cur, wr, wc, fr, fq, lds, wid, lane); S.done(cur); }
#undef PG8_SA
#undef PG8_SB
#undef PG8_STAGE
#undef PG8_LDA
#undef PG8_LDB
#undef PG8_MMA
#undef PG8_WAIT_V
#undef PG8_WAIT_L
#undef PG8_BAR
#undef PG8_SCHED
}
}

namespace att {
constexpr int D = 128;
constexpr float THR = 8.f;
constexpr bool WSKIP = false;
constexpr float SCALE = 0.08838834764831845f;
constexpr int NW = 8, QBLK = 32, KVBLK = 64, QB = NW * QBLK;
constexpr int SHM_V = KVBLK * D * 2, SHM_K = KVBLK * D * 2;
constexpr int LDS_BYTES = 2 * SHM_V + 2 * SHM_K + NW * 64 * 4;

using bf16 = __hip_bfloat16;
typedef short bf16x8 __attribute__((ext_vector_type(8)));
typedef short s16x4 __attribute__((ext_vector_type(4)));
typedef float f32x16 __attribute__((ext_vector_type(16)));
typedef float f32x4 __attribute__((ext_vector_type(4)));
typedef unsigned u32x4 __attribute__((ext_vector_type(4)));
template <class A, class Bt> struct same_t { static constexpr bool v = false; };
template <class A> struct same_t<A, A> { static constexpr bool v = true; };

#define KSWZ(row, colB) ((row) * 256 + ((colB) ^ (((row) & 7) << 4)))
#define SBAR() __builtin_amdgcn_sched_barrier(0)
__device__ __forceinline__ int v_st(int k, int c) { const int kk = (k & ~0xC) | ((k & 4) << 1) | ((k & 8) >> 1); return ((kk >> 3) * 4 + (c >> 5)) * 512 + ((kk & 7) * 32 + (c & 31)) * 2; }
__device__ __forceinline__ int v_rd_base(int lane) { return ((lane & 3) << 3) | (((lane >> 2) & 3) << 6) | (((lane >> 4) & 1) << 5) | (((lane >> 5) & 1) << 8); }
constexpr int v_rd_off(int d0, int ks, int half) { return d0 * 512 + ks * 4096 + half * 2048; }
__device__ __forceinline__ int crow(int r, int hi) { return (r & 3) + 8 * (r >> 2) + 4 * hi; }
__device__ __forceinline__ unsigned cvtpk(float lo, float hi) {
    unsigned r; asm volatile("v_cvt_pk_bf16_f32 %0, %1, %2" : "=v"(r) : "v"(lo), "v"(hi)); return r;
}
__device__ __forceinline__ bf16x8 pack8(f32x4 a, f32x4 b) {
    u32x4 w = {cvtpk(a[0], a[1]), cvtpk(a[2], a[3]), cvtpk(b[0], b[1]), cvtpk(b[2], b[3])};
    return *reinterpret_cast<bf16x8*>(&w);
}
template <class T> __device__ __forceinline__ bf16x8 load8(const T* p) {
    if constexpr (same_t<T, float>::v) { return pack8(*(const f32x4*)p, *(const f32x4*)(p + 4)); }
    else { return *reinterpret_cast<const bf16x8*>(p); }
}
__device__ __forceinline__ void mask_tile(f32x16& p0, f32x16& p1, int dq, unsigned W) {
    const float NEG = -__builtin_inff();
#pragma unroll
    for (int r = 0; r < 16; ++r) {
        const int c = (r & 3) + 8 * (r >> 2);
        if ((unsigned)(dq - c) >= W) p0[r] = NEG;
        if ((unsigned)(dq - c - 32) >= W) p1[r] = NEG;
    }
}
__device__ __forceinline__ void partialSM(f32x16& p0, f32x16& p1, float& m_reg, float& mn, float& alpha) {
    float pmax = p0[0]; for (int r = 1; r < 16; ++r) pmax = fmaxf(pmax, p0[r]); for (int r = 0; r < 16; ++r) pmax = fmaxf(pmax, p1[r]);
    { auto rr = __builtin_amdgcn_permlane32_swap(__float_as_uint(pmax), __float_as_uint(pmax), false, false);
      pmax = fmaxf(__uint_as_float(rr[0]), __uint_as_float(rr[1])); }
    constexpr float C2 = 1.4426950408889634f * SCALE;
    if (__builtin_expect(__all((pmax - m_reg) * SCALE <= THR), 1)) { mn = m_reg; alpha = 1.f; }
    else { mn = fmaxf(m_reg, pmax); alpha = __builtin_amdgcn_exp2f((m_reg - mn) * C2); m_reg = mn; }
    const float mnL = -mn * C2;
    for (int r = 0; r < 16; ++r) p0[r] = fmaf(p0[r], C2, mnL); for (int r = 0; r < 16; ++r) p1[r] = fmaf(p1[r], C2, mnL);
    for (int r = 0; r < 16; ++r) p0[r] = __builtin_amdgcn_exp2f(p0[r]);
}
__device__ __forceinline__ void finishSM(f32x16& p0, f32x16& p1, float alpha, float& l_reg, bf16x8& pa0, bf16x8& pa1, bf16x8& pa2, bf16x8& pa3) {
    for (int r = 0; r < 16; ++r) p1[r] = __builtin_amdgcn_exp2f(p1[r]);
    float ps = 0; for (int r = 0; r < 16; ++r) ps += p0[r]; for (int r = 0; r < 16; ++r) ps += p1[r];
    { auto rr = __builtin_amdgcn_permlane32_swap(__float_as_uint(ps), __float_as_uint(ps), false, false);
      ps = __uint_as_float(rr[0]) + __uint_as_float(rr[1]); }
    l_reg = l_reg * alpha + ps;
#define PK4(P, B_, OUT) do { unsigned a0 = cvtpk(P[B_+0], P[B_+1]), a1 = cvtpk(P[B_+2], P[B_+3]);                          \
        unsigned b0 = cvtpk(P[B_+4], P[B_+5]), b1 = cvtpk(P[B_+6], P[B_+7]);                                             \
        auto r0 = __builtin_amdgcn_permlane32_swap(a0, b0, false, false); auto r1 = __builtin_amdgcn_permlane32_swap(a1, b1, false, false); \
        u32x4 w = {r0[0], r1[0], r0[1], r1[1]}; OUT = *reinterpret_cast<bf16x8*>(&w); } while (0)
    PK4(p0, 0, pa0); PK4(p0, 8, pa1); PK4(p1, 0, pa2); PK4(p1, 8, pa3);
#undef PK4
}
template <int KB, bool SK>
__device__ __forceinline__ void qkt(f32x16& p0, f32x16& p1, const char* K_lds, int r32, int hi, const bf16x8* qr, bool act) {
    if (SK && !act) { const float NEG = -__builtin_inff();
#pragma unroll
        for (int r = 0; r < 16; ++r) { p0[r] = NEG; p1[r] = NEG; } return; }
    p0 = f32x16{}; p1 = f32x16{};
    const char* kb[4];
#pragma unroll
    for (int dd = 0; dd < 4; ++dd) kb[dd] = K_lds + KB * SHM_K + KSWZ(r32, (dd * 16 + hi * 8) * 2);
#pragma unroll
    for (int d0 = 0; d0 < 8; ++d0) { const char* a = kb[d0 & 3] + (d0 >> 2) * 128;
        bf16x8 b0 = *reinterpret_cast<const bf16x8*>(a);
        bf16x8 b1 = *reinterpret_cast<const bf16x8*>(a + 32 * 256);
        p0 = __builtin_amdgcn_mfma_f32_32x32x16_bf16(b0, qr[d0], p0, 0, 0, 0);
        p1 = __builtin_amdgcn_mfma_f32_32x32x16_bf16(b1, qr[d0], p1, 0, 0, 0); }
}
template <int VB, bool SK>
__device__ __forceinline__ void pv_tile(f32x16* o, int vb0, bf16x8 pa0, bf16x8 pa1, bf16x8 pa2, bf16x8 pa3, bool act) {
    if (SK && !act) return;
#define TRRD(dst, off) asm volatile("ds_read_b64_tr_b16 %0, %1 offset:%2" : "=&v"(dst) : "v"(vb0), "i"(off) : "memory")
#define PV_D0(d0) do { s16x4 l0, l1, l2, l3, h0, h1, h2, h3; constexpr int b_ = VB * SHM_V + v_rd_off(d0, 0, 0);     \
        TRRD(l0, b_); TRRD(h0, b_ + 2048); TRRD(l1, b_ + 4096); TRRD(h1, b_ + 6144); TRRD(l2, b_ + 8192); TRRD(h2, b_ + 10240); TRRD(l3, b_ + 12288); TRRD(h3, b_ + 14336); \
        asm volatile("s_waitcnt lgkmcnt(0)" ::: "memory"); SBAR();                 \
        o[d0] = __builtin_amdgcn_mfma_f32_32x32x16_bf16(pa0, (bf16x8){l0[0], l0[1], l0[2], l0[3], h0[0], h0[1], h0[2], h0[3]}, o[d0], 0, 0, 0);   \
        o[d0] = __builtin_amdgcn_mfma_f32_32x32x16_bf16(pa1, (bf16x8){l1[0], l1[1], l1[2], l1[3], h1[0], h1[1], h1[2], h1[3]}, o[d0], 0, 0, 0);   \
        o[d0] = __builtin_amdgcn_mfma_f32_32x32x16_bf16(pa2, (bf16x8){l2[0], l2[1], l2[2], l2[3], h2[0], h2[1], h2[2], h2[3]}, o[d0], 0, 0, 0);   \
        o[d0] = __builtin_amdgcn_mfma_f32_32x32x16_bf16(pa3, (bf16x8){l3[0], l3[1], l3[2], l3[3], h3[0], h3[1], h3[2], h3[3]}, o[d0], 0, 0, 0); } while (0)
    PV_D0(0); PV_D0(1); PV_D0(2); PV_D0(3);
#undef PV_D0
#undef TRRD
}

template <class TIn, class TOut> struct BlockRef { const TIn* Q; const TIn* K; const TIn* V; TOut* O; int P0; };
template <class TIn> struct Seam {
    bf16x8 qr[8];
    bf16x8 st_v0, st_v1, st_k0, st_k1; f32x4 sf0, sf1, sf2, sf3;
    f32x4 tq[16];
};
__device__ __forceinline__ int swa_jlo(int P0, int W) { const int lowk = P0 - W + 1; return lowk > 0 ? lowk / KVBLK : 0; }
#define ROW(p, k0, rr) ((p) + (size_t)((k0) + (rr)) * D + sc)
#define VMW() asm volatile("s_waitcnt vmcnt(0)" ::: "memory")
#define VMWN(n) asm volatile("s_waitcnt vmcnt(%0)" :: "i"(n) : "memory")
#define SLOAD_H(Kp, Vp, k0) do { S.st_v0 = load8<TIn>(ROW(Vp, k0, sr)); S.st_v1 = load8<TIn>(ROW(Vp, k0, 32 + sr));              \
                         S.st_k0 = load8<TIn>(ROW(Kp, k0, sr)); S.st_k1 = load8<TIn>(ROW(Kp, k0, 32 + sr)); } while (0)
#define SWRITE_HK(bf) do { *(bf16x8*)(K_lds + (bf) * SHM_K + kws) = S.st_k0; *(bf16x8*)(K_lds + (bf) * SHM_K + kws + 32 * 256) = S.st_k1; } while (0)
#define SWRITE_HV(bf) do { *(bf16x8*)(V_lds + (bf) * SHM_V + vst0) = S.st_v0; *(bf16x8*)(V_lds + (bf) * SHM_V + vst1) = S.st_v1; } while (0)
#define SWRITE_H(bf) do { SWRITE_HV(bf); SWRITE_HK(bf); } while (0)
#define SLOAD_F(p, k0) do { S.sf0 = *(const f32x4*)ROW(p, k0, sr); S.sf1 = *(const f32x4*)(ROW(p, k0, sr) + 4);                \
                            S.sf2 = *(const f32x4*)ROW(p, k0, 32 + sr); S.sf3 = *(const f32x4*)(ROW(p, k0, 32 + sr) + 4); } while (0)
#define SWRITE_KF(bf) do { *(bf16x8*)(K_lds + (bf) * SHM_K + kws) = pack8(S.sf0, S.sf1); *(bf16x8*)(K_lds + (bf) * SHM_K + kws + 32 * 256) = pack8(S.sf2, S.sf3); } while (0)
#define SWRITE_VF(bf) do { *(bf16x8*)(V_lds + (bf) * SHM_V + vst0) = pack8(S.sf0, S.sf1); *(bf16x8*)(V_lds + (bf) * SHM_V + vst1) = pack8(S.sf2, S.sf3); } while (0)
template <class TIn, class TOut>
__device__ __forceinline__ void causal_swa_prime(const BlockRef<TIn, TOut>& cur, int W, char* lds, Seam<TIn>& S) {
    constexpr bool F32 = same_t<TIn, float>::v;
    const int tid = mk_tid(), wid = __builtin_amdgcn_readfirstlane(tid >> 6), lane = tid & 63, r32 = lane & 31, hi = lane >> 5;
    const int sr = tid >> 4, sc = (tid & 15) * 8, kws = KSWZ(sr, sc * 2); char* K_lds = lds + 2 * SHM_V;
    const int kb0 = swa_jlo(cur.P0, W) * KVBLK;
    for (int d0 = 0; d0 < 8; ++d0) S.qr[d0] = load8<TIn>(cur.Q + (size_t)(wid * QBLK + r32) * D + d0 * 16 + hi * 8);
    if constexpr (F32) { SLOAD_F((const float*)cur.K, kb0); VMW(); SWRITE_KF(0); SBAR(); SLOAD_F((const float*)cur.V, kb0); }
    else { SLOAD_H(cur.K, cur.V, kb0); VMW(); SWRITE_HK(0); }
    __syncthreads();
}
template <class TIn, class TOut>
__device__ __forceinline__ void causal_swa_block(const BlockRef<TIn, TOut>& cur, const BlockRef<TIn, TOut>& nxt, int skv, int W, char* lds, Seam<TIn>& S) {
    constexpr bool F32 = same_t<TIn, float>::v;
    const int tid = mk_tid(), wid = __builtin_amdgcn_readfirstlane(tid >> 6), lane = tid & 63, r32 = lane & 31, hi = lane >> 5;
    const int j_lo = swa_jlo(cur.P0, W);
    int j_hi = (cur.P0 + QB - 1) / KVBLK + 1; if (j_hi > skv / KVBLK) j_hi = skv / KVBLK;
    const int NT = j_hi - j_lo;
    const int kbn = swa_jlo(nxt.P0, W) * KVBLK;
    const int qlo = cur.P0 + wid * QBLK, qm = qlo + r32 - 4 * hi;
    char* V_lds = lds; char* K_lds = lds + 2 * SHM_V;
    float* ws = (float*)(lds + 2 * SHM_V + 2 * SHM_K) + wid * 64; float* li_l = ws, * al_l = ws + 32;
    float m_reg = -1e30f, l_reg = 0; f32x16 o[4] = {};
    const int sr = tid >> 4, sc = (tid & 15) * 8, vst0 = v_st(sr, sc), vst1 = v_st(32 + sr, sc), kws = KSWZ(sr, sc * 2);
    const int vb0 = (int)(uintptr_t)V_lds + v_rd_base(lane);
    const TIn* Kh = cur.K; const TIn* Vh = cur.V;
#define RESC(a) do { if (__any((a) < 1.f)) { if (hi == 0) al_l[r32] = (a); asm volatile("s_waitcnt lgkmcnt(0)" ::: "memory");              \
                     for (int d_ = 0; d_ < 4; ++d_) for (int r = 0; r < 16; ++r) o[d_][r] *= al_l[crow(r, hi)]; } } while (0)
#define KBASE(t) ((j_lo + (t)) * KVBLK)
#define ACT(t) (KBASE(t) <= qlo + QBLK - 1 && KBASE(t) + KVBLK - 1 >= qlo - W + 1)
#define MASKT(P0_, P1_, t) do { const int kb_ = KBASE(t); if ((!SK || ACT(t)) && (kb_ + KVBLK - 1 > qlo || kb_ <= qlo + QBLK - 1 - W)) mask_tile(P0_, P1_, qm - kb_, (unsigned)W); } while (0)
    constexpr int NQL = F32 ? 16 : 8;
    constexpr bool SK = WSKIP && !F32;
#define SEAM_K0() do { VMWN(NQL); if constexpr (F32) { SWRITE_KF(0); SBAR(); SLOAD_F((const float*)nxt.V, kbn); } else { SWRITE_HK(0); } SBAR(); } while (0)
    f32x16 pA0, pA1, pB0, pB1; float mnA, mnB, alA, alB; bf16x8 pa0, pa1, pa2, pa3;
    if constexpr (F32) { VMW(); SWRITE_VF(0); SBAR(); } else { SWRITE_HV(0); SBAR(); }
    if (NT > 1) { if constexpr (F32) SLOAD_F((const float*)Kh, KBASE(1)); else SLOAD_H(Kh, Vh, KBASE(1)); }
    SBAR(); qkt<0, SK>(pA0, pA1, K_lds, r32, hi, S.qr, ACT(0));
    if constexpr (F32) { if (NT > 1) { VMW(); SWRITE_KF(1); SBAR(); SLOAD_F((const float*)Vh, KBASE(1)); } }
    MASKT(pA0, pA1, 0); partialSM(pA0, pA1, m_reg, mnA, alA);
    if (NT > 1) { VMW(); if constexpr (F32) { SWRITE_VF(1); SBAR(); if (NT > 2) SLOAD_F((const float*)Kh, KBASE(2)); } else SWRITE_H(1); }
    __syncthreads();
#define HALF_STEP(PX0, PX1, mnX, alX, PY0, PY1, alY, t, KB, VB, SB) do {                                                      \
        SBAR(); qkt<KB, SK>(PX0, PX1, K_lds, r32, hi, S.qr, ACT(t));                                             \
        finishSM(PY0, PY1, alY, l_reg, pa0, pa1, pa2, pa3); SBAR();                                                           \
        if ((t) + 1 < NT) { if constexpr (F32) { VMW(); SWRITE_KF(SB); SBAR(); SLOAD_F((const float*)Vh, KBASE((t) + 1)); }  \
                            else { SLOAD_H(Kh, Vh, KBASE((t) + 1)); } SBAR(); }                                               \
        pv_tile<VB, SK>(o, vb0, pa0, pa1, pa2, pa3, ACT((t) - 1)); MASKT(PX0, PX1, (t)); partialSM(PX0, PX1, m_reg, mnX, alX);                                        \
        __syncthreads();                                                                                                      \
        if ((t) + 1 < NT) { VMW(); if constexpr (F32) { SWRITE_VF(SB); SBAR(); if ((t) + 2 < NT) SLOAD_F((const float*)Kh, KBASE((t) + 2)); } \
                            else { SWRITE_H(SB); } }                                                                          \
        RESC(alX); __syncthreads(); } while (0)
    for (int t = 1; t + 1 < NT; t += 2) {
        HALF_STEP(pB0, pB1, mnB, alB, pA0, pA1, alA, t, 1, 0, 0);
        HALF_STEP(pA0, pA1, mnA, alA, pB0, pB1, alB, t + 1, 0, 1, 1);
    }
    const bool even = (NT & 1) == 0;
    if (even) { SBAR(); qkt<1, SK>(pB0, pB1, K_lds, r32, hi, S.qr, ACT(NT - 1)); SBAR(); }
#define QROW(e) (nxt.Q + (size_t)(wid * QBLK + r32) * D + ((e) >> 1) * 16 + hi * 8 + ((e) & 1) * 4)
    if constexpr (F32) { SLOAD_F((const float*)nxt.K, kbn); SBAR();
#pragma unroll
        for (int e = 0; e < 8; ++e) S.tq[e] = *(const f32x4*)QROW(e); }
    else { SLOAD_H(nxt.K, nxt.V, kbn); SBAR();
#pragma unroll
        for (int d0 = 0; d0 < 8; ++d0) S.qr[d0] = load8<TIn>(nxt.Q + (size_t)(wid * QBLK + r32) * D + d0 * 16 + hi * 8); }
    SBAR();
    finishSM(pA0, pA1, alA, l_reg, pa0, pa1, pa2, pa3); SBAR();
    if constexpr (F32) {
#pragma unroll
        for (int e = 8; e < 16; ++e) S.tq[e] = *(const f32x4*)QROW(e); SBAR(); }
#undef QROW
    pv_tile<0, SK>(o, vb0, pa0, pa1, pa2, pa3, ACT(even ? NT - 2 : NT - 1));
    if (even) { MASKT(pB0, pB1, NT - 1); partialSM(pB0, pB1, m_reg, mnB, alB); __syncthreads(); RESC(alB);
        finishSM(pB0, pB1, alB, l_reg, pa0, pa1, pa2, pa3); SBAR(); pv_tile<1, SK>(o, vb0, pa0, pa1, pa2, pa3, ACT(NT - 1)); }
    SBAR(); SEAM_K0();
    if (hi == 0) li_l[r32] = l_reg; asm volatile("s_waitcnt lgkmcnt(0)" ::: "memory");
    float rli[16];
#pragma unroll
    for (int r = 0; r < 16; ++r) rli[r] = __builtin_amdgcn_rcpf(li_l[crow(r, hi)]);
    TOut* Ow = cur.O + (size_t)(wid * QBLK) * D;
#pragma unroll
    for (int r = 0; r < 16; ++r) { const int orow = crow(r, hi);
#pragma unroll
        for (int d0 = 0; d0 < 4; ++d0) { const float v = o[d0][r] * rli[r];
            if constexpr (same_t<TOut, float>::v) { Ow[(size_t)orow * D + d0 * 32 + r32] = v; }
            else { const float vn = __shfl_xor(v, 1);
                   if ((r32 & 1) == 0) *(unsigned*)(Ow + (size_t)orow * D + d0 * 32 + r32) = cvtpk(v, vn); } } }
    if constexpr (F32) {
#pragma unroll
        for (int d0 = 0; d0 < 8; ++d0) S.qr[d0] = pack8(S.tq[2 * d0], S.tq[2 * d0 + 1]); }
    __syncthreads();
#undef RESC
#undef KBASE
#undef ACT
#undef MASKT
#undef SEAM_K0
#undef HALF_STEP
}
#undef ROW
#undef VMW
#undef VMWN
#undef SLOAD_H
#undef SWRITE_HK
#undef SWRITE_HV
#undef SWRITE_H
#undef SLOAD_F
#undef SWRITE_KF
#undef SWRITE_VF
}

#define GAS __attribute__((address_space(1)))
#define LAS __attribute__((address_space(3)))
typedef unsigned short bf16r;
typedef float f4 __attribute__((ext_vector_type(4)));
typedef unsigned u4 __attribute__((ext_vector_type(4)));
typedef unsigned u2 __attribute__((ext_vector_type(2)));
typedef short s8v __attribute__((ext_vector_type(8)));

constexpr int TOK = 8192, DM = 2048;
constexpr float EPS = 1e-6f;
constexpr size_t MiB = 1u << 20;
constexpr size_t WS_WIN = 0;
constexpr size_t WS_WOUT0 = 32 * MiB, WS_WG0 = 40 * MiB, WS_WPP0 = 48 * MiB;
constexpr size_t WS_ROPE = 49 * MiB;
constexpr size_t WS_IFG = 53 * MiB;
constexpr size_t WS_BCUM = WS_IFG + 256 * 1024;
constexpr size_t WS_NLOC = WS_BCUM + 128 * 1024;
constexpr size_t WS_NPREV = WS_NLOC + 128 * 1024;
constexpr size_t WS_MSC = WS_NPREV + 128 * 1024;
constexpr size_t WS_SSQA = 54 * MiB, WS_SSQB = 55 * MiB, WS_SSQC = 56 * MiB, WS_LNS = 57 * MiB, WS_LNQ = 58 * MiB;
constexpr size_t WS_H = 60 * MiB;
constexpr size_t WS_PB = 92 * MiB;
constexpr size_t WS_G1 = 100 * MiB;
constexpr size_t WS_MLQK = WS_G1, WS_MLV = WS_G1 + 16 * MiB, WS_MLO = WS_G1 + 32 * MiB, WS_MLZ = WS_G1 + 48 * MiB, WS_DAZ = WS_G1 + 64 * MiB,
                 WS_DAQ = WS_G1 + 80 * MiB, WS_DAK = WS_G1 + 96 * MiB, WS_DAV = WS_G1 + 112 * MiB;
constexpr size_t WS_PP0 = 228 * MiB;
constexpr size_t WS_CPREV = WS_DAQ;
constexpr size_t WS_AO = WS_DAK;
constexpr size_t WS_WCIN = 100 * MiB, WS_WCOUT = 124 * MiB, WS_WG1 = 132 * MiB, WS_WPP1 = 140 * MiB;
constexpr size_t WS_X2B = 141 * MiB;
constexpr size_t WS_PP1 = 205 * MiB;
constexpr size_t WS_V = WS_H, WS_MB = 0, WS_X1B = WS_H, WS_X3B = WS_H, WS_DAO = WS_H, WS_CLOC = 0;
constexpr size_t WS_END = 260 * MiB;
constexpr int LDS_BYTES = 147456;
constexpr size_t WS_BAR = 59 * MiB;
constexpr int LDS_BARST = 147440;

struct Args { const void* in[27]; float* out; unsigned char* ws; int ph_lo, ph_hi; };
__device__ __forceinline__ unsigned long long karg64(int off) {
    unsigned long long r;
    asm volatile("s_load_dwordx2 %0, %1, %2\n\ts_waitcnt lgkmcnt(0)" : "=s"(r) : "s"(__builtin_amdgcn_kernarg_segment_ptr()), "n"(off) : "memory");
    return r;
}
#define KIN(a_, k) (a_).in[k] = (const void*)(GAS const void*)karg64(8 * (k))
#define KOUT(a_) (a_).out = (float*)(GAS float*)karg64(216)
#define KWS(a_) (a_).ws = (unsigned char*)(GAS unsigned char*)karg64(224)

__device__ __forceinline__ unsigned pk2(float lo, float hi) { return pg8::cvt_pk_bf16(lo, hi); }
__device__ __forceinline__ float bflo(unsigned w) { return __uint_as_float(w << 16); }
__device__ __forceinline__ float bfhi(unsigned w) { return __uint_as_float(w & 0xffff0000u); }
__device__ __forceinline__ float wave_sum(float v) {
#pragma unroll
    for (int o = 1; o < 64; o <<= 1) v += __shfl_xor(v, o);
    return v;
}
__device__ __forceinline__ float sigm(float x) { return __builtin_amdgcn_rcpf(1.f + __expf(-x)); }
__device__ __forceinline__ float silu(float x) { return x * __builtin_amdgcn_rcpf(1.f + __expf(-x)); }
#define LDS_WAIT() asm volatile("s_waitcnt lgkmcnt(0)" ::: "memory")

__device__ __forceinline__ int ropeperm(int r) { const int blk = r & ~127, p = r & 127; return blk + 64 * ((p >> 2) & 1) + 16 * (p >> 5) + 4 * ((p >> 3) & 3) + (p & 3); }
__device__ __forceinline__ int win_src_col(int nd) {
    const int seg = nd >> 10, r = nd & 1023;
    if (seg < 2) return nd;
    if (seg == 2) return 2056 + r;
    if (seg == 3) return 3080 + r;
    if (seg == 4) return 4104 + ropeperm(r);
    if (seg == 5) return 5128 + ropeperm(r);
    if (seg == 6) return 6152 + r;
    return 7176 + r;
}
template <bool WINMAP>
__device__ __forceinline__ void transpose_item(const float* W, int K, int Nsrc, int Ndst, const float* gs, bf16r* WT, LAS unsigned* scr, int item, int lane) {
    const int nblk = Ndst >> 6, kb = item / nblk, nb = item - kb * nblk, k0 = kb * 64, n0 = nb * 64;
    const int nd = n0 + lane; const int src = WINMAP ? win_src_col(nd) : nd;
    const float* wp = W + (size_t)k0 * Nsrc + src;
    float v[64];
#pragma unroll
    for (int i = 0; i < 64; ++i) v[i] = __builtin_nontemporal_load(wp + (size_t)i * Nsrc);
    if (gs) {
#pragma unroll
        for (int i = 0; i < 64; ++i) v[i] *= gs[k0 + i];
    }
#pragma unroll
    for (int c = 0; c < 8; ++c) { u4 o; o.x = pk2(v[8 * c], v[8 * c + 1]); o.y = pk2(v[8 * c + 2], v[8 * c + 3]); o.z = pk2(v[8 * c + 4], v[8 * c + 5]); o.w = pk2(v[8 * c + 6], v[8 * c + 7]); *(LAS u4*)(scr + lane * 36 + 4 * c) = o; }
    LDS_WAIT();
    bf16r* op = WT + (size_t)(n0 + (lane >> 3)) * K + k0 + 8 * (lane & 7);
#pragma unroll
    for (int j = 0; j < 8; ++j) *(u4*)(op + (size_t)(8 * j) * K) = *(const LAS u4*)(scr + ((lane >> 3) + 8 * j) * 36 + 4 * (lane & 7));
    LDS_WAIT();
}

template <int PARTS = 7>
__device__ __forceinline__ void phase0(const Args& a, LAS unsigned char* lds, int tid, int lane, int wave, int G) {
    const float* x = (const float*)a.in[0]; const float* Win = (const float*)a.in[4]; const float* gn = (const float*)a.in[3];
    unsigned char* ws = a.ws;
    LAS float* wif = (LAS float*)lds;
    if (PARTS & 1) for (int k = tid; k < 2048; k += 512) { const f4 w0 = *(const f4*)(Win + (size_t)k * 8200 + 2048), w1 = *(const f4*)(Win + (size_t)k * 8200 + 2052); const float g = gn[k];
        wif[k] = w0.x * g; wif[2048 + k] = w0.y * g; wif[4096 + k] = w0.z * g; wif[6144 + k] = w0.w * g; wif[8192 + k] = w1.x * g; wif[10240 + k] = w1.y * g; wif[12288 + k] = w1.z * g; wif[14336 + k] = w1.w * g; }
    __syncthreads();
    const int gw = blockIdx.x * 8 + wave, NGW = G * 8;
    bf16r* H = (bf16r*)(ws + WS_H); float* IFG = (float*)(ws + WS_IFG);
    const float* ib = (const float*)a.in[7]; const float* fb = (const float*)a.in[8];
    f4 vnx[8];
    if (PARTS & 1) { const f4* xr0 = (const f4*)(x + (size_t)(gw < TOK ? gw : 0) * DM) + lane;
#pragma unroll
        for (int j = 0; j < 8; ++j) vnx[j] = __builtin_nontemporal_load(xr0 + 64 * j); }
    if (PARTS & 1) for (int m = gw; m < TOK; m += NGW) {
        f4 v[8]; float s = 0.f;
#pragma unroll
        for (int j = 0; j < 8; ++j) { v[j] = vnx[j]; s += (v[j].x * v[j].x + v[j].y * v[j].y) + (v[j].z * v[j].z + v[j].w * v[j].w); }
        { const int mn = m + NGW < TOK ? m + NGW : m; const f4* xr = (const f4*)(x + (size_t)mn * DM) + lane;
#pragma unroll
          for (int j = 0; j < 8; ++j) vnx[j] = __builtin_nontemporal_load(xr + 64 * j); }
        const float rstd = rsqrtf(wave_sum(s) * (1.f / DM) + EPS);
        u2* hp = (u2*)(H + (size_t)m * DM) + lane;
        float acc[8];
#pragma unroll
        for (int c = 0; c < 8; ++c) acc[c] = 0.f;
#pragma unroll
        for (int j = 0; j < 8; ++j) { const f4 g = *((const f4*)gn + lane + 64 * j); const f4 hv = v[j] * rstd * g; hp[64 * j] = (u2){pk2(hv.x, hv.y), pk2(hv.z, hv.w)};
#pragma unroll
            for (int c = 0; c < 8; ++c) { const f4 w = *(const LAS f4*)(wif + c * 2048 + 4 * lane + 256 * j); acc[c] += (v[j].x * w.x + v[j].y * w.y) + (v[j].z * w.z + v[j].w * w.w); } }
#pragma unroll
        for (int c = 0; c < 8; ++c) acc[c] = wave_sum(acc[c]) * rstd;
        float val = acc[0];
#pragma unroll
        for (int c = 1; c < 8; ++c) if (lane == c) val = acc[c];
        if (lane < 4) IFG[(size_t)m * 8 + lane] = val + ib[lane];
        else if (lane < 8) { const float xf = val + fb[lane - 4]; IFG[(size_t)m * 8 + lane] = fminf(xf, 0.f) - log1pf(expf(-fabsf(xf))); }
    }
    LAS unsigned* scr = (LAS unsigned*)(lds + 65536 + wave * 9216);
    constexpr int I_WIN = 32 * 128, I_SQ = 32 * 32, I_PP = 4 * 32, I_G0A = I_SQ - 128;
    if (PARTS & 2) for (int it = gw; it < I_WIN + I_SQ + I_G0A + I_PP; it += NGW) {
        int r = it;
        if (r < I_WIN) { transpose_item<true>(Win, 2048, 8200, 8192, nullptr, (bf16r*)(ws + WS_WIN), scr, r, lane); continue; } r -= I_WIN;
        if (r < I_SQ) { transpose_item<false>((const float*)a.in[15], 2048, 2048, 2048, nullptr, (bf16r*)(ws + WS_WOUT0), scr, r, lane); continue; } r -= I_SQ;
        if (r < I_G0A) { transpose_item<false>((const float*)a.in[24], 2048, 2048, 2048, (const float*)a.in[23], (bf16r*)(ws + WS_WG0), scr, r, lane); continue; } r -= I_G0A;
        transpose_item<false>((const float*)a.in[25], 256, 2048, 2048, nullptr, (bf16r*)(ws + WS_WPP0), scr, r, lane);
    }
    constexpr int NITEMS0 = 32 * 128 + 2 * 32 * 32 + 4 * 32 - 128;
    const int NX = NITEMS0 % NGW;
    if ((PARTS & 4) && gw >= NX) { const int gt = (gw - NX) * 64 + lane, NT = (NGW - NX) * 64;
        const f4* p4 = (const f4*)a.in[1]; u2* pb = (u2*)(ws + WS_PB);
        for (int e0 = gt; e0 < 2 * TOK * 256 / 4; e0 += 4 * NT) { f4 v[4];
#pragma unroll
            for (int k = 0; k < 4; ++k) { const int e = e0 + k * NT; v[k] = __builtin_nontemporal_load(p4 + (e < 2 * TOK * 256 / 4 ? e : e0)); }
#pragma unroll
            for (int k = 0; k < 4; ++k) { const int e = e0 + k * NT; if (e < 2 * TOK * 256 / 4) pb[e] = (u2){pk2(v[k].x, v[k].y), pk2(v[k].z, v[k].w)}; } }
        const int* pos = (const int*)a.in[2]; float2* rt = (float2*)(ws + WS_ROPE);
        for (int e = gt; e < TOK * 64; e += NT) { const int tok = e >> 6, j = e & 63; const float freq = exp2f(-(float)j * (13.287712379549449f / 64.f));
            const float ang = (float)pos[tok] * freq; float sn, cs; sincosf(ang, &sn, &cs); rt[e] = make_float2(cs, sn); } }
}

__device__ __forceinline__ void l1_weights(const Args& a, LAS unsigned char* lds, int lane, int wave, int G) {
    unsigned char* ws = a.ws; const int gw = blockIdx.x * 8 + wave, NGW = G * 8;
    LAS unsigned* scr = (LAS unsigned*)(lds + wave * 9216);
    constexpr int I_CIN = 32 * 96, I_SQ = 32 * 32, I_PP = 4 * 32;
    for (int it = gw; it < I_CIN + 2 * I_SQ + I_PP + 128; it += NGW) {
        int r = it;
        if (r < 128) { transpose_item<false>((const float*)a.in[24], 2048, 2048, 2048, (const float*)a.in[23], (bf16r*)(ws + WS_WG0), scr, I_SQ - 128 + r, lane); continue; } r -= 128;
        if (r < I_CIN) { transpose_item<false>((const float*)a.in[17], 2048, 6144, 6144, (const float*)a.in[16], (bf16r*)(ws + WS_WCIN), scr, r, lane); continue; } r -= I_CIN;
        if (r < I_SQ) { transpose_item<false>((const float*)a.in[22], 2048, 2048, 2048, nullptr, (bf16r*)(ws + WS_WCOUT), scr, r, lane); continue; } r -= I_SQ;
        if (r < I_SQ) { transpose_item<false>((const float*)a.in[24] + (size_t)2048 * 2048, 2048, 2048, 2048, (const float*)a.in[23] + 2048, (bf16r*)(ws + WS_WG1), scr, r, lane); continue; } r -= I_SQ;
        transpose_item<false>((const float*)a.in[25] + (size_t)256 * 2048, 256, 2048, 2048, nullptr, (bf16r*)(ws + WS_WPP1), scr, r, lane);
    }
}

#define XB_TMO      128
#define XB_XCNT(j)  (256  + 64 * (j))
#define XB_XSUB(j)  (1280 + 64 * (j))
#define XB_XGEN(j)  (2304 + 64 * (j))
#define XB_TOP      3328
#define XB_TOPGEN   3392
#define XCD_BAR_WORDS 3456
#define XB_SPIN_CAP (1u << 18)

__device__ __forceinline__ unsigned xb_ld(unsigned* p)              { return __hip_atomic_load(p, __ATOMIC_RELAXED, __HIP_MEMORY_SCOPE_AGENT); }
__device__ __forceinline__ unsigned xb_add(unsigned* p, unsigned v) { return __hip_atomic_fetch_add(p, v, __ATOMIC_RELAXED, __HIP_MEMORY_SCOPE_AGENT); }
__device__ __forceinline__ unsigned xb_xcc_id() { return (unsigned)__builtin_amdgcn_s_getreg((3 << 11) | 20) & 0xFu; }
#define XB_SPIN(cond, bar) do { unsigned _sp = 0; while (cond) { __builtin_amdgcn_s_sleep(1); \
    if ((++_sp & 255u) == 0u) { if (xb_ld(&(bar)[XB_TMO])) break; if (_sp > XB_SPIN_CAP) { atomicAdd(&(bar)[XB_TMO], 1u); break; } } } } while (0)

struct XcdBarrier {
    unsigned* bar; unsigned x;
    volatile LAS unsigned* st;
};

__device__ __forceinline__ XcdBarrier xcd_barrier_post(unsigned* bar, volatile LAS unsigned* st) {
    XcdBarrier b; b.bar = bar; b.x = xb_xcc_id(); b.st = st;
    if (threadIdx.x == 0) (void)xb_add(&bar[XB_XCNT(b.x)], 1u);
    return b;
}
__device__ __forceinline__ void xcd_barrier_complete(unsigned* bar, unsigned x, unsigned& nloc, unsigned& nx) {
    const unsigned G = gridDim.x * gridDim.y * gridDim.z;
    unsigned sum, cnt, mine, sp = 0u;
    for (;;) {
        sum = 0u; cnt = 0u; mine = 0u;
#pragma unroll
        for (unsigned j = 0; j < 16; ++j) { const unsigned c = xb_ld(&bar[XB_XCNT(j)]); sum += c; cnt += (c > 0u) ? 1u : 0u; mine = (j == x) ? c : mine; }
        if (sum == G) break;
        __builtin_amdgcn_s_sleep(1);
        if ((++sp & 255u) == 0u) { if (xb_ld(&bar[XB_TMO])) break; if (sp > XB_SPIN_CAP) { atomicAdd(&bar[XB_TMO], 1u); break; } }
    }
    nloc = mine > 0u ? mine : 1u; nx = cnt > 0u ? cnt : 1u;
}

__device__ __forceinline__ void xcd_barrier(const XcdBarrier& b) {
    asm volatile("s_waitcnt vmcnt(0)" ::: "memory");
    __syncthreads();
    if (threadIdx.x == 0) {
        unsigned* bar = b.bar;
        __builtin_amdgcn_s_waitcnt(0);
        unsigned nloc = b.st[0], nx = b.st[1];
        if (nloc == 0u) { xcd_barrier_complete(bar, b.x, nloc, nx); b.st[0] = nloc; b.st[1] = nx; }
        const unsigned old = xb_add(&bar[XB_XSUB(b.x)], 1u);
        const unsigned gen = old / nloc;
        if (old + 1u == (gen + 1u) * nloc) {
            __builtin_amdgcn_fence(__ATOMIC_RELEASE, "agent");
            asm volatile("s_waitcnt vmcnt(0)" ::: "memory");
            const unsigned og = xb_add(&bar[XB_TOP], 1u);
            const unsigned tg = og / nx;
            if (og + 1u == (tg + 1u) * nx) xb_add(&bar[XB_TOPGEN], 1u);
            else XB_SPIN(xb_ld(&bar[XB_TOPGEN]) == tg, bar);
            __builtin_amdgcn_fence(__ATOMIC_ACQUIRE, "agent");
            xb_add(&bar[XB_XGEN(b.x)], 1u);
            asm volatile("s_waitcnt vmcnt(0)" ::: "memory");
        } else {
            XB_SPIN(xb_ld(&bar[XB_XGEN(b.x)]) == gen, bar);
            __builtin_amdgcn_fence(__ATOMIC_ACQUIRE, "agent");
            asm volatile("s_waitcnt vmcnt(0)" ::: "memory");
        }
    }
    __syncthreads();
}


using pg8::Unit;
typedef pg8::f32x4 accv;

__device__ __forceinline__ u4 pack8(const accv& a, const accv& b) { u4 w; w.x = pk2(a[0], a[1]); w.y = pk2(a[2], a[3]); w.z = pk2(b[0], b[1]); w.w = pk2(b[2], b[3]); return w; }
__device__ __forceinline__ float row_rstd(const float* ssq, int r, int fq) {
    const f4 p0 = *(const f4*)(ssq + (size_t)r * 32 + 8 * fq), p1 = *(const f4*)(ssq + (size_t)r * 32 + 8 * fq + 4);
    float s = ((p0.x + p0.y) + (p0.z + p0.w)) + ((p1.x + p1.y) + (p1.z + p1.w));
    s += __shfl_xor(s, 16); s += __shfl_xor(s, 32);
    return rsqrtf(s * (1.f / DM) + EPS);
}

__device__ __forceinline__ float row_rstd_sc1(const float* ssq, int r, int fq) {
    GAS unsigned long long* p = (GAS unsigned long long*)(ssq + (size_t)r * 32 + 8 * fq); float s = 0.f;
#pragma unroll
    for (int i = 0; i < 4; ++i) { const unsigned long long w = __hip_atomic_load(p + i, __ATOMIC_RELAXED, __HIP_MEMORY_SCOPE_AGENT); s += __uint_as_float((unsigned)w) + __uint_as_float((unsigned)(w >> 32)); }
    s += __shfl_xor(s, 16); s += __shfl_xor(s, 32);
    return rsqrtf(s * (1.f / DM) + EPS);
}

__device__ __forceinline__ void unpack8(const u4& w, accv& a, accv& b) { a[0] = bflo(w.x); a[1] = bfhi(w.x); a[2] = bflo(w.y); a[3] = bfhi(w.y); b[0] = bflo(w.z); b[1] = bfhi(w.z); b[2] = bflo(w.w); b[3] = bfhi(w.w); }

struct RsPart { f4 p0, p1; };
__device__ __forceinline__ RsPart rs_load(const float* ssq, int r, int fq) { RsPart p; p.p0 = *(const f4*)(ssq + (size_t)r * 32 + 8 * fq); p.p1 = *(const f4*)(ssq + (size_t)r * 32 + 8 * fq + 4); return p; }
__device__ __forceinline__ float rs_fin(const RsPart& p) {
    float s = ((p.p0.x + p.p0.y) + (p.p0.z + p.p0.w)) + ((p.p1.x + p.p1.y) + (p.p1.z + p.p1.w));
    s += __shfl_xor(s, 16); s += __shfl_xor(s, 32);
    return rsqrtf(s * (1.f / DM) + EPS);
}

struct EpiG1 {
    static constexpr bool PERM = true, AFTER_DRAIN = false;
    unsigned char* ws;
    __device__ __forceinline__ void operator()(const accv (&acc)[2][2][4][2], const Unit& u, int wr, int wc, int fr, int fq) const {
        const int seg = u.pn >> 2, q4 = u.pn & 3;
        const int row0 = u.pm * 256 + wr * 64 + fr, cl = wc * 32 + 8 * fq;
        if (seg < 4 || seg == 7) {
            const int reg = seg == 7 ? 4 : seg;
            bf16r* base = (bf16r*)(ws + WS_G1 + (size_t)reg * 16 * MiB);
#pragma unroll
            for (int ai = 0; ai < 2; ++ai)
#pragma unroll
                for (int m = 0; m < 4; ++m) { bf16r* rowp = base + (size_t)(row0 + ai * 128 + m * 16) * 1024 + q4 * 256 + cl;
#pragma unroll
                    for (int bj = 0; bj < 2; ++bj) *(u4*)(rowp + bj * 128) = pack8(acc[ai][bj][m][0], acc[ai][bj][m][1]); }
        } else if (seg == 6) {
            bf16r* base = (bf16r*)(ws + WS_DAV);
#pragma unroll
            for (int ai = 0; ai < 2; ++ai)
#pragma unroll
                for (int m = 0; m < 4; ++m) { const int r = row0 + ai * 128 + m * 16, b = r >> 11, s = r & 2047;
#pragma unroll
                    for (int bj = 0; bj < 2; ++bj) *(u4*)(base + ((size_t)((b * 4 + q4) * 2 + bj) * 2048 + s) * 128 + cl) = pack8(acc[ai][bj][m][0], acc[ai][bj][m][1]); }
        } else {
            bf16r* base = (bf16r*)(ws + (seg == 4 ? WS_DAQ : WS_DAK));
            const float* rope = (const float*)(ws + WS_ROPE);
            const int j0 = 16 * wc + 4 * fq;
#pragma unroll
            for (int ai = 0; ai < 2; ++ai)
#pragma unroll
                for (int m = 0; m < 4; ++m) { const int r = row0 + ai * 128 + m * 16, b = r >> 11, s = r & 2047;
                    const f4 t0 = *(const f4*)(rope + ((size_t)r * 64 + j0) * 2), t1 = *(const f4*)(rope + ((size_t)r * 64 + j0) * 2 + 4);
                    const accv cs = {t0.x, t0.z, t1.x, t1.z}, sn = {t0.y, t0.w, t1.y, t1.w};
#pragma unroll
                    for (int bj = 0; bj < 2; ++bj) { const accv x1 = acc[ai][bj][m][0], x2 = acc[ai][bj][m][1];
                        const accv o1 = x1 * cs - x2 * sn, o2 = x1 * sn + x2 * cs;
                        *(u4*)(base + ((size_t)((b * 4 + q4) * 2 + bj) * 2048 + s) * 128 + cl) = pack8(o1, o2); } }
        }
    }
};

template <bool XBF>
struct EpiRes {
    static constexpr bool PERM = true, AFTER_DRAIN = false;
    const void* xin; bf16r* xb; float* ssq;
    __device__ __forceinline__ void operator()(const accv (&acc)[2][2][4][2], const Unit& u, int wr, int wc, int fr, int fq) const {
        const int row0 = u.pm * 256 + wr * 64 + fr, col0 = u.pn * 256 + wc * 32 + 8 * fq;
#pragma unroll
        for (int ah = 0; ah < 4; ++ah) { const int ai = ah >> 1, m0 = (ah & 1) * 2;
            accv xa[4][2], xc[4][2];
#pragma unroll
            for (int m = m0; m < m0 + 2; ++m)
#pragma unroll
                for (int bj = 0; bj < 2; ++bj) { const size_t o = (size_t)(row0 + ai * 128 + m * 16) * DM + col0 + bj * 128;
                    if constexpr (XBF) { unpack8(*(const u4*)((const bf16r*)xin + o), xa[m][bj], xc[m][bj]); } else { xa[m][bj] = __builtin_nontemporal_load((const accv*)((const float*)xin + o)); xc[m][bj] = __builtin_nontemporal_load((const accv*)((const float*)xin + o + 4)); } }
#pragma unroll
            for (int m = m0; m < m0 + 2; ++m) { const int r = row0 + ai * 128 + m * 16; float q = 0.f;
#pragma unroll
                for (int bj = 0; bj < 2; ++bj) { const size_t o = (size_t)r * DM + col0 + bj * 128;
                    const accv v0 = acc[ai][bj][m][0] + xa[m][bj], v1 = acc[ai][bj][m][1] + xc[m][bj];
                    *(u4*)(xb + o) = pack8(v0, v1);
                    q += ((v0[0] * v0[0] + v0[1] * v0[1]) + (v0[2] * v0[2] + v0[3] * v0[3])) + ((v1[0] * v1[0] + v1[1] * v1[1]) + (v1[2] * v1[2] + v1[3] * v1[3])); }
                q += __shfl_xor(q, 16); q += __shfl_xor(q, 32);
                if (fq == 0) ssq[(size_t)r * 32 + u.pn * 4 + wc] = q; } }
    }
};

struct EpiGate {
    static constexpr bool PERM = true, AFTER_DRAIN = false;
    const bf16r* xin; bf16r* xb; const bf16r* pp; const float* ssq_in; float* ssq_out;
    __device__ __forceinline__ void operator()(const accv (&acc)[2][2][4][2], const Unit& u, int wr, int wc, int fr, int fq) const {
        const int row0 = u.pm * 256 + wr * 64 + fr, col0 = u.pn * 256 + wc * 32 + 8 * fq;
#pragma unroll
        for (int ah = 0; ah < 4; ++ah) { const int ai = ah >> 1, m0 = (ah & 1) * 2;
            u4 xw[4][2], pw[4][2]; RsPart rp[4];
#pragma unroll
            for (int m = m0; m < m0 + 2; ++m) { const int r = row0 + ai * 128 + m * 16; rp[m] = rs_load(ssq_in, r, fq);
#pragma unroll
                for (int bj = 0; bj < 2; ++bj) { const size_t o = (size_t)r * DM + col0 + bj * 128; xw[m][bj] = *(const u4*)(xin + o); pw[m][bj] = *(const u4*)(pp + o); } }
#pragma unroll
            for (int m = m0; m < m0 + 2; ++m) { const int r = row0 + ai * 128 + m * 16; const float rstd = rs_fin(rp[m]); float q = 0.f;
#pragma unroll
                for (int bj = 0; bj < 2; ++bj) { const size_t o = (size_t)r * DM + col0 + bj * 128;
                    accv xa, xc, pa, pc; unpack8(xw[m][bj], xa, xc); unpack8(pw[m][bj], pa, pc);
                    const accv a0 = acc[ai][bj][m][0] * rstd, a1 = acc[ai][bj][m][1] * rstd;
                    accv v0, v1;
#pragma unroll
                    for (int i = 0; i < 4; ++i) { v0[i] = xa[i] + sigm(a0[i]) * pa[i]; v1[i] = xc[i] + sigm(a1[i]) * pc[i]; }
                    *(u4*)(xb + o) = pack8(v0, v1);
                    q += ((v0[0] * v0[0] + v0[1] * v0[1]) + (v0[2] * v0[2] + v0[3] * v0[3])) + ((v1[0] * v1[0] + v1[1] * v1[1]) + (v1[2] * v1[2] + v1[3] * v1[3])); }
                q += __shfl_xor(q, 16); q += __shfl_xor(q, 32); if (fq == 0) ssq_out[(size_t)r * 32 + u.pn * 4 + wc] = q; } }
    }
};

struct EpiUVZ {
    static constexpr bool PERM = true, AFTER_DRAIN = false;
    bf16r* U; bf16r* V; const float* ssq_in; float* lns; float* lnq;
    __device__ __forceinline__ void operator()(const accv (&acc)[2][2][4][2], const Unit& u, int wr, int wc, int fr, int fq) const {
        const int seg = u.pn >> 3, pnl = u.pn & 7;
        bf16r* base = (seg == 1) ? V : U + (size_t)(seg >> 1) * TOK * DM;
        const int row0 = u.pm * 256 + wr * 64 + fr, col0 = pnl * 256 + wc * 32 + 8 * fq;

#pragma unroll
        for (int ai = 0; ai < 2; ++ai) { RsPart rp[4];
#pragma unroll
            for (int m = 0; m < 4; ++m) rp[m] = rs_load(ssq_in, row0 + ai * 128 + m * 16, fq);
#pragma unroll
            for (int m = 0; m < 4; ++m) { const int r = row0 + ai * 128 + m * 16; const float rstd = rs_fin(rp[m]); float s1 = 0.f, s2 = 0.f;
#pragma unroll
                for (int bj = 0; bj < 2; ++bj) { const size_t o = (size_t)r * DM + col0 + bj * 128;
                    const accv v0 = acc[ai][bj][m][0] * rstd, v1 = acc[ai][bj][m][1] * rstd;
                    *(u4*)(base + o) = pack8(v0, v1);
                    s1 += ((v0[0] + v0[1]) + (v0[2] + v0[3])) + ((v1[0] + v1[1]) + (v1[2] + v1[3]));
                    s2 += ((v0[0] * v0[0] + v0[1] * v0[1]) + (v0[2] * v0[2] + v0[3] * v0[3])) + ((v1[0] * v1[0] + v1[1] * v1[1]) + (v1[2] * v1[2] + v1[3] * v1[3])); }
                if (seg == 1) { s1 += __shfl_xor(s1, 16); s1 += __shfl_xor(s1, 32); s2 += __shfl_xor(s2, 16); s2 += __shfl_xor(s2, 32);
                    if (fq == 0) { lns[(size_t)r * 32 + pnl * 4 + wc] = s1; lnq[(size_t)r * 32 + pnl * 4 + wc] = s2; } } } }
    }
};

struct EpiGateFinal {
    static constexpr bool PERM = true, AFTER_DRAIN = false;
    const bf16r* xin; float* out; const bf16r* pp; const float* ssq_in; float* ssq_x; unsigned* cnt; const float* gfin;
    __device__ __forceinline__ void operator()(accv (&acc)[2][2][4][2], const Unit& u, int wr, int wc, int fr, int fq) const {
        const int row0 = u.pm * 256 + wr * 64 + fr, col0 = u.pn * 256 + wc * 32 + 8 * fq;
#pragma unroll
        for (int ah = 0; ah < 4; ++ah) { const int ai = ah >> 1, m0 = (ah & 1) * 2;
            u4 xw[4][2], pw[4][2]; RsPart rp[4];
#pragma unroll
            for (int m = m0; m < m0 + 2; ++m) { const int r = row0 + ai * 128 + m * 16; rp[m] = rs_load(ssq_in, r, fq);
#pragma unroll
                for (int bj = 0; bj < 2; ++bj) { const size_t o = (size_t)r * DM + col0 + bj * 128; xw[m][bj] = *(const u4*)(xin + o); pw[m][bj] = *(const u4*)(pp + o); } }
#pragma unroll
            for (int m = m0; m < m0 + 2; ++m) { const int r = row0 + ai * 128 + m * 16; const float rstd = rs_fin(rp[m]); float q = 0.f;
#pragma unroll
                for (int bj = 0; bj < 2; ++bj) {
                    accv xa, xc, pa, pc; unpack8(xw[m][bj], xa, xc); unpack8(pw[m][bj], pa, pc);
                    const accv a0 = acc[ai][bj][m][0] * rstd, a1 = acc[ai][bj][m][1] * rstd;
                    accv v0, v1;
#pragma unroll
                    for (int i = 0; i < 4; ++i) { v0[i] = xa[i] + sigm(a0[i]) * pa[i]; v1[i] = xc[i] + sigm(a1[i]) * pc[i]; }
                    acc[ai][bj][m][0] = v0; acc[ai][bj][m][1] = v1;
                    q += ((v0[0] * v0[0] + v0[1] * v0[1]) + (v0[2] * v0[2] + v0[3] * v0[3])) + ((v1[0] * v1[0] + v1[1] * v1[1]) + (v1[2] * v1[2] + v1[3] * v1[3])); }
                q += __shfl_xor(q, 16); q += __shfl_xor(q, 32); if (fq == 0) __hip_atomic_store((GAS unsigned*)(ssq_x + (size_t)r * 32 + u.pn * 4 + wc), __float_as_uint(q), __ATOMIC_RELAXED, __HIP_MEMORY_SCOPE_AGENT); } }
        asm volatile("s_waitcnt vmcnt(0)" ::: "memory");
        __builtin_amdgcn_s_barrier();
        if ((wr | wc) == 0) { GAS unsigned* c = (GAS unsigned*)(cnt + u.pm * 64);
            if ((fr | fq) == 0) (void)__hip_atomic_fetch_add(c, 1u, __ATOMIC_RELAXED, __HIP_MEMORY_SCOPE_AGENT);
            unsigned spins = 0; while ((unsigned)__builtin_amdgcn_readfirstlane((int)__hip_atomic_load(c, __ATOMIC_RELAXED, __HIP_MEMORY_SCOPE_AGENT)) < 8u) { __builtin_amdgcn_s_sleep(1); if (++spins > (1u << 22)) break; }
            __builtin_amdgcn_fence(__ATOMIC_ACQUIRE, "agent"); asm volatile("s_waitcnt vmcnt(0)" ::: "memory"); }
        __builtin_amdgcn_s_barrier();
        accv g[2][2];
#pragma unroll
        for (int bj = 0; bj < 2; ++bj) { g[bj][0] = *(const accv*)(gfin + col0 + bj * 128); g[bj][1] = *(const accv*)(gfin + col0 + bj * 128 + 4); }
#pragma unroll
        for (int ai = 0; ai < 2; ++ai)
#pragma unroll
            for (int m = 0; m < 4; ++m) { const int r = row0 + ai * 128 + m * 16; const float rstd = row_rstd_sc1(ssq_x, r, fq);
#pragma unroll
                for (int bj = 0; bj < 2; ++bj) { const size_t o = (size_t)r * DM + col0 + bj * 128;
                    __builtin_nontemporal_store(acc[ai][bj][m][0] * rstd * g[bj][0], (accv*)(out + o)); __builtin_nontemporal_store(acc[ai][bj][m][1] * rstd * g[bj][1], (accv*)(out + o + 4)); } }
    }
};

#define MFMA16(a, b, c) __builtin_amdgcn_mfma_f32_16x16x32_bf16((a), (b), (c), 0, 0, 0)
constexpr int LP = 136;

struct ConvW { f4 w[4][2]; f4 b[2]; };
__device__ __forceinline__ void conv_w_load(const float* cw, const float* cb, int col, ConvW& W) {
    W.b[0] = *(const f4*)(cb + col); W.b[1] = *(const f4*)(cb + col + 4);
#pragma unroll
    for (int j = 0; j < 4; ++j) { W.w[j][0] = *(const f4*)(cw + j * 1024 + col); W.w[j][1] = *(const f4*)(cw + j * 1024 + col + 4); }
}
__device__ __forceinline__ void conv8_ld(const bf16r* mlqk, int t0, int cpos, int l, int col, u4 (&xv)[4]) {
#pragma unroll
    for (int j = 0; j < 4; ++j) { const int tt = l - 3 + j; const bool ok = cpos + tt >= 0;
        xv[j] = *(const u4*)(mlqk + (size_t)(t0 + (ok ? tt : 0)) * 1024 + col); if (!ok) xv[j] = (u4){0u, 0u, 0u, 0u}; }
}
__device__ __forceinline__ void conv8_fin(const ConvW& W, const u4 (&xv)[4], float scale, float (&o)[8]) {
    o[0] = W.b[0].x; o[1] = W.b[0].y; o[2] = W.b[0].z; o[3] = W.b[0].w; o[4] = W.b[1].x; o[5] = W.b[1].y; o[6] = W.b[1].z; o[7] = W.b[1].w;
#pragma unroll
    for (int j = 0; j < 4; ++j) { const f4 w0 = W.w[j][0], w1 = W.w[j][1];
        o[0] += w0.x * bflo(xv[j].x); o[1] += w0.y * bfhi(xv[j].x); o[2] += w0.z * bflo(xv[j].y); o[3] += w0.w * bfhi(xv[j].y);
        o[4] += w1.x * bflo(xv[j].z); o[5] += w1.y * bfhi(xv[j].z); o[6] += w1.z * bflo(xv[j].w); o[7] += w1.w * bfhi(xv[j].w); }
#pragma unroll
    for (int i = 0; i < 8; ++i) o[i] = silu(o[i]) * scale;
}
constexpr float KSCALE = 0.08838834764831845f;
constexpr int LPV = 264;
typedef short s4v __attribute__((ext_vector_type(4)));
__device__ __forceinline__ s8v tr_frag(const LAS bf16r* base, int pitch, int fr, int fq) {
    const LAS bf16r* p = base + (8 * fq + (fr >> 2)) * pitch + 4 * (fr & 3);
    const s4v lo = __builtin_amdgcn_ds_read_tr16_b64_v4i16((LAS s4v*)p), hi = __builtin_amdgcn_ds_read_tr16_b64_v4i16((LAS s4v*)(p + 4 * pitch));
    return (s8v){lo[0], lo[1], lo[2], lo[3], hi[0], hi[1], hi[2], hi[3]};
}
__device__ __forceinline__ float wave_scan_add(float x, int lane) {
#pragma unroll
    for (int o = 1; o < 64; o <<= 1) { const float y = __shfl_up(x, o); if (lane >= o) x += y; }
    return x;
}
__device__ __forceinline__ float wave_scan_max(float x, int lane) {
#pragma unroll
    for (int o = 1; o < 64; o <<= 1) { const float y = __shfl_up(x, o); if (lane >= o) x = fmaxf(x, y); }
    return x;
}
__device__ __forceinline__ float wave_max(float v) {
#pragma unroll
    for (int o = 1; o < 64; o <<= 1) v = fmaxf(v, __shfl_xor(v, o));
    return v;
}

__device__ __forceinline__ void m1_unit(const Args& a, LAS unsigned char* lds, int unit, int tid, int lane, int wave) {
    unsigned char* ws = a.ws;
    const int b = unit >> 6, c = (unit >> 2) & 15, h = unit & 3, t0 = b * 2048 + c * 128;
    LAS bf16r* Kn = (LAS bf16r*)lds;
    LAS bf16r* Vn = (LAS bf16r*)(lds + 34816);
    LAS float* fs = (LAS float*)(lds + 104448);
    const float* IFG = (const float*)(ws + WS_IFG); float* BCUM = (float*)(ws + WS_BCUM); float* MSC = (float*)(ws + WS_MSC);
    float li = 0.f, bsum = 0.f;
    if (wave < 2) { li = IFG[(size_t)(t0 + tid) * 8 + h]; bsum = wave_scan_add(IFG[(size_t)(t0 + tid) * 8 + 4 + h], lane); if (tid == 63) fs[128] = bsum; }
    __syncthreads();
    if (wave == 1) bsum += fs[128];
    if (wave < 2) { BCUM[(size_t)(t0 + tid) * 4 + h] = bsum; if (tid == 127) fs[129] = bsum; }
    __syncthreads();
    float w = 0.f;
    if (wave < 2) { w = fs[129] - bsum + li; const float wm = wave_max(w); if (lane == 0) fs[130 + wave] = wm; }
    __syncthreads();
    if (wave < 2) { const float m = fmaxf(fs[130], fs[131]); fs[tid] = __expf(w - m); if (tid == 0) { MSC[unit * 4 + 0] = m; MSC[unit * 4 + 1] = fs[129]; } }
    __syncthreads();
    const bf16r* mlqk = (const bf16r*)(ws + WS_MLQK); const bf16r* mlv = (const bf16r*)(ws + WS_MLV);
    const float* cw = (const float*)a.in[5]; const float* cb = (const float*)a.in[6];
    { const int dg = (tid & 15) * 8, col = 512 + h * 128 + dg; ConvW W; conv_w_load(cw, cb, col, W);
      u4 xv[4][4];
#pragma unroll
      for (int n = 0; n < 4; ++n) conv8_ld(mlqk, t0, c * 128, (tid >> 4) + 32 * n, col, xv[n]);
#pragma unroll
      for (int n = 0; n < 4; ++n) { const int l = (tid >> 4) + 32 * n; float o[8]; conv8_fin(W, xv[n], KSCALE, o);
          *(LAS u4*)(Kn + l * LP + dg) = (u4){pk2(o[0], o[1]), pk2(o[2], o[3]), pk2(o[4], o[5]), pk2(o[6], o[7])}; } }
#pragma unroll
    for (int it = tid; it < 128 * 32; it += 512) { const int l = it >> 5, dg = (it & 31) * 8; const float e = fs[l];
        const u4 xv = *(const u4*)(mlv + (size_t)(t0 + l) * 1024 + h * 256 + dg);
        *(LAS u4*)(Vn + l * LPV + dg) = (u4){pk2(bflo(xv.x) * e, bfhi(xv.x) * e), pk2(bflo(xv.y) * e, bfhi(xv.y) * e), pk2(bflo(xv.z) * e, bfhi(xv.z) * e), pk2(bflo(xv.w) * e, bfhi(xv.w) * e)}; }
    __syncthreads();
    if (tid < 128) { float sacc = 0.f;
#pragma unroll 16
        for (int l = 0; l < 128; ++l) sacc += fs[l] * __uint_as_float((unsigned)Kn[l * LP + tid] << 16);
        ((float*)(ws + WS_NLOC))[unit * 128 + tid] = sacc; }
    const int fr = lane & 15, fq = lane >> 4;
    f4 acc[8][2];
#pragma unroll
    for (int mt = 0; mt < 8; ++mt) { acc[mt][0] = (f4){0.f, 0.f, 0.f, 0.f}; acc[mt][1] = (f4){0.f, 0.f, 0.f, 0.f}; }
#pragma unroll
    for (int ks = 0; ks < 4; ++ks) {
        const s8v b0 = tr_frag(Vn + 32 * ks * LPV + 32 * wave, LPV, fr, fq), b1 = tr_frag(Vn + 32 * ks * LPV + 32 * wave + 16, LPV, fr, fq);
#pragma unroll
        for (int mt = 0; mt < 8; ++mt) { const s8v av = tr_frag(Kn + 32 * ks * LP + 16 * mt, LP, fr, fq); acc[mt][0] = MFMA16(av, b0, acc[mt][0]); acc[mt][1] = MFMA16(av, b1, acc[mt][1]); } }
    float* cl = (float*)(ws + WS_CLOC) + (size_t)unit * 32768;
#pragma unroll
    for (int mt = 0; mt < 8; ++mt)
#pragma unroll
        for (int nt = 0; nt < 2; ++nt)
            *(f4*)(cl + ((((2 * wave + nt) * 4 + (mt >> 1)) * 64 + ((2 * mt + (fq >> 1)) & 3) * 16 + fr) * 8 + 4 * (fq & 1))) = acc[mt][nt];
    __syncthreads();
}

__device__ __forceinline__ void m2_scan(const Args& a, int tid, int G) {
    unsigned char* ws = a.ws; const int gt = blockIdx.x * 512 + tid, NT = G * 512;
    const float* MSC = (const float*)(ws + WS_MSC); float* MSCw = (float*)(ws + WS_MSC);
    const float* CL = (const float*)(ws + WS_CLOC); bf16r* CP = (bf16r*)(ws + WS_CPREV);
    for (int e = gt; e < 16 * 8192; e += NT) { const int bh = e >> 13, idx = (e & 8191) * 4, b = bh >> 2, h = bh & 3;
        f4 C = {0.f, 0.f, 0.f, 0.f}; float m = 0.f;
        for (int c = 0; c < 16; ++c) { const int u = (b * 16 + c) * 4 + h;
            *(u2*)(CP + (size_t)u * 32768 + idx) = (u2){pk2(C[0], C[1]), pk2(C[2], C[3])};
            const float ml = MSC[u * 4 + 0], g = MSC[u * 4 + 1]; const float mn = fmaxf(g + m, ml), aa = __expf(g + m - mn), cc = __expf(ml - mn);
            const f4 Cl = __builtin_nontemporal_load((const f4*)(CL + (size_t)u * 32768 + idx)); C = C * aa + Cl * cc; m = mn; } }
    const float* NL = (const float*)(ws + WS_NLOC); float* NP = (float*)(ws + WS_NPREV);
    for (int e = gt; e < 16 * 128; e += NT) { const int bh = e >> 7, dk = e & 127, b = bh >> 2, h = bh & 3; float n = 0.f, m = 0.f;
        for (int c = 0; c < 16; ++c) { const int u = (b * 16 + c) * 4 + h; NP[u * 128 + dk] = n; if (dk == 0) MSCw[u * 4 + 2] = m;
            const float ml = MSC[u * 4 + 0], g = MSC[u * 4 + 1]; const float mn = fmaxf(g + m, ml), aa = __expf(g + m - mn), cc = __expf(ml - mn);
            n = aa * n + cc * NL[u * 128 + dk]; m = mn; } }
}

template <int ONLY_STAGE = 0>
__device__ __forceinline__ void m3_unit(const Args& a, LAS unsigned char* lds, int unit, int tid, int lane, int wave) {
    unsigned char* ws = a.ws;
    const int b = unit >> 6, c = (unit >> 2) & 15, h = unit & 3, t0 = b * 2048 + c * 128;
    LAS bf16r* Qc = (LAS bf16r*)lds;
    LAS bf16r* Kc = (LAS bf16r*)(lds + 34816);
    LAS bf16r* Vn = (LAS bf16r*)(lds + 69632);
    LAS float* fs = (LAS float*)(lds + 139264);
    const float* IFG = (const float*)(ws + WS_IFG); const float* BCUM = (const float*)(ws + WS_BCUM); const float* MSC = (const float*)(ws + WS_MSC);
    const float m_prev = MSC[unit * 4 + 2];
    if (tid < 128) { const float bt = BCUM[(size_t)(t0 + tid) * 4 + h]; fs[tid] = IFG[(size_t)(t0 + tid) * 8 + h] - bt; fs[128 + tid] = bt; }
    else if (tid < 256) fs[256 + tid - 128] = ((const float*)(ws + WS_NPREV))[unit * 128 + tid - 128];
    const bf16r* mlqk = (const bf16r*)(ws + WS_MLQK); const bf16r* mlv = (const bf16r*)(ws + WS_MLV);
    const float* cw = (const float*)a.in[5]; const float* cb = (const float*)a.in[6];
    { const int isk = (tid >> 4) & 1, dg = (tid & 15) * 8, col = isk * 512 + h * 128 + dg; ConvW W; conv_w_load(cw, cb, col, W);
      LAS bf16r* dst = isk ? Kc : Qc; const float sc = isk ? KSCALE : 1.f;
#pragma unroll
      for (int hf = 0; hf < 2; ++hf) { u4 xv[4][4];
#pragma unroll
          for (int n = 0; n < 4; ++n) conv8_ld(mlqk, t0, c * 128, (tid >> 5) + 16 * (4 * hf + n), col, xv[n]);
#pragma unroll
          for (int n = 0; n < 4; ++n) { const int l = (tid >> 5) + 16 * (4 * hf + n); float o[8]; conv8_fin(W, xv[n], sc, o);
              *(LAS u4*)(dst + l * LP + dg) = (u4){pk2(o[0], o[1]), pk2(o[2], o[3]), pk2(o[4], o[5]), pk2(o[6], o[7])}; } } }
#pragma unroll
    for (int it = tid; it < 128 * 32; it += 512) { const int l = it >> 5, dg = (it & 31) * 8;
        *(LAS u4*)(Vn + l * LPV + dg) = __builtin_nontemporal_load((const u4*)(mlv + (size_t)(t0 + l) * 1024 + h * 256 + dg)); }
    const int fr = lane & 15, fq = lane >> 4, t = 16 * wave + fr;
    const bf16r* cp = (const bf16r*)(ws + WS_CPREV) + (size_t)unit * 32768 + (fq * 16 + fr) * 8;
    s8v cpa[32];
#pragma unroll
    for (int ks = 0; ks < 4; ++ks)
#pragma unroll
        for (int mt = 0; mt < 8; ++mt) cpa[ks * 8 + mt] = *(const s8v*)(cp + (mt * 4 + ks) * 512);
    __syncthreads();
    if (ONLY_STAGE) return;
    float pmx = 0.f;
    if (wave < 2) { pmx = wave_scan_max(fs[tid], lane); if (tid == 63) fs[896] = pmx; }
    __syncthreads();
    if (wave < 2) { if (wave == 1) pmx = fmaxf(pmx, fs[896]);
        const float M = fmaxf(m_prev, pmx); fs[384 + tid] = M; fs[512 + tid] = __expf(m_prev - M); fs[640 + tid] = __expf(-(fs[128 + tid] + M));
        float qn = 0.f;
#pragma unroll 4
        for (int d8 = 0; d8 < 16; ++d8) { const u4 qv = *(const LAS u4*)(Qc + tid * LP + 8 * d8); const f4 n0 = *(const LAS f4*)(fs + 256 + 8 * d8), n1 = *(const LAS f4*)(fs + 256 + 8 * d8 + 4);
            qn += (bflo(qv.x) * n0.x + bfhi(qv.x) * n0.y) + (bflo(qv.y) * n0.z + bfhi(qv.y) * n0.w) + (bflo(qv.z) * n1.x + bfhi(qv.z) * n1.y) + (bflo(qv.w) * n1.z + bfhi(qv.w) * n1.w); }
        fs[768 + tid] = qn; }
    __syncthreads();
    f4 as[8];
#pragma unroll
    for (int mt = 0; mt < 8; ++mt) as[mt] = (f4){0.f, 0.f, 0.f, 0.f};
#pragma unroll
    for (int ks = 0; ks < 4; ++ks) { const s8v bq = *(const LAS s8v*)(Qc + t * LP + 32 * ks + 8 * fq);
#pragma unroll
        for (int mt = 0; mt < 8; ++mt) if (mt <= wave) { const s8v av = *(const LAS s8v*)(Kc + (16 * mt + fr) * LP + 32 * ks + 8 * fq); as[mt] = MFMA16(av, bq, as[mt]); } }
    __syncthreads();
    const float Mt = fs[384 + t]; float den = 0.f; const int lim = fr - 4 * fq;
#pragma unroll
    for (int mt = 0; mt < 8; ++mt) if (mt <= wave + 1) { float v[4];
        if (mt < wave) {
#pragma unroll
            for (int r = 0; r < 4; ++r) v[r] = as[mt][r] * __expf(fs[16 * mt + 4 * fq + r] - Mt);
        } else if (mt == wave) {
#pragma unroll
            for (int r = 0; r < 4; ++r) v[r] = (r <= lim) ? as[mt][r] * __expf(fs[16 * mt + 4 * fq + r] - Mt) : 0.f;
        } else { v[0] = 0.f; v[1] = 0.f; v[2] = 0.f; v[3] = 0.f; }
        den += (v[0] + v[1]) + (v[2] + v[3]);
        if (mt <= wave || (wave & 1) == 0) *(LAS u2*)(Kc + t * LP + 16 * mt + 4 * fq) = (u2){pk2(v[0], v[1]), pk2(v[2], v[3])}; }
    den += __shfl_xor(den, 16); den += __shfl_xor(den, 32);
    __syncthreads();
    f4 ao[16]; const float iw = fs[512 + t];
#pragma unroll
    for (int mt = 0; mt < 16; ++mt) ao[mt] = (f4){0.f, 0.f, 0.f, 0.f};
#pragma unroll
    for (int ks = 0; ks < 4; ++ks) { const s8v bq = *(const LAS s8v*)(Qc + t * LP + 32 * ks + 8 * fq);
#pragma unroll
        for (int mt = 0; mt < 8; ++mt) ao[mt] = MFMA16(cpa[ks * 8 + mt], bq, ao[mt]); }
#pragma unroll
    for (int ks = 0; ks < 4; ++ks)
#pragma unroll
        for (int mt = 0; mt < 8; ++mt) cpa[ks * 8 + mt] = *(const s8v*)(cp + ((mt + 8) * 4 + ks) * 512);
#pragma unroll
    for (int ks = 0; ks < 4; ++ks) { const s8v bq = *(const LAS s8v*)(Qc + t * LP + 32 * ks + 8 * fq);
#pragma unroll
        for (int mt = 0; mt < 8; ++mt) ao[8 + mt] = MFMA16(cpa[ks * 8 + mt], bq, ao[8 + mt]); }
    const bf16r* mlo = (const bf16r*)(ws + WS_MLO) + (size_t)(t0 + t) * 1024 + h * 256 + 4 * fq; const bf16r* mlz = (const bf16r*)(ws + WS_MLZ) + (size_t)(t0 + t) * 1024 + h * 256 + 4 * fq;
    u2 ovv[16], zvv[16];
#pragma unroll
    for (int mt = 0; mt < 16; ++mt) { ovv[mt] = __builtin_nontemporal_load((const u2*)(mlo + 16 * mt)); zvv[mt] = __builtin_nontemporal_load((const u2*)(mlz + 16 * mt)); }
#pragma unroll
    for (int mt = 0; mt < 16; ++mt) ao[mt] = ao[mt] * iw;
    const int nks = (wave + 2) >> 1;
    for (int ks = 0; ks < nks; ++ks) { const s8v bs = *(const LAS s8v*)(Kc + t * LP + 32 * ks + 8 * fq);
#pragma unroll
        for (int mt = 0; mt < 16; ++mt) { const s8v av = tr_frag(Vn + 32 * ks * LPV + 16 * mt, LPV, fr, fq); ao[mt] = MFMA16(av, bs, ao[mt]); } }
    const float dt = den + iw * fs[768 + t], inv = 1.f / fmaxf(fabsf(dt), fs[640 + t]);
    float ssq = 0.f;
#pragma unroll
    for (int mt = 0; mt < 16; ++mt) { const f4 hv = ao[mt] * inv; ssq += (hv[0] * hv[0] + hv[1] * hv[1]) + (hv[2] * hv[2] + hv[3] * hv[3]); }
    ssq += __shfl_xor(ssq, 16); ssq += __shfl_xor(ssq, 32);
    const float rstd = rsqrtf(ssq * (1.f / 256.f) + EPS) * inv;
    const float* gn = (const float*)a.in[9] + h * 256 + 4 * fq;
    bf16r* ao_out = (bf16r*)(ws + WS_AO) + (size_t)(t0 + t) * 2048 + h * 256 + 4 * fq;
#pragma unroll
    for (int mt = 0; mt < 16; ++mt) { const f4 g = *(const f4*)(gn + 16 * mt); const u2 ov = ovv[mt], zv = zvv[mt];
        const float r0 = ao[mt][0] * rstd * g.x * sigm(bflo(ov.x)) * silu(bflo(zv.x)), r1 = ao[mt][1] * rstd * g.y * sigm(bfhi(ov.x)) * silu(bfhi(zv.x));
        const float r2 = ao[mt][2] * rstd * g.z * sigm(bflo(ov.y)) * silu(bflo(zv.y)), r3 = ao[mt][3] * rstd * g.w * sigm(bfhi(ov.y)) * silu(bfhi(zv.y));
        *(u2*)(ao_out + 16 * mt) = (u2){pk2(r0, r1), pk2(r2, r3)}; }
    __syncthreads();
}

__device__ __forceinline__ void da_combine(const Args& a, int lane, int wave, int G) {
    unsigned char* ws = a.ws; const int gw = blockIdx.x * 8 + wave, NGW = G * 8;
    const float* q1 = (const float*)a.in[10]; const float* k1 = (const float*)a.in[11]; const float* q2 = (const float*)a.in[12]; const float* k2 = (const float*)a.in[13];
    const float s1 = wave_sum(q1[lane] * k1[lane] + q1[lane + 64] * k1[lane + 64]), s2 = wave_sum(q2[lane] * k2[lane] + q2[lane + 64] * k2[lane + 64]);
    const float lam_init = 0.2f, lam = expf(s1) - expf(s2) + lam_init;
    const bf16r* dao = (const bf16r*)(ws + WS_DAO); const bf16r* daz = (const bf16r*)(ws + WS_DAZ); bf16r* ao = (bf16r*)(ws + WS_AO);
    const float* gn = (const float*)a.in[14];
    const int half = lane >> 5, d = (lane & 31) * 4, dv = half * 128 + d;
    for (int it0 = gw; it0 < TOK * 4; it0 += 4 * NGW) {
        u2 o0[4], o1[4], zv[4]; f4 g[4];
#pragma unroll
        for (int k = 0; k < 4; ++k) { const int it = it0 + k * NGW, tok = it >> 2, h = it & 3, b = tok >> 11, s = tok & 2047;
            o0[k] = __builtin_nontemporal_load((const u2*)(dao + ((size_t)(((b * 4 + h) * 2 + 0) * 2 + half) * 2048 + s) * 128 + d)); o1[k] = __builtin_nontemporal_load((const u2*)(dao + ((size_t)(((b * 4 + h) * 2 + 1) * 2 + half) * 2048 + s) * 128 + d));
            g[k] = *(const f4*)(gn + h * 256 + dv); zv[k] = __builtin_nontemporal_load((const u2*)(daz + (size_t)tok * 1024 + h * 256 + dv)); }
#pragma unroll
        for (int k = 0; k < 4; ++k) { const int it = it0 + k * NGW, tok = it >> 2, h = it & 3;
            const float h0 = bflo(o0[k].x) - lam * bflo(o1[k].x), h1 = bfhi(o0[k].x) - lam * bfhi(o1[k].x), h2 = bflo(o0[k].y) - lam * bflo(o1[k].y), h3 = bfhi(o0[k].y) - lam * bfhi(o1[k].y);
            const float rstd = rsqrtf(wave_sum((h0 * h0 + h1 * h1) + (h2 * h2 + h3 * h3)) * (1.f / 256.f) + EPS) * (1.f - lam_init);
            *(u2*)(ao + (size_t)tok * 2048 + 1024 + h * 256 + dv) = (u2){pk2(h0 * rstd * g[k].x * silu(bflo(zv[k].x)), h1 * rstd * g[k].y * silu(bfhi(zv[k].x))), pk2(h2 * rstd * g[k].z * silu(bflo(zv[k].y)), h3 * rstd * g[k].w * silu(bfhi(zv[k].y)))}; } }
}

__device__ __forceinline__ void sgu_unit(const Args& a, LAS unsigned char* lds, int unit, int tid, int lane, int wave) {
    unsigned char* ws = a.ws;
    const int b = unit >> 7, c = (unit >> 3) & 15, g = unit & 7, t0 = b * 2048 + c * 128;
    LAS bf16r* VLn = (LAS bf16r*)lds;
    LAS bf16r* Wt = (LAS bf16r*)(lds + 69632);
    LAS float* fs = (LAS float*)(lds + 104448);
    if (tid < 128) { const f4* p1 = (const f4*)((const float*)(ws + WS_LNS) + (size_t)(t0 + tid) * 32); const f4* p2 = (const f4*)((const float*)(ws + WS_LNQ) + (size_t)(t0 + tid) * 32); float s1 = 0.f, s2 = 0.f;
#pragma unroll
        for (int i = 0; i < 8; ++i) { const f4 x1 = p1[i], x2 = p2[i]; s1 += (x1.x + x1.y) + (x1.z + x1.w); s2 += (x2.x + x2.y) + (x2.z + x2.w); }
        const float mu = s1 * (1.f / DM), var = fmaxf(s2 * (1.f / DM) - mu * mu, 0.f); fs[tid] = mu; fs[128 + tid] = rsqrtf(var + EPS); }
    __syncthreads();
    const bf16r* V = (const bf16r*)(ws + WS_V); const float* lg = (const float*)a.in[18] + g * 256; const float* lb = (const float*)a.in[19] + g * 256;
    const int dgs = (tid & 31) * 8;
    const f4 g0 = *(const f4*)(lg + dgs), g1 = *(const f4*)(lg + dgs + 4), b0 = *(const f4*)(lb + dgs), b1 = *(const f4*)(lb + dgs + 4);
#pragma unroll
    for (int it = tid; it < 128 * 32; it += 512) { const int s = it >> 5, dg = dgs; const float mu = fs[s], rs = fs[128 + s];
        const u4 xv = __builtin_nontemporal_load((const u4*)(V + (size_t)(t0 + s) * 2048 + g * 256 + dg));
        const unsigned w0 = pk2((bflo(xv.x) - mu) * rs * g0.x + b0.x, (bfhi(xv.x) - mu) * rs * g0.y + b0.y), w1 = pk2((bflo(xv.y) - mu) * rs * g0.z + b0.z, (bfhi(xv.y) - mu) * rs * g0.w + b0.w);
        const unsigned w2 = pk2((bflo(xv.z) - mu) * rs * g1.x + b1.x, (bfhi(xv.z) - mu) * rs * g1.y + b1.y), w3 = pk2((bflo(xv.w) - mu) * rs * g1.z + b1.z, (bfhi(xv.w) - mu) * rs * g1.w + b1.w);
        *(LAS u4*)(VLn + s * LPV + dg) = (u4){w0, w1, w2, w3}; }
    const float* sw = (const float*)a.in[20] + (size_t)g * 128 * 128;
#pragma unroll
    for (int it = tid; it < 128 * 16; it += 512) { const int t = it >> 4, sg = (it & 15) * 8; f4 w0 = *(const f4*)(sw + t * 128 + sg), w1 = *(const f4*)(sw + t * 128 + sg + 4);
        if (sg + 0 > t) w0.x = 0.f; if (sg + 1 > t) w0.y = 0.f; if (sg + 2 > t) w0.z = 0.f; if (sg + 3 > t) w0.w = 0.f;
        if (sg + 4 > t) w1.x = 0.f; if (sg + 5 > t) w1.y = 0.f; if (sg + 6 > t) w1.z = 0.f; if (sg + 7 > t) w1.w = 0.f;
        *(LAS u4*)(Wt + t * LP + sg) = (u4){pk2(w0.x, w0.y), pk2(w0.z, w0.w), pk2(w1.x, w1.y), pk2(w1.z, w1.w)}; }
    __syncthreads();
    const int fr = lane & 15, fq = lane >> 4, t = 16 * wave + fr;
    f4 ac[16];
#pragma unroll
    for (int mt = 0; mt < 16; ++mt) ac[mt] = (f4){0.f, 0.f, 0.f, 0.f};
    const int nks = (wave + 2) >> 1;
    for (int ks = 0; ks < nks; ++ks) { const s8v bw = *(const LAS s8v*)(Wt + t * LP + 32 * ks + 8 * fq);
#pragma unroll
        for (int mt = 0; mt < 16; ++mt) { const s8v av = tr_frag(VLn + 32 * ks * LPV + 16 * mt, LPV, fr, fq); ac[mt] = MFMA16(av, bw, ac[mt]); } }
    __syncthreads();
    LAS float* OUTS = (LAS float*)lds;
    { const float sb = ((const float*)a.in[21])[g * 128 + t];
#pragma unroll
      for (int mt = 0; mt < 16; ++mt) *(LAS f4*)(OUTS + t * 260 + 16 * mt + 4 * fq) = ac[mt] + sb; }
    __syncthreads();
    { const int dg = (tid & 31) * 8;
      const bf16r* U = (const bf16r*)a.out + (size_t)t0 * 2048 + g * 256 + dg; const bf16r* Z = U + (size_t)TOK * DM; bf16r* MB = (bf16r*)(ws + WS_MB) + (size_t)t0 * 2048 + g * 256 + dg;
      u4 uw[8], zw[8];
#pragma unroll
      for (int n = 0; n < 8; ++n) { const int tt = (tid >> 5) + 16 * n; uw[n] = __builtin_nontemporal_load((const u4*)(U + (size_t)tt * 2048)); zw[n] = __builtin_nontemporal_load((const u4*)(Z + (size_t)tt * 2048)); }
#pragma unroll
      for (int n = 0; n < 8; ++n) { const int tt = (tid >> 5) + 16 * n; const f4 s0 = *(const LAS f4*)(OUTS + tt * 260 + dg), s1 = *(const LAS f4*)(OUTS + tt * 260 + dg + 4);
          u4 o; o.x = pk2(bflo(uw[n].x) * s0.x * silu(bflo(zw[n].x)), bfhi(uw[n].x) * s0.y * silu(bfhi(zw[n].x))); o.y = pk2(bflo(uw[n].y) * s0.z * silu(bflo(zw[n].y)), bfhi(uw[n].y) * s0.w * silu(bfhi(zw[n].y)));
          o.z = pk2(bflo(uw[n].z) * s1.x * silu(bflo(zw[n].z)), bfhi(uw[n].z) * s1.y * silu(bfhi(zw[n].z))); o.w = pk2(bflo(uw[n].w) * s1.z * silu(bflo(zw[n].w)), bfhi(uw[n].w) * s1.w * silu(bfhi(zw[n].w)));
          *(u4*)(MB + (size_t)tt * 2048) = o; } }
    __syncthreads();
}

__device__ __forceinline__ void final_norm(const Args& a, int lane, int wave, int G) {
    const int gw = blockIdx.x * 8 + wave, NGW = G * 8; const f4* gn = (const f4*)a.in[26];
    for (int m = gw; m < TOK; m += NGW) { f4* xr = (f4*)(a.out + (size_t)m * DM) + lane; f4 v[8]; float s = 0.f;
#pragma unroll
        for (int j = 0; j < 8; ++j) { v[j] = xr[64 * j]; s += (v[j].x * v[j].x + v[j].y * v[j].y) + (v[j].z * v[j].z + v[j].w * v[j].w); }
        const float rstd = rsqrtf(wave_sum(s) * (1.f / DM) + EPS);
#pragma unroll
        for (int j = 0; j < 8; ++j) xr[64 * j] = v[j] * rstd * gn[lane + 64 * j]; }
}

__device__ __forceinline__ void attn_phase(const Args& a, char* lds, int G) {
    using namespace att;
    unsigned char* ws = a.ws;
    const bf16* DQ = (const bf16*)(ws + WS_DAQ); const bf16* DK = (const bf16*)(ws + WS_DAK); const bf16* DV = (const bf16*)(ws + WS_DAV); bf16* DO = (bf16*)(ws + WS_DAO);
    const int W = 1 << 30;
    { const int L = blockIdx.x;
        const int xcd = L & 7, slot = L >> 3, grp = xcd * 2 + (slot >> 4), w = slot & 15, map = w >> 3, half = (w >> 2) & 1, x = w & 3;
        const bf16* Q = DQ + (size_t)(grp * 2 + map) * 2048 * 128; const bf16* K = DK + (size_t)(grp * 2 + map) * 2048 * 128;
        const bf16* V = DV + (size_t)(grp * 2 + half) * 2048 * 128; bf16* O = DO + (size_t)((grp * 2 + map) * 2 + half) * 2048 * 128;
        const int qb0 = x, qb1 = 7 - x;
        BlockRef<bf16, bf16> c0, c1;
        c0.Q = Q + (size_t)qb0 * QB * D; c0.K = K; c0.V = V; c0.O = O + (size_t)qb0 * QB * D; c0.P0 = qb0 * QB;
        c1.Q = Q + (size_t)qb1 * QB * D; c1.K = K; c1.V = V; c1.O = O + (size_t)qb1 * QB * D; c1.P0 = qb1 * QB;
        Seam<bf16> S;
        causal_swa_prime<bf16, bf16>(c0, W, lds, S);
        causal_swa_block<bf16, bf16>(c0, c1, 2048, W, lds, S);
        causal_swa_block<bf16, bf16>(c1, c1, 2048, W, lds, S);
        __syncthreads();
    }
}

#ifndef MK_LAUNCHES
#define MK_LAUNCHES 1
#endif
constexpr int NPHASE = 11;
__global__ void __launch_bounds__(512, 2) mk_fwd(Args args_unused) {
    extern __shared__ __attribute__((aligned(16))) unsigned char lds_raw[];
    LAS unsigned char* lds = (LAS unsigned char*)lds_raw;
    const int G = gridDim.x;
#define TIDS int tid = threadIdx.x; asm volatile("" : "+v"(tid)); const int lane = tid & 63, wave = __builtin_amdgcn_readfirstlane(tid >> 6); (void)tid; (void)lane; (void)wave
    const unsigned long long lohi = karg64(232); const int lo = (int)(unsigned)lohi, hi = (int)(unsigned)(lohi >> 32);
#define IN(k) (lo <= (k) && (k) < hi)
#if MK_LAUNCHES == 1
    if ((int)(unsigned)(karg64(232) >> 32) > NPHASE) cg::this_grid().sync();
    if (threadIdx.x < 2) ((volatile LAS unsigned*)(lds + LDS_BARST))[threadIdx.x] = 0u;
    __syncthreads();
    (void)xcd_barrier_post((unsigned*)(GAS unsigned*)(karg64(224) + WS_BAR), (volatile LAS unsigned*)(lds + LDS_BARST));
#define SEAM(k) do { if (IN(k) && IN((k) + 1)) { XcdBarrier b_; b_.bar = (unsigned*)(GAS unsigned*)(karg64(224) + WS_BAR); b_.x = xb_xcc_id(); b_.st = (volatile LAS unsigned*)(lds + LDS_BARST); xcd_barrier(b_); } } while (0)
#else
#define SEAM(k) do { } while (0)
#endif
    typedef pg8::EpiBf16<0> EpiPlain;
    if (IN(0)) { TIDS; Args args; KWS(args); KIN(args, 0); KIN(args, 1); KIN(args, 2); KIN(args, 3); KIN(args, 4); KIN(args, 7); KIN(args, 8); KIN(args, 15); KIN(args, 23); KIN(args, 24); KIN(args, 25);
        phase0<7>(args, lds, tid, lane, wave, G); }
#ifdef MK_P4_PART
    if (lo == 21) {
        if (MK_P4_PART & 1) { TIDS; Args args; KWS(args); KIN(args, 5); KIN(args, 6); KIN(args, 9);
          __syncthreads();
          for (int rr = 0; rr < MK_INNER; ++rr) for (int u = blockIdx.x; u < 256; u += G) m3_unit(args, lds, u, tid, lane, wave); }
        if (MK_P4_PART & 2) { TIDS; Args args; KWS(args); KIN(args, 10); KIN(args, 11); KIN(args, 12); KIN(args, 13); KIN(args, 14);
          da_combine(args, lane, wave, G); }
    }
#endif
#ifdef MK_P0_PART
    if (lo == 20) { TIDS; Args args; KWS(args); KIN(args, 0); KIN(args, 1); KIN(args, 2); KIN(args, 3); KIN(args, 4); KIN(args, 7); KIN(args, 8); KIN(args, 15); KIN(args, 23); KIN(args, 24); KIN(args, 25);
        phase0<MK_P0_PART>(args, lds, tid, lane, wave, G); }
#endif
    SEAM(0);
    if (IN(1)) {
        Args args; KWS(args); unsigned char* ws = args.ws;
        __syncthreads();
        { pg8::Gemm g{(const bf16r*)(ws + WS_H), (const bf16r*)(ws + WS_WIN), TOK, 8192, 2048}; pg8::StaticOrder S; S.init(TOK, 8192, G, (int)blockIdx.x);
          EpiG1 E{ws}; pg8::gemm_phase<EpiG1, pg8::StaticOrder, true, true>(lds, g, S, E); }
        __syncthreads();
        { pg8::Gemm g{(const bf16r*)(ws + WS_PB), (const bf16r*)(ws + WS_WPP0), TOK, 2048, 256}; pg8::StaticOrder S; S.init(TOK, 2048, G, (int)blockIdx.x);
          EpiPlain E{(bf16r*)(ws + WS_PP0), 2048, nullptr, 0, 0, 1.f}; pg8::gemm_phase<EpiPlain, pg8::StaticOrder, true, true>(lds, g, S, E); }
    }
    SEAM(1);
    if (IN(2)) {
        TIDS; Args args; KWS(args); KIN(args, 5); KIN(args, 6);
        __syncthreads();
        attn_phase(args, (char*)lds_raw, G);
        __syncthreads();
        for (int u = blockIdx.x; u < 256; u += G) m1_unit(args, lds, u, tid, lane, wave);
    }
    SEAM(2);
    if (IN(3)) { TIDS; Args args; KWS(args); m2_scan(args, tid, G); }
    SEAM(3);
    if (IN(4)) {
        { TIDS; Args args; KWS(args); KIN(args, 5); KIN(args, 6); KIN(args, 9);
          __syncthreads();
#ifdef MK_M3_STAGE2
          for (int rr = 0; rr < MK_M3_STAGE2; ++rr) { for (int u = blockIdx.x; u < 256; u += G) m3_unit<1>(args, lds, u, tid, lane, wave); __syncthreads(); }
#endif
          for (int u = blockIdx.x; u < 256; u += G) m3_unit(args, lds, u, tid, lane, wave); }
        { TIDS; Args args; KWS(args); KIN(args, 10); KIN(args, 11); KIN(args, 12); KIN(args, 13); KIN(args, 14);
          da_combine(args, lane, wave, G); }
    }
    SEAM(4);
    if (IN(5)) {
        TIDS; Args args; KWS(args); KOUT(args); KIN(args, 0); KIN(args, 16); KIN(args, 17); KIN(args, 22); KIN(args, 23); KIN(args, 24); KIN(args, 25); unsigned char* ws = args.ws;
        __syncthreads();
        l1_weights(args, lds, lane, wave, G);
        __syncthreads();
        pg8::Gemm g{(const bf16r*)(ws + WS_AO), (const bf16r*)(ws + WS_WOUT0), TOK, 2048, 2048}; pg8::StaticOrder S; S.init(TOK, 2048, G, (int)blockIdx.x);
        EpiRes<false> E{args.in[0], (bf16r*)(ws + WS_X1B), (float*)(ws + WS_SSQA)};
        pg8::gemm_phase<EpiRes<false>, pg8::StaticOrder, true, true>(lds, g, S, E);
    }
    SEAM(5);
    if (IN(6)) {
        Args args; KWS(args); KOUT(args); unsigned char* ws = args.ws;
        __syncthreads();
        pg8::Gemm g{(const bf16r*)(ws + WS_X1B), (const bf16r*)(ws + WS_WG0), TOK, 2048, 2048}; pg8::StaticOrder S; S.init(TOK, 2048, G, (int)blockIdx.x);
        EpiGate E{(const bf16r*)(ws + WS_X1B), (bf16r*)(ws + WS_X2B), (const bf16r*)(ws + WS_PP0), (const float*)(ws + WS_SSQA), (float*)(ws + WS_SSQB)};
        pg8::gemm_phase<EpiGate, pg8::StaticOrder, true, true>(lds, g, S, E);
    }
    SEAM(6);
    if (IN(7)) {
        Args args; KWS(args); KOUT(args); unsigned char* ws = args.ws;
        __syncthreads();
        { pg8::Gemm g{(const bf16r*)(ws + WS_X2B), (const bf16r*)(ws + WS_WCIN), TOK, 6144, 2048}; pg8::StaticOrder S; S.init(TOK, 6144, G, (int)blockIdx.x);
          EpiUVZ E{(bf16r*)args.out, (bf16r*)(ws + WS_V), (const float*)(ws + WS_SSQB), (float*)(ws + WS_LNS), (float*)(ws + WS_LNQ)};
          pg8::gemm_phase<EpiUVZ, pg8::StaticOrder, true, true>(lds, g, S, E); }
        __syncthreads();
        { pg8::Gemm g{(const bf16r*)(ws + WS_PB) + (size_t)TOK * 256, (const bf16r*)(ws + WS_WPP1), TOK, 2048, 256}; pg8::StaticOrder S; S.init(TOK, 2048, G, (int)blockIdx.x);
          EpiPlain E{(bf16r*)(ws + WS_PP1), 2048, nullptr, 0, 0, 1.f}; pg8::gemm_phase<EpiPlain, pg8::StaticOrder, true, true>(lds, g, S, E); }
    }
    SEAM(7);
    if (IN(8)) {
        TIDS; Args args; KWS(args); KOUT(args); KIN(args, 18); KIN(args, 19); KIN(args, 20); KIN(args, 21);
        __syncthreads();
        for (int u = blockIdx.x; u < 512; u += G) sgu_unit(args, lds, u, tid, lane, wave);
    }
    SEAM(8);
    if (IN(9)) {
        Args args; KWS(args); KOUT(args); unsigned char* ws = args.ws;
        __syncthreads();
        pg8::Gemm g{(const bf16r*)(ws + WS_MB), (const bf16r*)(ws + WS_WCOUT), TOK, 2048, 2048}; pg8::StaticOrder S; S.init(TOK, 2048, G, (int)blockIdx.x);
        EpiRes<true> E{(const void*)(ws + WS_X2B), (bf16r*)(ws + WS_X3B), (float*)(ws + WS_SSQC)};
        pg8::gemm_phase<EpiRes<true>, pg8::StaticOrder, true, true>(lds, g, S, E);
    }
    SEAM(9);
    if (IN(10)) {
        Args args; KWS(args); KOUT(args); KIN(args, 26); unsigned char* ws = args.ws;
        __syncthreads();
        pg8::Gemm g{(const bf16r*)(ws + WS_X3B), (const bf16r*)(ws + WS_WG1), TOK, 2048, 2048}; pg8::StaticOrder S; S.init(TOK, 2048, G, (int)blockIdx.x);
        EpiGateFinal E{(const bf16r*)(ws + WS_X3B), args.out, (const bf16r*)(ws + WS_PP1), (const float*)(ws + WS_SSQC), (float*)(ws + WS_SSQA), (unsigned*)(ws + WS_BAR + 16384), (const float*)args.in[26]};
        pg8::gemm_phase<EpiGateFinal, pg8::StaticOrder, true, true>(lds, g, S, E);
    }
#undef IN
#undef SEAM
}

extern "C" void kernel_launch(void* const* d_in, const int* in_sizes, int n_in, void* d_out, int out_size, void* d_ws, size_t ws_size, hipStream_t stream) {
    static int grid = 0;
    if (grid == 0) {
        if (n_in != 27 || out_size != TOK * DM || ws_size < WS_END) { fprintf(stderr, "kernel_launch: unexpected shapes (n_in %d out %d ws %zu)\n", n_in, out_size, ws_size); grid = -1; return; }
        int dev = 0, cus = 0, per_cu = 0;
        (void)hipGetDevice(&dev); (void)hipDeviceGetAttribute(&cus, hipDeviceAttributeMultiprocessorCount, dev);
        (void)hipFuncSetAttribute((const void*)mk_fwd, hipFuncAttributeMaxDynamicSharedMemorySize, LDS_BYTES);
        (void)hipOccupancyMaxActiveBlocksPerMultiprocessor(&per_cu, (const void*)mk_fwd, 512, LDS_BYTES);
        if (per_cu < 1) { fprintf(stderr, "kernel_launch: occupancy query says %d blocks per CU\n", per_cu); per_cu = 1; }
        if (cus != 256) { fprintf(stderr, "kernel_launch: built for a 256-CU device (got %d)\n", cus); grid = -1; return; }
        grid = 256;
        (void)hipGetLastError();
    }
    if (grid < 0) return;
    Args a{};
    for (int i = 0; i < 27; ++i) a.in[i] = d_in[i];
    (void)hipMemsetAsync((unsigned char*)d_ws + WS_BAR, 0, 32768, stream);
    a.out = (float*)d_out; a.ws = (unsigned char*)d_ws;
#if MK_LAUNCHES == 1
    a.ph_lo = 0; a.ph_hi = NPHASE;
    void* kargs[] = {&a};
    hipError_t e = hipLaunchCooperativeKernel((const void*)mk_fwd, dim3(grid), dim3(512), kargs, LDS_BYTES, stream);
    if (e != hipSuccess) fprintf(stderr, "cooperative launch failed: %s (grid %d)\n", hipGetErrorString(e), grid);
#else
    for (int p = 0; p < NPHASE; ++p) { a.ph_lo = p; a.ph_hi = p + 1; hipLaunchKernelGGL(mk_fwd, dim3(grid), dim3(512), LDS_BYTES, stream, a);
#ifdef MK_REP_PHASE
#if defined(MK_P4_PART)
        if (p == 4) { a.ph_lo = 21; a.ph_hi = 22; for (int r = 0; r < MK_REP_N; ++r) hipLaunchKernelGGL(mk_fwd, dim3(grid), dim3(512), LDS_BYTES, stream, a); }
#elif defined(MK_P0_PART)
        if (p == 0) { a.ph_lo = 20; a.ph_hi = 21; for (int r = 0; r < MK_REP_N; ++r) hipLaunchKernelGGL(mk_fwd, dim3(grid), dim3(512), LDS_BYTES, stream, a); }
#else
        if (p == MK_REP_PHASE) for (int r = 0; r < MK_REP_N; ++r) hipLaunchKernelGGL(mk_fwd, dim3(grid), dim3(512), LDS_BYTES, stream, a);
#endif
#endif
    }
#endif
}
```
